# Optimizing an MI355X kernel written in HIP

```python
import math
import jax
import jax.numpy as jnp
from jax import lax
import numpy as np

D_MODEL = 1024
BATCH = 8
SEQ = 2048
DEPTH = 1

SSM_EXPAND = 2
D_INNER = SSM_EXPAND * D_MODEL
SSM_HEAD_DIM = 64
SSM_HEADS = D_INNER // SSM_HEAD_DIM
SSM_GROUPS = 4
SSM_STATE = 128
SSM_CONV = 4
SSM_CHUNK = 128
D_CONV = D_INNER + 2 * SSM_GROUPS * SSM_STATE

ATT_HEADS = 16
ATT_HEAD_DIM = 64
ATT_KV_GROUPS = 4
ATT_HPG = ATT_HEADS // ATT_KV_GROUPS
ATT_WIDTH = ATT_HEADS * ATT_HEAD_DIM
KV_WIDTH = ATT_KV_GROUPS * ATT_HEAD_DIM
CMP_BLOCK = 32
CMP_STRIDE = 16
CMP_HIDDEN = 256
SLC_BLOCK = 64
SLC_TOPK = 16
WINDOW = 512
ATT_Q_BLOCK = 64
FORCE_BONUS = 1000.0

N_BRANCH = 2
EPS = 1e-6
NEG_INF = -1e30

IN_SIZES = (D_INNER, D_CONV, SSM_HEADS, ATT_WIDTH, 6 * KV_WIDTH, 3 * ATT_HEADS, ATT_WIDTH, N_BRANCH * D_MODEL)
IN_SPLITS = tuple(int(v) for v in np.cumsum(IN_SIZES)[:-1])
IN_TOTAL = int(sum(IN_SIZES))

kernel_name = 'hybrid_ssd_nsa_griffin_block'


def _rmsnorm(x, g):
    xf = x.astype(jnp.float32)
    y = xf * lax.rsqrt(jnp.mean(xf * xf, axis=-1, keepdims=True) + EPS)
    return (y * g.astype(jnp.float32)).astype(x.dtype)


def _alibi_slopes():
    m = 2.0 ** (-8.0 * np.arange(1, ATT_HEADS + 1) / ATT_HEADS)
    return jnp.asarray(m.reshape(ATT_KV_GROUPS, ATT_HPG), dtype=jnp.float32)


def _causal_dwconv(u, w, b):
    k = w.shape[0]
    y = lax.conv_general_dilated(u, w[:, None, :].astype(u.dtype), window_strides=(1,),
                                 padding=[(k - 1, 0)], dimension_numbers=('NWC', 'WIO', 'NWC'),
                                 feature_group_count=u.shape[-1])
    return y + b


def _ssd_chunked(xh, dt, a, bm, cm):
    bsz, s, h, p = xh.shape
    nc = s // SSM_CHUNK
    cl = SSM_CHUNK
    hg = SSM_HEADS // SSM_GROUPS
    xdt = (xh * dt[..., None]).reshape(bsz, nc, cl, SSM_GROUPS, hg, p)
    adt = (dt * a).reshape(bsz, nc, cl, SSM_GROUPS, hg)
    b_ = bm.reshape(bsz, nc, cl, SSM_GROUPS, SSM_STATE)
    c_ = cm.reshape(bsz, nc, cl, SSM_GROUPS, SSM_STATE)
    a_cs = jnp.cumsum(adt, axis=2)
    causal = jnp.tril(jnp.ones((cl, cl), dtype=bool))[None, None, :, :, None, None]
    seg = a_cs[:, :, :, None] - a_cs[:, :, None, :]
    decay = jnp.exp(jnp.where(causal, seg, -jnp.inf))
    cb = jnp.einsum('bclgn,bcsgn->bclsg', c_, b_)
    y_diag = jnp.einsum('bclsg,bclsgh,bcsghp->bclghp', cb, decay, xdt)
    decay_states = jnp.exp(a_cs[:, :, -1:] - a_cs)
    states = jnp.einsum('bclgn,bclgh,bclghp->bcghpn', b_, decay_states, xdt)
    chunk_decay = jnp.exp(a_cs[:, :, -1])

    def step(carry, inp):
        st, dec = inp
        return carry * dec[..., None, None] + st, carry

    h0 = jnp.zeros(states.shape[:1] + states.shape[2:], states.dtype)
    _, prev = lax.scan(step, h0, (jnp.moveaxis(states, 1, 0), jnp.moveaxis(chunk_decay, 1, 0)))
    prev = jnp.moveaxis(prev, 0, 1)
    y_off = jnp.einsum('bclgn,bcghpn,bclgh->bclghp', c_, prev, jnp.exp(a_cs))
    return (y_diag + y_off).reshape(bsz, s, h, p)


def _mamba2_branch(z, xbc, dt_raw, conv_w, conv_b, dt_bias, a_log, d_skip, g_norm):
    bsz, s, _ = z.shape
    xbc = jax.nn.silu(_causal_dwconv(xbc, conv_w, conv_b))
    xs, bm, cm = jnp.split(xbc, [D_INNER, D_INNER + SSM_GROUPS * SSM_STATE], axis=-1)
    xh = xs.reshape(bsz, s, SSM_HEADS, SSM_HEAD_DIM)
    bm = bm.reshape(bsz, s, SSM_GROUPS, SSM_STATE)
    cm = cm.reshape(bsz, s, SSM_GROUPS, SSM_STATE)
    dt = jax.nn.softplus((dt_raw + dt_bias).astype(jnp.float32))
    a = -jnp.exp(a_log.astype(jnp.float32))
    y = _ssd_chunked(xh, dt, a, bm, cm) + xh * d_skip[:, None]
    y = y.reshape(bsz, s, D_INNER) * jax.nn.silu(z)
    gsz = D_INNER // SSM_GROUPS
    y = _rmsnorm(y.reshape(bsz, s, SSM_GROUPS, gsz), g_norm.reshape(SSM_GROUPS, gsz))
    return y.reshape(bsz, s, D_INNER)


def _compress(kv, pos, w1, w2):
    bsz, s, g, d = kv.shape
    n_cmp = (s - CMP_BLOCK) // CMP_STRIDE + 1
    idx = np.arange(n_cmp)[:, None] * CMP_STRIDE + np.arange(CMP_BLOCK)[None, :]
    blk = kv[:, idx] + pos[None, None, :, None, :]
    blk = jnp.transpose(blk, (0, 1, 3, 2, 4)).reshape(bsz, n_cmp, g, CMP_BLOCK * d)
    return jax.nn.silu(blk @ w1) @ w2


def _cmp_to_slc(n_cmp, n_slc):
    cs = np.arange(n_cmp) * CMP_STRIDE
    ss = np.arange(n_slc) * SLC_BLOCK
    lo = np.maximum(cs[:, None], ss[None, :])
    hi = np.minimum(cs[:, None] + CMP_BLOCK, ss[None, :] + SLC_BLOCK)
    return jnp.asarray(np.clip(hi - lo, 0, None) / CMP_BLOCK, dtype=jnp.float32)


def _nsa_branch(q, kv, gate_raw, z_att, cmp_pos_k, cmp_w1_k, cmp_w2_k, cmp_pos_v, cmp_w1_v, cmp_w2_v):
    bsz, s, _ = q.shape
    ng, hg, d = ATT_KV_GROUPS, ATT_HPG, ATT_HEAD_DIM
    scale = ATT_HEAD_DIM ** -0.5
    slopes = _alibi_slopes()
    q = q.reshape(bsz, s, ng, hg, d)
    kc, vc, ks, vs, kw, vw = [t.reshape(bsz, s, ng, d) for t in jnp.split(kv, 6, axis=-1)]
    t_pos = jnp.arange(s)

    kc = _compress(kc, cmp_pos_k, cmp_w1_k, cmp_w2_k)
    vc = _compress(vc, cmp_pos_v, cmp_w1_v, cmp_w2_v)
    n_cmp = kc.shape[1]
    cmp_end = jnp.arange(n_cmp) * CMP_STRIDE + (CMP_BLOCK - 1)
    dist_c = (t_pos[:, None] - cmp_end[None, :]).astype(jnp.float32)
    valid_c = dist_c >= 0
    sc = jnp.einsum('btghd,bjgd->bghtj', q, kc).astype(jnp.float32) * scale - slopes[None, :, :, None, None] * dist_c
    sc = jnp.where(valid_c, sc, NEG_INF)
    p_c = jnp.where(valid_c, jax.nn.softmax(sc, axis=-1), 0.0)
    o_cmp = jnp.einsum('bghtj,bjgd->btghd', p_c, vc)

    n_slc = s // SLC_BLOCK
    n_sel = min(SLC_TOPK, n_slc)
    imp = jnp.einsum('bghtj,jk->bgtk', p_c, _cmp_to_slc(n_cmp, n_slc))
    blk_t = (t_pos // SLC_BLOCK)[:, None]
    kk = jnp.arange(n_slc)[None, :]
    forced = (kk == 0) | (kk == blk_t) | (kk == blk_t - 1)
    score = jnp.where(forced, imp + FORCE_BONUS, jnp.where(kk <= blk_t, imp, -1.0))
    _, sel = lax.top_k(score, n_sel)

    ks_b = ks.reshape(bsz, n_slc, SLC_BLOCK, ng, d).transpose(0, 3, 1, 2, 4)
    vs_b = vs.reshape(bsz, n_slc, SLC_BLOCK, ng, d).transpose(0, 3, 1, 2, 4)
    kw_p = jnp.pad(kw, ((0, 0), (WINDOW, 0), (0, 0), (0, 0)))
    vw_p = jnp.pad(vw, ((0, 0), (WINDOW, 0), (0, 0), (0, 0)))
    b_ix = jnp.arange(bsz)[:, None, None, None]
    g_ix = jnp.arange(ng)[None, :, None, None]
    span = ATT_Q_BLOCK + WINDOW

    def q_block(i):
        t0 = i * ATT_Q_BLOCK
        tq = t0 + jnp.arange(ATT_Q_BLOCK)
        qb = lax.dynamic_slice_in_dim(q, t0, ATT_Q_BLOCK, axis=1)
        ib = lax.dynamic_slice_in_dim(sel, t0, ATT_Q_BLOCK, axis=2)
        kg = ks_b[b_ix, g_ix, ib]
        vg = vs_b[b_ix, g_ix, ib]
        spos = ib[..., None] * SLC_BLOCK + jnp.arange(SLC_BLOCK)
        ds = (tq[None, None, :, None, None] - spos).astype(jnp.float32)[:, :, None]
        ss = jnp.einsum('btghd,bgtnld->bghtnl', qb, kg).astype(jnp.float32) * scale - slopes[None, :, :, None, None, None] * ds
        ss = jnp.where(ds >= 0, ss, NEG_INF)
        ps = jax.nn.softmax(ss.reshape(ss.shape[:4] + (-1,)), axis=-1).reshape(ss.shape)
        o_s = jnp.einsum('bghtnl,bgtnld->btghd', ps, vg)
        kwb = lax.dynamic_slice_in_dim(kw_p, t0, span, axis=1)
        vwb = lax.dynamic_slice_in_dim(vw_p, t0, span, axis=1)
        kpos = t0 - WINDOW + jnp.arange(span)
        dw = (tq[:, None] - kpos[None, :]).astype(jnp.float32)
        ok = (dw >= 0) & (dw < WINDOW) & (kpos[None, :] >= 0)
        sw = jnp.einsum('btghd,bsgd->bghts', qb, kwb).astype(jnp.float32) * scale - slopes[None, :, :, None, None] * dw
        sw = jnp.where(ok, sw, NEG_INF)
        o_w = jnp.einsum('bghts,bsgd->btghd', jax.nn.softmax(sw, axis=-1), vwb)
        return o_s, o_w

    o_slc, o_win = lax.map(q_block, jnp.arange(s // ATT_Q_BLOCK))
    o_slc = jnp.moveaxis(o_slc, 0, 1).reshape(bsz, s, ng, hg, d)
    o_win = jnp.moveaxis(o_win, 0, 1).reshape(bsz, s, ng, hg, d)
    g = jax.nn.sigmoid(gate_raw.astype(jnp.float32)).reshape(bsz, s, ng, hg, 3, 1)
    o = g[..., 0, :] * o_cmp + g[..., 1, :] * o_slc + g[..., 2, :] * o_win
    return o.reshape(bsz, s, ATT_WIDTH) * jax.nn.silu(z_att)


def _layer(x, c, w_ada, b_ada, g_pre, g_post, w_in, conv_w, conv_b, dt_bias, a_log, d_skip,
           g_ssm_norm, w_ssm_out, cmp_pos_k, cmp_w1_k, cmp_w2_k, cmp_pos_v, cmp_w1_v, cmp_w2_v,
           w_nsa_out, w_out):
    bsz, s, dm = x.shape
    shift, scale, gate = jnp.split(c @ w_ada + b_ada, 3, axis=-1)
    h = _rmsnorm(x, g_pre) * (1.0 + scale[:, None, :]) + shift[:, None, :]
    z_ssm, xbc, dt_raw, q, kv, nsa_gate, z_att, merge_gate = jnp.split(h @ w_in, IN_SPLITS, axis=-1)
    y_ssm = _mamba2_branch(z_ssm, xbc, dt_raw, conv_w, conv_b, dt_bias, a_log, d_skip, g_ssm_norm) @ w_ssm_out
    y_nsa = _nsa_branch(q, kv, nsa_gate, z_att, cmp_pos_k, cmp_w1_k, cmp_w2_k,
                        cmp_pos_v, cmp_w1_v, cmp_w2_v) @ w_nsa_out
    mg = jax.nn.sigmoid(merge_gate.reshape(bsz, s, N_BRANCH, dm))
    merged = mg[:, :, 0] * y_ssm + mg[:, :, 1] * y_nsa
    out = merged @ w_out
    return x + gate[:, None, :] * _rmsnorm(out, g_post)


def setup_inputs(seed: int = 0) -> dict:
    key = jax.random.key(seed)
    ks = jax.random.split(key, 24)
    nl = DEPTH

    def nrm(k, shape, sd):
        return jax.random.normal(k, shape, jnp.float32) * sd

    dt0 = jnp.exp(jax.random.uniform(ks[9], (nl, SSM_HEADS), jnp.float32, math.log(1e-3), math.log(1e-1)))
    fan_cmp = CMP_BLOCK * ATT_HEAD_DIM
    return {
        'x': nrm(ks[0], (BATCH, SEQ, D_MODEL), 1.0),
        'c': nrm(ks[1], (BATCH, D_MODEL), 1.0),
        'w_ada': nrm(ks[2], (nl, D_MODEL, 3 * D_MODEL), 0.5 * D_MODEL ** -0.5),
        'b_ada': nrm(ks[3], (nl, 3 * D_MODEL), 0.01),
        'g_pre': 1.0 + nrm(ks[4], (nl, D_MODEL), 0.05),
        'g_post': 1.0 + nrm(ks[5], (nl, D_MODEL), 0.05),
        'w_in': nrm(ks[6], (nl, D_MODEL, IN_TOTAL), D_MODEL ** -0.5),
        'conv_w': nrm(ks[7], (nl, SSM_CONV, D_CONV), SSM_CONV ** -0.5),
        'conv_b': nrm(ks[8], (nl, D_CONV), 0.01),
        'dt_bias': dt0 + jnp.log(-jnp.expm1(-dt0)),
        'a_log': jnp.log(jax.random.uniform(ks[10], (nl, SSM_HEADS), jnp.float32, 1.0, 16.0)),
        'd_skip': 1.0 + nrm(ks[11], (nl, SSM_HEADS), 0.1),
        'g_ssm_norm': 1.0 + nrm(ks[12], (nl, D_INNER), 0.05),
        'w_ssm_out': nrm(ks[13], (nl, D_INNER, D_MODEL), D_INNER ** -0.5),
        'cmp_pos_k': nrm(ks[14], (nl, CMP_BLOCK, ATT_HEAD_DIM), 0.1),
        'cmp_w1_k': nrm(ks[15], (nl, fan_cmp, CMP_HIDDEN), fan_cmp ** -0.5),
        'cmp_w2_k': nrm(ks[16], (nl, CMP_HIDDEN, ATT_HEAD_DIM), CMP_HIDDEN ** -0.5),
        'cmp_pos_v': nrm(ks[17], (nl, CMP_BLOCK, ATT_HEAD_DIM), 0.1),
        'cmp_w1_v': nrm(ks[18], (nl, fan_cmp, CMP_HIDDEN), fan_cmp ** -0.5),
        'cmp_w2_v': nrm(ks[19], (nl, CMP_HIDDEN, ATT_HEAD_DIM), CMP_HIDDEN ** -0.5),
        'w_nsa_out': nrm(ks[20], (nl, ATT_WIDTH, D_MODEL), ATT_WIDTH ** -0.5),
        'w_out': nrm(ks[21], (nl, D_MODEL, D_MODEL), D_MODEL ** -0.5),
    }


def reference(x, c, w_ada, b_ada, g_pre, g_post, w_in, conv_w, conv_b, dt_bias, a_log, d_skip,
              g_ssm_norm, w_ssm_out, cmp_pos_k, cmp_w1_k, cmp_w2_k, cmp_pos_v, cmp_w1_v, cmp_w2_v,
              w_nsa_out, w_out):
    for layer in range(DEPTH):
        x = _layer(x, c, w_ada[layer], b_ada[layer], g_pre[layer], g_post[layer], w_in[layer],
                   conv_w[layer], conv_b[layer], dt_bias[layer], a_log[layer], d_skip[layer],
                   g_ssm_norm[layer], w_ssm_out[layer], cmp_pos_k[layer], cmp_w1_k[layer],
                   cmp_w2_k[layer], cmp_pos_v[layer], cmp_w1_v[layer], cmp_w2_v[layer],
                   w_nsa_out[layer], w_out[layer])
    return x
```

```cpp
#include <hip/hip_runtime.h>
#include <hip/hip_cooperative_groups.h>
#include <cstdio>
namespace cg = cooperative_groups;

typedef unsigned short u16;
typedef short s8v __attribute__((ext_vector_type(8)));
typedef short s4v __attribute__((ext_vector_type(4)));
typedef float f4v __attribute__((ext_vector_type(4)));
#define DI __device__ __forceinline__
#define MFMA16(a, b, c) __builtin_amdgcn_mfma_f32_16x16x32_bf16((a), (b), (c), 0, 0, 0)

constexpr int SEQ = 2048, DM = 1024, NB = 8;
constexpr int TS = SEQ + 64;
constexpr int NBG = 2;
constexpr int MP = NBG * SEQ;
constexpr int NPASS = NB / NBG;
constexpr int NIN = 10832, LDP = 10880;
constexpr int C_Z = 0, C_XBC = 2048, C_DT = 5120, C_Q = 5152, C_KC = 6176, C_VC = 6432, C_KS = 6688, C_VS = 6944,
              C_KW = 7200, C_VW = 7456, C_G = 7712, C_ZA = 7760, C_MG = 8784;
constexpr float EPS = 1e-6f;
constexpr float NEGB = -1e30f;
constexpr int APROBE = 0;

constexpr size_t al256(size_t x) { return (x + 255) & ~size_t(255); }
constexpr size_t O_WIN = 0;
constexpr size_t O_WSSM = O_WIN + al256((size_t)LDP * 1024 * 2);
constexpr size_t O_WNSA = O_WSSM + al256((size_t)1024 * 2048 * 2);
constexpr size_t O_WOUT = O_WNSA + al256((size_t)1024 * 1024 * 2);
constexpr size_t O_W1K = O_WOUT + al256((size_t)1024 * 1024 * 2);
constexpr size_t O_W1V = O_W1K + al256((size_t)256 * 2048 * 2);
constexpr size_t O_W2K = O_W1V + al256((size_t)256 * 2048 * 2);
constexpr size_t O_W2V = O_W2K + al256((size_t)64 * 256 * 2);
constexpr size_t O_POSB = O_W2V + al256((size_t)64 * 256 * 2);
constexpr size_t O_ADA = O_POSB + al256(2 * 256 * 4);
constexpr size_t O_H = O_ADA + al256((size_t)8 * 3072 * 4);
constexpr size_t O_P = O_H + al256((size_t)MP * 1024 * 2);
constexpr size_t O_XC = O_P + al256((size_t)MP * LDP * 2);
constexpr size_t O_XCT = O_XC + al256((size_t)MP * 3072 * 2);
constexpr size_t O_DT = O_XCT + al256((size_t)NBG * 2560 * TS * 2);
constexpr size_t O_ACS = O_DT + al256((size_t)NBG * 32 * 2048 * 4);
constexpr size_t O_ST = O_ACS + al256((size_t)NBG * 32 * 2048 * 4);
constexpr size_t O_YD = O_ST + al256((size_t)NBG * 16 * 32 * 64 * 128 * 2);
constexpr size_t O_YN = O_YD + al256((size_t)MP * 2048 * 2);
constexpr size_t O_KCMP = O_YN + al256((size_t)MP * 2048 * 2);
constexpr size_t O_VCT = O_KCMP + al256((size_t)NBG * 4 * 128 * 64 * 2);
constexpr size_t O_VST = O_VCT + al256((size_t)NBG * 4 * 128 * 64 * 2);
constexpr size_t O_VWT = O_VST + al256((size_t)NBG * 4 * 64 * TS * 2);
constexpr size_t O_SEL = O_VWT + al256((size_t)NBG * 4 * 64 * TS * 2);
constexpr size_t O_OCMP = O_SEL + al256((size_t)NBG * 4 * 2048 * 4);
constexpr size_t O_O = O_OCMP + al256((size_t)MP * 1024 * 2);
constexpr size_t O_BAR = O_O + al256((size_t)MP * 1024 * 2);
constexpr size_t O_END = O_BAR + 16384;
static_assert(O_END <= (size_t)256 * 1024 * 1024, "workspace map must fit the guaranteed 256 MiB");
constexpr size_t O_OUTF = O_P;
constexpr size_t O_RSQ = O_P + al256((size_t)MP * 1024 * 4);

struct Params {
  const float *x, *c, *w_ada, *b_ada, *g_pre, *g_post, *w_in, *conv_w, *conv_b, *dt_bias, *a_log, *d_skip, *g_ssm_norm,
      *w_ssm_out, *cmp_pos_k, *cmp_w1_k, *cmp_w2_k, *cmp_pos_v, *cmp_w1_v, *cmp_w2_v, *w_nsa_out, *w_out;
  float* out;
  unsigned char* ws;
};

DI u16 f2bf(float f) { unsigned u = __float_as_uint(f); u += 0x7fffu + ((u >> 16) & 1u); return (u16)(u >> 16); }
DI float bf2f(u16 h) { return __uint_as_float(((unsigned)h) << 16); }
DI float bfs(short h) { return __uint_as_float(((unsigned)(u16)h) << 16); }
DI s8v ld8(const u16* p) { return *reinterpret_cast<const s8v*>(p); }
DI s4v ld4(const u16* p) { return *reinterpret_cast<const s4v*>(p); }
DI f4v ldf4(const float* p) { return *reinterpret_cast<const f4v*>(p); }
typedef __bf16 bf2v __attribute__((ext_vector_type(2)));
typedef float f2v __attribute__((ext_vector_type(2)));
typedef unsigned u2v __attribute__((ext_vector_type(2)));
typedef unsigned u4v __attribute__((ext_vector_type(4)));
DI unsigned pk2(float a, float b) {
  f2v v = {a, b};
  return __builtin_bit_cast(unsigned, __builtin_convertvector(v, bf2v));
}
DI void st4bf(u16* p, float a, float b, float c, float d) {
  u2v v = {pk2(a, b), pk2(c, d)};
  *reinterpret_cast<u2v*>(p) = v;
}
DI void st8bf_pair(u16* p, f4v a, f4v b, int quad) {
  unsigned ax = pk2(a[0], a[1]), ay = pk2(a[2], a[3]), bx = pk2(b[0], b[1]), by = pk2(b[2], b[3]);
  const auto r0 = __builtin_amdgcn_permlane16_swap(ax, bx, false, false);
  const auto r1 = __builtin_amdgcn_permlane16_swap(ay, by, false, false);
  u4v v = {r0[0], r1[0], r0[1], r1[1]};
  *reinterpret_cast<u4v*>(p + (quad & 1) * 16 + (quad >> 1) * 8) = v;
}
DI void ld8bf_pair(const u16* p, int quad, s4v& a, s4v& b) {
  const u4v x = *reinterpret_cast<const u4v*>(p + (quad & 1) * 16 + (quad >> 1) * 8);
  const auto r0 = __builtin_amdgcn_permlane16_swap(x[0], x[2], false, false);
  const auto r1 = __builtin_amdgcn_permlane16_swap(x[1], x[3], false, false);
  u2v ua = {r0[0], r1[0]}, ub = {r0[1], r1[1]};
  a = __builtin_bit_cast(s4v, ua);
  b = __builtin_bit_cast(s4v, ub);
}
DI s8v pack8(f4v a, f4v b) {
  u4v v = {pk2(a[0], a[1]), pk2(a[2], a[3]), pk2(b[0], b[1]), pk2(b[2], b[3])};
  return __builtin_bit_cast(s8v, v);
}
DI s8v pack8f(const float* x) {
  u4v v = {pk2(x[0], x[1]), pk2(x[2], x[3]), pk2(x[4], x[5]), pk2(x[6], x[7])};
  return __builtin_bit_cast(s8v, v);
}
DI s8v cat44(s4v a, s4v b) { s8v v; v[0]=a[0]; v[1]=a[1]; v[2]=a[2]; v[3]=a[3]; v[4]=b[0]; v[5]=b[1]; v[6]=b[2]; v[7]=b[3]; return v; }
DI float sigmoidf_(float x) { return __builtin_amdgcn_rcpf(1.f + __expf(-x)); }
DI float siluf_(float x) { return x * __builtin_amdgcn_rcpf(1.f + __expf(-x)); }
DI float softplusf_(float x) {
  const float y = __expf(x);
  const float small = y * (1.f - y * (0.5f - y * (0.33333334f - 0.25f * y)));
  const float big = __logf(1.f + y);
  return x > 20.f ? x : (y < 0.03f ? small : big);
}
DI float qmax(float v) { v = fmaxf(v, __shfl_xor(v, 16)); v = fmaxf(v, __shfl_xor(v, 32)); return v; }
DI float qsum(float v) { v += __shfl_xor(v, 16); v += __shfl_xor(v, 32); return v; }
DI int tidx() { int t = __builtin_amdgcn_workitem_id_x(); asm volatile("" : "+v"(t)); return t; }
DI f4v fz() { f4v z = {0.f, 0.f, 0.f, 0.f}; return z; }

DI int lds_byte32(int r, int c) {
  const int ob = (r & 15) * 64 + c * 2;
  return (r >> 4) * 1024 + (ob ^ (((ob >> 9) & 1) << 5));
}
DI void stage_rc32(int b, int& R, int& C) {
  const int st = b >> 10, sb = b & 1023, swz = sb ^ (((sb >> 9) & 1) << 5);
  R = st * 16 + (swz >> 6);
  C = (swz & 63) >> 1;
}
template <int N> DI void wait_vm() {
  if constexpr (N == 0) asm volatile("s_waitcnt vmcnt(0)" ::: "memory");
  else if constexpr (N == 3) asm volatile("s_waitcnt vmcnt(3)" ::: "memory");
  else if constexpr (N == 4) asm volatile("s_waitcnt vmcnt(4)" ::: "memory");
  else if constexpr (N == 6) asm volatile("s_waitcnt vmcnt(6)" ::: "memory");
  else asm volatile("s_waitcnt vmcnt(8)" ::: "memory");
}
template <int NT, int MODE = 0>
DI void gemm_mainloop(f4v (&acc)[4][NT], const u16* __restrict__ A, int lda, const u16* __restrict__ Bt, int ldb, int K,
                      int m0, int n0, u16* smem) {
  const int tid = tidx(), lane = tid & 63, w = tid >> 6, wm = w >> 1, wn = w & 1;
  const int l15 = lane & 15, quad = lane >> 4;
  constexpr int TA = 8192, TBB = NT * 2048, TBUF = TA + TBB;
  constexpr int NBP = NT / 2;
  constexpr int L = 2 + NBP;
  char* sbase = reinterpret_cast<char*>(smem);
  const unsigned lbase = (unsigned)(size_t)sbase;
  int Rr[2], Cc[2];
#pragma unroll
  for (int i = 0; i < 2; ++i) stage_rc32(tid * 16 + i * 4096, Rr[i], Cc[i]);
  const u16* ga0 = A + (size_t)(m0 + Rr[0]) * lda + Cc[0];
  const u16* ga1 = A + (size_t)(m0 + Rr[1]) * lda + Cc[1];
  const u16* gb0 = Bt + (size_t)(n0 + Rr[0]) * ldb + Cc[0];
  const u16* gb1 = Bt + (size_t)(n0 + Rr[NBP - 1]) * ldb + Cc[NBP - 1];
  unsigned offa[4], offb[NT];
#pragma unroll
  for (int t = 0; t < 4; ++t) offa[t] = lds_byte32(wm * 64 + t * 16 + l15, quad * 8);
#pragma unroll
  for (int t = 0; t < NT; ++t) offb[t] = TA + lds_byte32(wn * 16 * NT + t * 16 + l15, quad * 8);
  const int ns = K >> 5;
#define GEMM_STAGE(j)                                                                                                 \
  do {                                                                                                               \
    char* _d = sbase + ((j) & 3) * TBUF + tid * 16;                                                                   \
    __builtin_amdgcn_global_load_lds((const unsigned*)(ga0 + (j) * 32), (unsigned*)(_d), 16, 0, 0);                   \
    __builtin_amdgcn_global_load_lds((const unsigned*)(ga1 + (j) * 32), (unsigned*)(_d + 4096), 16, 0, 0);            \
    __builtin_amdgcn_global_load_lds((const unsigned*)(gb0 + (j) * 32), (unsigned*)(_d + TA), 16, 0, 0);              \
    if (NBP == 2) __builtin_amdgcn_global_load_lds((const unsigned*)(gb1 + (j) * 32), (unsigned*)(_d + TA + 4096), 16, 0, 0); \
  } while (0)
  asm volatile("s_waitcnt vmcnt(0)" ::: "memory");
  if (MODE != 1) { GEMM_STAGE(0); GEMM_STAGE(1); GEMM_STAGE(2); }
  for (int j = 0; j < ns; ++j) {
    if (j + 2 < ns) wait_vm<2 * L>();
    else if (j + 1 < ns) wait_vm<L>();
    else wait_vm<0>();
    asm volatile("s_waitcnt lgkmcnt(0)" ::: "memory");
    __builtin_amdgcn_s_barrier();
    if (MODE != 1 && j + 3 < ns) GEMM_STAGE(j + 3);
    if (MODE == 2) continue;
    const unsigned sl = lbase + (unsigned)((j & 3) * TBUF);
    s8v af[4], bg[NT];
    if constexpr (NT == 4) {
      asm volatile(
          "ds_read_b128 %0, %8\n\tds_read_b128 %1, %9\n\tds_read_b128 %2, %10\n\tds_read_b128 %3, %11\n\t"
          "ds_read_b128 %4, %12\n\tds_read_b128 %5, %13\n\tds_read_b128 %6, %14\n\tds_read_b128 %7, %15\n\t"
          "s_waitcnt lgkmcnt(0)"
          : "=&v"(af[0]), "=&v"(af[1]), "=&v"(af[2]), "=&v"(af[3]), "=&v"(bg[0]), "=&v"(bg[1]), "=&v"(bg[2]), "=&v"(bg[3])
          : "v"(sl + offa[0]), "v"(sl + offa[1]), "v"(sl + offa[2]), "v"(sl + offa[3]), "v"(sl + offb[0]), "v"(sl + offb[1]),
            "v"(sl + offb[2]), "v"(sl + offb[3])
          : "memory");
    } else {
      asm volatile(
          "ds_read_b128 %0, %6\n\tds_read_b128 %1, %7\n\tds_read_b128 %2, %8\n\tds_read_b128 %3, %9\n\t"
          "ds_read_b128 %4, %10\n\tds_read_b128 %5, %11\n\t"
          "s_waitcnt lgkmcnt(0)"
          : "=&v"(af[0]), "=&v"(af[1]), "=&v"(af[2]), "=&v"(af[3]), "=&v"(bg[0]), "=&v"(bg[1])
          : "v"(sl + offa[0]), "v"(sl + offa[1]), "v"(sl + offa[2]), "v"(sl + offa[3]), "v"(sl + offb[0]), "v"(sl + offb[1])
          : "memory");
    }
#pragma unroll
    for (int mt = 0; mt < 4; ++mt)
#pragma unroll
      for (int nt = 0; nt < NT; ++nt) acc[mt][nt] = MFMA16(bg[nt], af[mt], acc[mt][nt]);
  }
#undef GEMM_STAGE
  asm volatile("s_waitcnt lgkmcnt(0)" ::: "memory");
  __builtin_amdgcn_s_barrier();
}
template <int NT>
DI void zero_acc(f4v (&acc)[4][NT]) {
#pragma unroll
  for (int i = 0; i < 4; ++i)
#pragma unroll
    for (int j = 0; j < NT; ++j) acc[i][j] = fz();
}

DI void gemm_big_prefetch(const u16* __restrict__ A, int lda, const u16* __restrict__ Bt, int ldb, int m0, int n0, u16* smem) {
  const int tid = tidx();
  char* sbase = reinterpret_cast<char*>(smem);
#pragma unroll
  for (int sl = 0; sl < 2; ++sl) {
    char* d = sbase + sl * 24576 + tid * 16;
#pragma unroll
    for (int i = 0; i < 4; ++i) {
      int R, C;
      stage_rc32(tid * 16 + i * 4096, R, C);
      __builtin_amdgcn_global_load_lds((const unsigned*)(A + (size_t)(m0 + R) * lda + C + sl * 32), (unsigned*)(d + i * 4096), 16, 0, 0);
      if (i < 2)
        __builtin_amdgcn_global_load_lds((const unsigned*)(Bt + (size_t)(n0 + R) * ldb + C + sl * 32), (unsigned*)(d + 16384 + i * 4096), 16, 0, 0);
    }
  }
}
DI void gemm_big(f4v (&acc)[8][4], const u16* __restrict__ A, int lda, const u16* __restrict__ Bt, int ldb, int K, int m0, int n0,
                 u16* smem, bool prestaged) {
  const int tid = tidx(), lane = tid & 63, w = tid >> 6, wm = w >> 1, wn = w & 1;
  const int l15 = lane & 15, quad = lane >> 4;
  constexpr int TA = 16384, TBUF = 24576;
  char* sbase = reinterpret_cast<char*>(smem);
  const unsigned lbase = (unsigned)(size_t)sbase;
  const u16* ga[4];
  const u16* gb[2];
#pragma unroll
  for (int i = 0; i < 4; ++i) {
    int R, C;
    stage_rc32(tid * 16 + i * 4096, R, C);
    ga[i] = A + (size_t)(m0 + R) * lda + C;
    if (i < 2) gb[i] = Bt + (size_t)(n0 + R) * ldb + C;
  }
  unsigned offa[8], offb[4];
#pragma unroll
  for (int t = 0; t < 8; ++t) offa[t] = lds_byte32(wm * 128 + t * 16 + l15, quad * 8);
#pragma unroll
  for (int t = 0; t < 4; ++t) offb[t] = TA + lds_byte32(wn * 64 + t * 16 + l15, quad * 8);
  const int ns = K >> 5;
#define BIG_STAGE(j, slot)                                                                                            \
  do {                                                                                                               \
    char* _d = sbase + (slot) * TBUF + tid * 16;                                                                      \
    _Pragma("unroll") for (int _i = 0; _i < 4; ++_i)                                                                 \
      __builtin_amdgcn_global_load_lds((const unsigned*)(ga[_i] + (j) * 32), (unsigned*)(_d + _i * 4096), 16, 0, 0);  \
    _Pragma("unroll") for (int _i = 0; _i < 2; ++_i)                                                                 \
      __builtin_amdgcn_global_load_lds((const unsigned*)(gb[_i] + (j) * 32), (unsigned*)(_d + TA + _i * 4096), 16, 0, 0); \
  } while (0)
  if (!prestaged) {
    asm volatile("s_waitcnt vmcnt(0)" ::: "memory");
    BIG_STAGE(0, 0);
    BIG_STAGE(1, 1);
  }
  int slot = 0;
  for (int j = 0; j < ns; ++j) {
    if (j + 1 < ns) wait_vm<6>();
    else wait_vm<0>();
    asm volatile("s_waitcnt lgkmcnt(0)" ::: "memory");
    __builtin_amdgcn_s_barrier();
    const int s2 = (slot == 0) ? 2 : slot - 1;
    if (j + 2 < ns) BIG_STAGE(j + 2, s2);
    const unsigned sl = lbase + (unsigned)(slot * TBUF);
    s8v af[8], bg[4];
    asm volatile(
        "ds_read_b128 %0, %12\n\tds_read_b128 %1, %13\n\tds_read_b128 %2, %14\n\tds_read_b128 %3, %15\n\t"
        "ds_read_b128 %4, %16\n\tds_read_b128 %5, %17\n\tds_read_b128 %6, %18\n\tds_read_b128 %7, %19\n\t"
        "ds_read_b128 %8, %20\n\tds_read_b128 %9, %21\n\tds_read_b128 %10, %22\n\tds_read_b128 %11, %23\n\t"
        "s_waitcnt lgkmcnt(0)"
        : "=&v"(bg[0]), "=&v"(bg[1]), "=&v"(bg[2]), "=&v"(bg[3]), "=&v"(af[0]), "=&v"(af[1]), "=&v"(af[2]), "=&v"(af[3]),
          "=&v"(af[4]), "=&v"(af[5]), "=&v"(af[6]), "=&v"(af[7])
        : "v"(sl + offb[0]), "v"(sl + offb[1]), "v"(sl + offb[2]), "v"(sl + offb[3]), "v"(sl + offa[0]), "v"(sl + offa[1]),
          "v"(sl + offa[2]), "v"(sl + offa[3]), "v"(sl + offa[4]), "v"(sl + offa[5]), "v"(sl + offa[6]), "v"(sl + offa[7])
        : "memory");
#pragma unroll
    for (int mt = 0; mt < 8; ++mt)
#pragma unroll
      for (int nt = 0; nt < 4; ++nt) acc[mt][nt] = MFMA16(bg[nt], af[mt], acc[mt][nt]);
    slot = (slot == 2) ? 0 : slot + 1;
  }
#undef BIG_STAGE
  asm volatile("s_waitcnt lgkmcnt(0)" ::: "memory");
  __builtin_amdgcn_s_barrier();
}

DI void gemm_k64(f4v (&acc)[4][2], const u16* __restrict__ A, int lda, const u16* __restrict__ Bt, int ldb, int K, int m0, int n0,
                 u16* smem) {
  const int tid = tidx(), lane = tid & 63, w = tid >> 6, wm = w >> 1, wn = w & 1;
  const int l15 = lane & 15, quad = lane >> 4;
  constexpr int TA = 16384, TBUF = 24576;
  char* sbase = reinterpret_cast<char*>(smem);
  const unsigned lbase = (unsigned)(size_t)sbase;
  const u16* ga[4];
  const u16* gb[2];
#pragma unroll
  for (int i = 0; i < 4; ++i) {
    int R, C;
    stage_rc32(tid * 16 + (i & 1) * 4096, R, C);
    ga[i] = A + (size_t)(m0 + R) * lda + C + 32 * (i >> 1);
  }
  {
    int R, C;
    stage_rc32(tid * 16, R, C);
    gb[0] = Bt + (size_t)(n0 + R) * ldb + C;
    gb[1] = gb[0] + 32;
  }
  unsigned offa[8], offb[4];
#pragma unroll
  for (int t = 0; t < 8; ++t) offa[t] = (t >> 2) * 8192 + lds_byte32(wm * 64 + (t & 3) * 16 + l15, quad * 8);
#pragma unroll
  for (int t = 0; t < 4; ++t) offb[t] = TA + (t >> 1) * 4096 + lds_byte32(wn * 32 + (t & 1) * 16 + l15, quad * 8);
  const int ns = K >> 6;
#define K64_STAGE(j, slot)                                                                                            \
  do {                                                                                                               \
    char* _d = sbase + (slot) * TBUF + tid * 16;                                                                      \
    _Pragma("unroll") for (int _i = 0; _i < 4; ++_i)                                                                 \
      __builtin_amdgcn_global_load_lds((const unsigned*)(ga[_i] + (j) * 64), (unsigned*)(_d + _i * 4096), 16, 0, 0);  \
    _Pragma("unroll") for (int _i = 0; _i < 2; ++_i)                                                                 \
      __builtin_amdgcn_global_load_lds((const unsigned*)(gb[_i] + (j) * 64), (unsigned*)(_d + TA + _i * 4096), 16, 0, 0); \
  } while (0)
  asm volatile("s_waitcnt vmcnt(0)" ::: "memory");
  K64_STAGE(0, 0);
  if (ns > 1) K64_STAGE(1, 1);
  int slot = 0;
  for (int j = 0; j < ns; ++j) {
    if (j + 1 < ns) wait_vm<6>();
    else wait_vm<0>();
    asm volatile("s_waitcnt lgkmcnt(0)" ::: "memory");
    __builtin_amdgcn_s_barrier();
    const int s2 = (slot == 0) ? 2 : slot - 1;
    if (j + 2 < ns) K64_STAGE(j + 2, s2);
    const unsigned sl = lbase + (unsigned)(slot * TBUF);
    s8v af[8], bg[4];
    asm volatile(
        "ds_read_b128 %0, %12\n\tds_read_b128 %1, %13\n\tds_read_b128 %2, %14\n\tds_read_b128 %3, %15\n\t"
        "ds_read_b128 %4, %16\n\tds_read_b128 %5, %17\n\tds_read_b128 %6, %18\n\tds_read_b128 %7, %19\n\t"
        "ds_read_b128 %8, %20\n\tds_read_b128 %9, %21\n\tds_read_b128 %10, %22\n\tds_read_b128 %11, %23\n\t"
        "s_waitcnt lgkmcnt(0)"
        : "=&v"(bg[0]), "=&v"(bg[1]), "=&v"(bg[2]), "=&v"(bg[3]), "=&v"(af[0]), "=&v"(af[1]), "=&v"(af[2]), "=&v"(af[3]),
          "=&v"(af[4]), "=&v"(af[5]), "=&v"(af[6]), "=&v"(af[7])
        : "v"(sl + offb[0]), "v"(sl + offb[1]), "v"(sl + offb[2]), "v"(sl + offb[3]), "v"(sl + offa[0]), "v"(sl + offa[1]),
          "v"(sl + offa[2]), "v"(sl + offa[3]), "v"(sl + offa[4]), "v"(sl + offa[5]), "v"(sl + offa[6]), "v"(sl + offa[7])
        : "memory");
#pragma unroll
    for (int h = 0; h < 2; ++h)
#pragma unroll
      for (int mt = 0; mt < 4; ++mt)
#pragma unroll
        for (int nt = 0; nt < 2; ++nt) acc[mt][nt] = MFMA16(bg[h * 2 + nt], af[h * 4 + mt], acc[mt][nt]);
    slot = (slot == 2) ? 0 : slot + 1;
  }
#undef K64_STAGE
  asm volatile("s_waitcnt lgkmcnt(0)" ::: "memory");
  __builtin_amdgcn_s_barrier();
}

DI void convT_tile(const float* __restrict__ w, int K, int N, u16* __restrict__ wt, int tile, float* sm) {
  const int tid = tidx();
  const int tiles_k = K >> 6;
  const int tk = tile % tiles_k, tn = tile / tiles_k;
  const int k0 = tk * 64, n0 = tn * 64;
  {
    const int c = tid & 63, r0 = tid >> 6;
    const bool ok = (n0 + c) < N;
    float v[16];
#pragma unroll
    for (int i = 0; i < 16; ++i) v[i] = ok ? w[(size_t)(k0 + r0 + 4 * i) * N + n0 + c] : 0.f;
    __builtin_amdgcn_sched_barrier(0);
#pragma unroll
    for (int i = 0; i < 16; ++i) sm[(r0 + 4 * i) * 65 + c] = v[i];
  }
  __syncthreads();
  {
    const int n = tid >> 2, ks = (tid & 3) * 16;
    float t0[8], t1[8];
#pragma unroll
    for (int j = 0; j < 8; ++j) { t0[j] = sm[(ks + j) * 65 + n]; t1[j] = sm[(ks + 8 + j) * 65 + n]; }
    const s8v v0 = pack8f(t0), v1 = pack8f(t1);
    u16* dst = wt + (size_t)(n0 + n) * K + k0 + ks;
    *reinterpret_cast<s8v*>(dst) = v0;
    *reinterpret_cast<s8v*>(dst + 8) = v1;
  }
  __syncthreads();
}

template <int NR>
DI void gemv_cols(const float* __restrict__ vec, int K, const float* __restrict__ W, int N, const float* __restrict__ bias,
                  float* __restrict__ out, int col0, float* sm) {
  const int tid = tidx(), kg = tid >> 6, cl = tid & 63;
  const int kper = K >> 2;
  float acc[NR];
#pragma unroll
  for (int r = 0; r < NR; ++r) acc[r] = 0.f;
  for (int k0 = kg * kper; k0 < (kg + 1) * kper; k0 += 16) {
    float wv[16];
#pragma unroll
    for (int j = 0; j < 16; ++j) wv[j] = W[(size_t)(k0 + j) * N + col0 + cl];
    __builtin_amdgcn_sched_barrier(0);
#pragma unroll
    for (int j = 0; j < 16; ++j)
#pragma unroll
      for (int r = 0; r < NR; ++r) acc[r] += vec[r * K + k0 + j] * wv[j];
    __builtin_amdgcn_sched_barrier(0);
  }
#pragma unroll
  for (int r = 0; r < NR; ++r) sm[(kg * NR + r) * 64 + cl] = acc[r];
  __syncthreads();
  for (int idx = tid; idx < NR * 64; idx += 256) {
    const int r = idx >> 6, c2 = idx & 63;
    float s = bias ? bias[col0 + c2] : 0.f;
#pragma unroll
    for (int g = 0; g < 4; ++g) s += sm[(g * NR + r) * 64 + c2];
    out[(size_t)r * N + col0 + c2] = s;
  }
  __syncthreads();
}

DI void phaseA(const Params& p, unsigned char* smem_raw) {
  float* smf = reinterpret_cast<float*>(smem_raw);
  unsigned char* ws = p.ws;
  constexpr int T0 = 16 * 170, T1 = T0 + 32 * 16, T2 = T1 + 16 * 16, T3 = T2 + 16 * 16, T4 = T3 + 32 * 4, T5 = T4 + 32 * 4,
                T6 = T5 + 4, T7 = T6 + 4, T8 = T7 + 48, T9 = T8 + 8;
  for (int it = blockIdx.x; it < T9; it += gridDim.x) {
    if (it < T0) convT_tile(p.w_in, 1024, NIN, (u16*)(ws + O_WIN), it, smf);
    else if (it < T1) convT_tile(p.w_ssm_out, 2048, 1024, (u16*)(ws + O_WSSM), it - T0, smf);
    else if (it < T2) convT_tile(p.w_nsa_out, 1024, 1024, (u16*)(ws + O_WNSA), it - T1, smf);
    else if (it < T3) convT_tile(p.w_out, 1024, 1024, (u16*)(ws + O_WOUT), it - T2, smf);
    else if (it < T4) convT_tile(p.cmp_w1_k, 2048, 256, (u16*)(ws + O_W1K), it - T3, smf);
    else if (it < T5) convT_tile(p.cmp_w1_v, 2048, 256, (u16*)(ws + O_W1V), it - T4, smf);
    else if (it < T6) convT_tile(p.cmp_w2_k, 256, 64, (u16*)(ws + O_W2K), it - T5, smf);
    else if (it < T7) convT_tile(p.cmp_w2_v, 256, 64, (u16*)(ws + O_W2V), it - T6, smf);
    else if (it < T8) gemv_cols<8>(p.c, 1024, p.w_ada, 3072, p.b_ada, (float*)(ws + O_ADA), (it - T7) * 64, smf);
    else {
      const int j = it - T8, kind = j >> 2, cb = j & 3;
      gemv_cols<1>(kind ? p.cmp_pos_v : p.cmp_pos_k, 2048, kind ? p.cmp_w1_v : p.cmp_w1_k, 256, nullptr,
                   (float*)(ws + O_POSB) + kind * 256, cb * 64, smf);
    }
  }
}

DI void phaseB(const Params& p, int pass) {
  const int tid = tidx(), lane = tid & 63, w = tid >> 6;
  const float* ada = (const float*)(p.ws + O_ADA);
  u16* h = (u16*)(p.ws + O_H);
  for (int it = blockIdx.x; it < MP / 4; it += gridDim.x) {
    const int r = it * 4 + w;
    const int tg = pass * MP + r;
    const int b = tg >> 11;
    const float* xr = p.x + (size_t)tg * DM;
    f4v v[4];
    float ss = 0.f;
#pragma unroll
    for (int i = 0; i < 4; ++i) {
      v[i] = ldf4(xr + i * 256 + lane * 4);
      ss += v[i][0] * v[i][0] + v[i][1] * v[i][1] + v[i][2] * v[i][2] + v[i][3] * v[i][3];
    }
#pragma unroll
    for (int o = 1; o < 64; o <<= 1) ss += __shfl_xor(ss, o);
    const float rstd = rsqrtf(ss * (1.f / DM) + EPS);
    f4v gg[4], shh[4], scc[4];
#pragma unroll
    for (int i = 0; i < 4; ++i) {
      const int c0 = i * 256 + lane * 4;
      gg[i] = ldf4(p.g_pre + c0);
      shh[i] = ldf4(ada + b * 3072 + c0);
      scc[i] = ldf4(ada + b * 3072 + 1024 + c0);
    }
    __builtin_amdgcn_sched_barrier(0);
#pragma unroll
    for (int i = 0; i < 4; ++i) {
      const int c0 = i * 256 + lane * 4;
      const f4v g = gg[i], sh = shh[i], sc = scc[i];
      float o0 = v[i][0] * rstd * g[0] * (1.f + sc[0]) + sh[0];
      float o1 = v[i][1] * rstd * g[1] * (1.f + sc[1]) + sh[1];
      float o2 = v[i][2] * rstd * g[2] * (1.f + sc[2]) + sh[2];
      float o3 = v[i][3] * rstd * g[3] * (1.f + sc[3]) + sh[3];
      st4bf(h + (size_t)r * DM + c0, o0, o1, o2, o3);
    }
  }
}

template <int MODE>
DI void phaseC(const Params& p, u16* smem) {
  const int lane = tidx() & 63, w = tidx() >> 6, wm = w >> 1, wn = w & 1, l15 = lane & 15, quad = lane >> 4;
  const u16* A = (const u16*)(p.ws + O_H);
  const u16* Bt = (const u16*)(p.ws + O_WIN);
  u16* P = (u16*)(p.ws + O_P);
  constexpr int NTN = LDP / 128;
  const int xcd = blockIdx.x & 7, lb = blockIdx.x >> 3, nlb = gridDim.x >> 3;
  bool pre = false;
  for (int t = lb;; t += nlb) {
    const int mi = (xcd & 3) * 4 + (t & 3);
    const int ni = 2 * (t >> 2) + (xcd >> 2);
    if (ni >= NTN) break;
    f4v acc[8][4];
#pragma unroll
    for (int i = 0; i < 8; ++i)
#pragma unroll
      for (int j = 0; j < 4; ++j) acc[i][j] = fz();
    gemm_big(acc, A, 1024, Bt, 1024, 1024, mi * 256, ni * 128, smem, pre);
    {
      const int t2 = t + nlb;
      const int ni2 = 2 * (t2 >> 2) + (xcd >> 2);
      pre = ni2 < NTN;
      if (pre) gemm_big_prefetch(A, 1024, Bt, 1024, ((xcd & 3) * 4 + (t2 & 3)) * 256, ni2 * 128, smem);
    }
    if (MODE != 0) { if (acc[0][0][0] + acc[7][3][3] != 12345.678f) continue; }
#pragma unroll
    for (int mt = 0; mt < 8; ++mt) {
      u16* prow = P + (size_t)(mi * 256 + wm * 128 + mt * 16 + l15) * LDP + ni * 128 + wn * 64;
      st8bf_pair(prow, acc[mt][0], acc[mt][1], quad);
      st8bf_pair(prow + 32, acc[mt][2], acc[mt][3], quad);
    }
  }
}

DI void conv_item(const Params& p, int it) {
  const int tid = tidx();
  const int cb = it % 12, tb = (it / 12) & 63, b = it / (12 * 64);
  const int ch0 = cb * 256 + 4 * (tid & 63);
  const int t0 = tb * 32 + 8 * (tid >> 6);
  const u16* P = (const u16*)(p.ws + O_P);
  u16* xc = (u16*)(p.ws + O_XC);
  u16* xcT = (u16*)(p.ws + O_XCT);
  const bool isx = ch0 < 2048, isxb = ch0 < 2560;
  u2v raw[11];
#pragma unroll
  for (int i = 0; i < 11; ++i) {
    const int t = t0 - 3 + i;
    const u2v z2 = {0u, 0u};
    raw[i] = (t >= 0) ? *reinterpret_cast<const u2v*>(P + (size_t)(b * SEQ + t) * LDP + C_XBC + ch0) : z2;
  }
  const int hd = ch0 >> 6;
  u16 dtr[8];
  if (isx) {
#pragma unroll
    for (int i = 0; i < 8; ++i) dtr[i] = P[(size_t)(b * SEQ + t0 + i) * LDP + C_DT + hd];
  }
  f4v wv[4];
#pragma unroll
  for (int k = 0; k < 4; ++k) wv[k] = ldf4(p.conv_w + k * 3072 + ch0);
  const f4v bias = ldf4(p.conv_b + ch0);
  float y[4][8];
#pragma unroll
  for (int i = 0; i < 8; ++i) {
    f4v a = bias;
#pragma unroll
    for (int k = 0; k < 4; ++k) {
      const u2v r = raw[i + k];
      a[0] += wv[k][0] * __uint_as_float(r[0] << 16);
      a[1] += wv[k][1] * __uint_as_float(r[0] & 0xffff0000u);
      a[2] += wv[k][2] * __uint_as_float(r[1] << 16);
      a[3] += wv[k][3] * __uint_as_float(r[1] & 0xffff0000u);
    }
#pragma unroll
    for (int c = 0; c < 4; ++c) y[c][i] = siluf_(a[c]);
    if (!isx) {
      u2v pk = {pk2(y[0][i], y[1][i]), pk2(y[2][i], y[3][i])};
      *reinterpret_cast<u2v*>(xc + (size_t)(b * SEQ + t0 + i) * 3072 + ch0) = pk;
    }
  }
  if (isxb) {
    if (isx) {
      const float db = p.dt_bias[hd];
#pragma unroll
      for (int i = 0; i < 8; ++i) {
        const float dtv = softplusf_(bf2f(dtr[i]) + db);
#pragma unroll
        for (int c = 0; c < 4; ++c) y[c][i] *= dtv;
      }
    }
    u16* d0 = xcT + ((size_t)b * 2560 + ch0) * TS + t0;
#pragma unroll
    for (int c = 0; c < 4; ++c) *reinterpret_cast<s8v*>(d0 + (size_t)c * TS) = pack8f(y[c]);
  }
}
DI void dt_item(const Params& p, int it, float* sm) {
  const int tid = tidx(), hd = tid & 31, seg = tid >> 5;
  const int c = it & 15, b = it >> 4;
  const u16* P = (const u16*)(p.ws + O_P);
  float* dtb = (float*)(p.ws + O_DT);
  float* acs = (float*)(p.ws + O_ACS);
  const float db = p.dt_bias[hd];
  const float a = -expf(p.a_log[hd]);
  const int tbase = c * 128 + seg * 16;
  float v[16], cs[16];
#pragma unroll
  for (int i = 0; i < 16; ++i) v[i] = bf2f(P[(size_t)(b * SEQ + tbase + i) * LDP + C_DT + hd]);
  float run = 0.f;
#pragma unroll
  for (int i = 0; i < 16; ++i) { v[i] = softplusf_(v[i] + db); run += v[i] * a; cs[i] = run; }
  sm[seg * 32 + hd] = run;
  __syncthreads();
  float off = 0.f;
#pragma unroll
  for (int s2 = 0; s2 < 8; ++s2) off += (s2 < seg) ? sm[s2 * 32 + hd] : 0.f;
  float* d0 = dtb + ((size_t)b * 32 + hd) * SEQ + tbase;
  float* d1 = acs + ((size_t)b * 32 + hd) * SEQ + tbase;
#pragma unroll
  for (int i = 0; i < 4; ++i) {
    f4v x0 = {v[4 * i], v[4 * i + 1], v[4 * i + 2], v[4 * i + 3]};
    f4v x1 = {cs[4 * i] + off, cs[4 * i + 1] + off, cs[4 * i + 2] + off, cs[4 * i + 3] + off};
    *reinterpret_cast<f4v*>(d0 + 4 * i) = x0;
    *reinterpret_cast<f4v*>(d1 + 4 * i) = x1;
  }
  __syncthreads();
}
DI void vtr_item(const Params& p, int it) {
  const int tid = tidx();
  const int tb = it & 31, g = (it >> 5) & 3, b = (it >> 7) % NBG, kind = it / (128 * NBG);
  const u16* P = (const u16*)(p.ws + O_P);
  u16* dst = (u16*)(p.ws + (kind ? O_VWT : O_VST));
  const int d = tid & 63, tq = tid >> 6;
  const int t0 = tb * 64 + tq * 16;
  const int col = (kind ? C_VW : C_VS) + g * 64 + d;
  s8v v0, v1;
#pragma unroll
  for (int i = 0; i < 8; ++i) {
    v0[i] = (short)P[(size_t)(b * SEQ + t0 + i) * LDP + col];
    v1[i] = (short)P[(size_t)(b * SEQ + t0 + 8 + i) * LDP + col];
  }
  u16* o = dst + (((size_t)b * 4 + g) * 64 + d) * TS + t0;
  *reinterpret_cast<s8v*>(o) = v0;
  *reinterpret_cast<s8v*>(o + 8) = v1;
}
DI void cmp_item(const Params& p, int it, u16* sm) {
  const int tid = tidx(), lane = tid & 63, w = tid >> 6, l15 = lane & 15, quad = lane >> 4;
  const int jt = it & 7, g = (it >> 3) & 3, b = (it >> 5) % NBG, kind = it / (32 * NBG);
  const u16* P = (const u16*)(p.ws + O_P);
  const u16* W1 = (const u16*)(p.ws + (kind ? O_W1V : O_W1K));
  const u16* W2 = (const u16*)(p.ws + (kind ? O_W2V : O_W2K));
  const float* posb = (const float*)(p.ws + O_POSB) + kind * 256;
  const int col0 = (kind ? C_VC : C_KC) + g * 64;
  const int j = jt * 16 + l15;
  const bool rv = j < 127;
  const u16* arow = P + (size_t)(b * SEQ + (rv ? j : 0) * 16) * LDP + col0 + quad * 8;
  f4v hid[16];
#pragma unroll
  for (int nt = 0; nt < 16; ++nt) hid[nt] = fz();
  s8v zero8 = {0, 0, 0, 0, 0, 0, 0, 0};
#define CMP_LOAD(AF, BW, K2R)                                                                        \
  do {                                                                                               \
    const int _kk = 16 * w + (((K2R) + it) & 15);                        \
    const int _l = _kk >> 1, _d0 = (_kk & 1) * 32;                                                    \
    AF = rv ? ld8(arow + (size_t)_l * LDP + _d0) : zero8;                                             \
    const u16* _wb = W1 + (size_t)l15 * 2048 + _kk * 32 + quad * 8;                                   \
    _Pragma("unroll") for (int nt = 0; nt < 16; ++nt) BW[nt] = ld8(_wb + (size_t)nt * 16 * 2048);    \
  } while (0)
#define CMP_MMA(AF, BW)                                                                              \
  do {                                                                                               \
    _Pragma("unroll") for (int nt = 0; nt < 16; ++nt) hid[nt] = MFMA16(AF, BW[nt], hid[nt]);         \
  } while (0)
  {
    s8v a0, a1, b0[16], b1[16];
    CMP_LOAD(a0, b0, 0);
#pragma unroll 1
    for (int k2r = 0; k2r < 16; k2r += 2) {
      CMP_LOAD(a1, b1, k2r + 1);
      __builtin_amdgcn_sched_barrier(0);
      CMP_MMA(a0, b0);
      __builtin_amdgcn_sched_barrier(0);
      CMP_LOAD(a0, b0, k2r + 2);
      __builtin_amdgcn_sched_barrier(0);
      CMP_MMA(a1, b1);
      __builtin_amdgcn_sched_barrier(0);
    }
  }
#undef CMP_LOAD
#undef CMP_MMA
  float* red = reinterpret_cast<float*>(sm);
#pragma unroll
  for (int nt = 0; nt < 16; ++nt)
#pragma unroll
    for (int i = 0; i < 4; ++i) red[(w * 16 + quad * 4 + i) * 260 + nt * 16 + l15] = hid[nt][i];
  __syncthreads();
  u16 hb[16];
  {
    const float pb = posb[tid];
#pragma unroll
    for (int r = 0; r < 16; ++r) {
      const float v = red[r * 260 + tid] + red[(16 + r) * 260 + tid] + red[(32 + r) * 260 + tid] + red[(48 + r) * 260 + tid] + pb;
      hb[r] = f2bf(siluf_(v));
    }
  }
  __syncthreads();
  constexpr int HS = 264;
#pragma unroll
  for (int r = 0; r < 16; ++r) sm[r * HS + tid] = hb[r];
  __syncthreads();
  f4v res = fz();
#pragma unroll
  for (int ks = 0; ks < 8; ++ks) {
    const s8v a = ld8(sm + l15 * HS + ks * 32 + quad * 8);
    const s8v bw = ld8(W2 + (size_t)(w * 16 + l15) * 256 + ks * 32 + quad * 8);
    res = MFMA16(a, bw, res);
  }
  const int d = w * 16 + l15;
  const int jb = jt * 16 + quad * 4;
  if (kind == 0) {
    u16* kc = (u16*)(p.ws + O_KCMP) + ((size_t)(b * 4 + g) * 128) * 64;
#pragma unroll
    for (int i = 0; i < 4; ++i) kc[(size_t)(jb + i) * 64 + d] = (jb + i < 127) ? f2bf(res[i]) : (u16)0;
  } else {
    u16* vc = (u16*)(p.ws + O_VCT) + ((size_t)(b * 4 + g) * 64 + d) * 128 + jb;
    st4bf(vc, res[0], res[1], res[2], (jb + 3 < 127) ? res[3] : 0.f);
  }
  __syncthreads();
}

DI int q_next(unsigned* ctr) {
  __shared__ int q_slot;
  if (tidx() == 0) q_slot = (int)atomicAdd(ctr, 1u);
  __syncthreads();
  const int it = q_slot;
  __syncthreads();
  return it;
}
DI unsigned* q_counter(const Params& p, int pass, int phase, int rep) {
  return (unsigned*)(p.ws + O_BAR) + 3520 + 8 * (((pass * 4 + phase) * 2) + rep);
}

DI void phaseD(const Params& p, u16* smem, int sub, int pass, int rep) {
  constexpr int N_CMP = 2 * NBG * 32, N_CONV = NBG * 128 * 6, N_VTR = 2 * NBG * 128, N_DT = NBG * 16;
  constexpr int E1 = N_CONV, E2 = E1 + N_VTR, E3 = E2 + N_DT;
  const int ncb = ((int)gridDim.x >= 2 * N_CMP) ? N_CMP : 0;
  constexpr int TAIL = 320;
  int lo, hi, start, step;
  if (ncb == 0) {
    for (int it = blockIdx.x; it < N_CMP; it += gridDim.x)
      if (sub == 0 || sub == 1) cmp_item(p, it, smem);
    lo = 0; hi = E3; start = blockIdx.x; step = gridDim.x;
  } else if ((int)blockIdx.x < ncb) {
    if (sub == 0 || sub == 1) cmp_item(p, blockIdx.x, smem);
    lo = E3 - TAIL; hi = E3; start = lo + blockIdx.x; step = ncb;
  } else {
    lo = 0; hi = E3 - TAIL; start = (int)blockIdx.x - ncb; step = (int)gridDim.x - ncb;
  }
  for (int it = start; it < hi; it += step) {
    if (it < E1) { if (sub == 0 || sub == 2) conv_item(p, it); }
    else if (it < E2) { if (sub == 0 || sub == 3) vtr_item(p, it - E1); }
    else { if (sub == 0 || sub == 3) dt_item(p, it - E2, (float*)smem); }
  }
}

DI void ssd_item(const Params& p, int it, u16* sm) {
  const int tid = tidx(), lane = tid & 63, w = tid >> 6, l15 = lane & 15, quad = lane >> 4;
  const int qr = it & 3, g = (it >> 2) & 3, c = (it >> 4) & 15, b = it >> 8;
  const int t0 = c * 128;
  const u16* xc = (const u16*)(p.ws + O_XC);
  const u16* xcT = (const u16*)(p.ws + O_XCT);
  const float* acsb = (const float*)(p.ws + O_ACS);
  const float* dtb = (const float*)(p.ws + O_DT);
  u16* yd = (u16*)(p.ws + O_YD);
  u16* stb = (u16*)(p.ws + O_ST);
  const u16* Bbase = xc + (size_t)(b * SEQ + t0) * 3072 + 2048 + g * 128;
  const u16* Cbase = xc + (size_t)(b * SEQ + t0) * 3072 + 2560 + g * 128;
  const u16* BT = xcT + ((size_t)b * 2560 + 2048 + g * 128) * TS + t0;
  const int h0 = g * 8 + qr * 2;
  constexpr int LS = 136;
  u16* Bs = sm;
  u16* Xs = sm + 128 * LS;
  float* As = reinterpret_cast<float*>(sm + 256 * LS);
  {
    s8v rb[8], rx[8];
#pragma unroll
    for (int r = 0; r < 8; ++r) {
      const int idx = tid + 256 * r, row = idx >> 4, seg = idx & 15;
      rb[r] = ld8(Bbase + (size_t)row * 3072 + seg * 8);
      rx[r] = ld8(xcT + ((size_t)b * 2560 + h0 * 64 + row) * TS + t0 + seg * 8);
    }
#pragma unroll
    for (int r = 0; r < 8; ++r) {
      const int idx = tid + 256 * r, row = idx >> 4, seg = idx & 15;
      *reinterpret_cast<s8v*>(Bs + row * LS + seg * 8) = rb[r];
      *reinterpret_cast<s8v*>(Xs + row * LS + seg * 8) = rx[r];
    }
    As[tid] = acsb[((size_t)b * 32 + h0 + (tid >> 7)) * SEQ + t0 + (tid & 127)];
  }
  __syncthreads();

#pragma unroll 1
  for (int li = 0; li < 2; ++li) {
    const int lt = li ? 7 - w : w;
    const int l = 16 * lt + l15;
    s8v cf[4];
#pragma unroll
    for (int ks = 0; ks < 4; ++ks) cf[ks] = ld8(Cbase + (size_t)l * 3072 + ks * 32 + quad * 8);
    f4v y[2][4];
#pragma unroll
    for (int hh = 0; hh < 2; ++hh)
#pragma unroll
      for (int pt = 0; pt < 4; ++pt) y[hh][pt] = fz();
    float acl[2];
#pragma unroll
    for (int hh = 0; hh < 2; ++hh) acl[hh] = As[hh * 128 + l];
    const int spn = lt >> 1;
    for (int sp = 0; sp <= spn; ++sp) {
      f4v cb[2];
#pragma unroll
      for (int si = 0; si < 2; ++si) {
        cb[si] = fz();
#pragma unroll
        for (int ks = 0; ks < 4; ++ks)
          cb[si] = MFMA16(ld8(Bs + (32 * sp + 16 * si + l15) * LS + ks * 32 + quad * 8), cf[ks], cb[si]);
      }
#pragma unroll
      for (int hh = 0; hh < 2; ++hh) {
        const float* ah = As + hh * 128;
        const f4v as0 = ldf4(ah + 32 * sp + quad * 4);
        const f4v as1 = ldf4(ah + 32 * sp + 16 + quad * 4);
        f4v m0, m1;
#pragma unroll
        for (int i = 0; i < 4; ++i) {
          const int s0 = 32 * sp + quad * 4 + i, s1 = s0 + 16;
          m0[i] = (s0 <= l) ? cb[0][i] * __expf(acl[hh] - as0[i]) : 0.f;
          m1[i] = (s1 <= l) ? cb[1][i] * __expf(acl[hh] - as1[i]) : 0.f;
        }
        const s8v pb = pack8(m0, m1);
#pragma unroll
        for (int pt = 0; pt < 4; ++pt) {
          const u16* xr = Xs + (hh * 64 + 16 * pt + l15) * LS + 32 * sp + quad * 4;
          y[hh][pt] = MFMA16(cat44(ld4(xr), ld4(xr + 16)), pb, y[hh][pt]);
        }
      }
    }
#pragma unroll
    for (int hh = 0; hh < 2; ++hh) {
      const float dinv = p.d_skip[h0 + hh] / dtb[((size_t)b * 32 + h0 + hh) * SEQ + t0 + l];
#pragma unroll
      for (int pt = 0; pt < 4; ++pt) {
#pragma unroll
        for (int i = 0; i < 4; ++i) y[hh][pt][i] += dinv * bf2f(Xs[(hh * 64 + 16 * pt + 4 * quad + i) * LS + l]);
      }
      u16* yrow = yd + (size_t)(b * SEQ + t0 + l) * 2048 + (h0 + hh) * 64;
      st8bf_pair(yrow, y[hh][0], y[hh][1], quad);
      st8bf_pair(yrow + 32, y[hh][2], y[hh][3], quad);
    }
  }
#pragma unroll 1
  for (int hh = 0; hh < 2; ++hh) {
    const int hd = h0 + hh;
    const float* ah = As + hh * 128;
    const float alast = ah[127];
    f4v st[2][4];
#pragma unroll
    for (int ni = 0; ni < 2; ++ni)
#pragma unroll
      for (int pt = 0; pt < 4; ++pt) st[ni][pt] = fz();
    s8v bt[4][2];
#pragma unroll
    for (int ks = 0; ks < 4; ++ks)
#pragma unroll
      for (int ni = 0; ni < 2; ++ni) bt[ks][ni] = ld8(BT + (size_t)(16 * (2 * w + ni) + l15) * TS + ks * 32 + quad * 8);
    __builtin_amdgcn_sched_barrier(0);
#pragma unroll
    for (int ks = 0; ks < 4; ++ks) {
      const f4v a0 = ldf4(ah + ks * 32 + quad * 8), a1 = ldf4(ah + ks * 32 + quad * 8 + 4);
      float wl[8];
#pragma unroll
      for (int j = 0; j < 4; ++j) { wl[j] = __expf(alast - a0[j]); wl[4 + j] = __expf(alast - a1[j]); }
#pragma unroll
      for (int pt = 0; pt < 4; ++pt) {
        const s8v raw = ld8(Xs + (hh * 64 + 16 * pt + l15) * LS + ks * 32 + quad * 8);
        float xf[8];
#pragma unroll
        for (int j = 0; j < 8; ++j) xf[j] = bfs(raw[j]) * wl[j];
        const s8v xw = pack8f(xf);
        st[0][pt] = MFMA16(bt[ks][0], xw, st[0][pt]);
        st[1][pt] = MFMA16(bt[ks][1], xw, st[1][pt]);
      }
    }
    u16* so = stb + (((size_t)(b * 16 + c) * 32 + hd) * 64) * 128;
#pragma unroll
    for (int pt = 0; pt < 4; ++pt) st8bf_pair(so + (size_t)(16 * pt + l15) * 128 + 32 * w, st[0][pt], st[1][pt], quad);
  }
  __syncthreads();
}

DI void cmpattn_item(const Params& p, int it, unsigned char* smraw) {
  const int tid = tidx(), lane = tid & 63, w = tid >> 6, l15 = lane & 15, quad = lane >> 4;
  const int tq2 = it & 63, g = (it >> 6) & 3, b = it >> 8;
  const int H = g * 4 + w;
  const float slope = exp2f(-0.5f * (float)(H + 1));
  const u16* P = (const u16*)(p.ws + O_P);
  const u16* kcg = (const u16*)(p.ws + O_KCMP) + (size_t)(b * 4 + g) * 128 * 64;
  const u16* vcg = (const u16*)(p.ws + O_VCT) + (size_t)(b * 4 + g) * 64 * 128;
  constexpr int KS = 72, VS = 136;
  u16* kcs = reinterpret_cast<u16*>(smraw);
  u16* vcs = kcs + 128 * KS;
  float* impA = reinterpret_cast<float*>(smraw + 36864);
  float* impB = impA + 2048;
  float* scl = impB + 2112;
  {
    s8v r0[4], r1[4];
#pragma unroll
    for (int r = 0; r < 4; ++r) {
      const int idx = tid + 256 * r;
      r0[r] = ld8(kcg + (size_t)(idx >> 3) * 64 + (idx & 7) * 8);
      r1[r] = ld8(vcg + (size_t)(idx >> 4) * 128 + (idx & 15) * 8);
    }
#pragma unroll
    for (int r = 0; r < 4; ++r) {
      const int idx = tid + 256 * r;
      *reinterpret_cast<s8v*>(kcs + (idx >> 3) * KS + (idx & 7) * 8) = r0[r];
      *reinterpret_cast<s8v*>(vcs + (idx >> 4) * VS + (idx & 15) * 8) = r1[r];
    }
  }
  __syncthreads();
#pragma unroll 1
  for (int sub = 0; sub < 2; ++sub) {
    const int q0 = tq2 * 32 + sub * 16;
    const int njt = (q0 >= 16) ? (((q0 - 16) >> 8) + 1) : 0;
    const int t = q0 + l15;
    const size_t trow = (size_t)(b * SEQ + t);
    s8v qf[2];
    qf[0] = ld8(P + trow * LDP + C_Q + H * 64 + quad * 8);
    qf[1] = ld8(P + trow * LDP + C_Q + H * 64 + 32 + quad * 8);
    f4v s[8];
#pragma unroll
    for (int jt = 0; jt < 8; ++jt) {
      s[jt] = fz();
      if (jt < njt) {
#pragma unroll
        for (int ks = 0; ks < 2; ++ks) s[jt] = MFMA16(ld8(kcs + (16 * jt + l15) * KS + ks * 32 + quad * 8), qf[ks], s[jt]);
      }
    }
    float mx = NEGB;
#pragma unroll
    for (int jt = 0; jt < 8; ++jt)
#pragma unroll
      for (int i = 0; i < 4; ++i) {
        const int j = 16 * jt + 4 * quad + i;
        const int dist = t - (16 * j + 31);
        const float sc = (dist >= 0) ? s[jt][i] * 0.125f - slope * (float)dist : NEGB;
        s[jt][i] = sc;
        mx = fmaxf(mx, sc);
      }
    mx = qmax(mx);
    float lsum = 0.f;
#pragma unroll
    for (int jt = 0; jt < 8; ++jt)
#pragma unroll
      for (int i = 0; i < 4; ++i) {
        const float e = (s[jt][i] > -1e29f) ? __expf(s[jt][i] - mx) : 0.f;
        s[jt][i] = e;
        lsum += e;
      }
    lsum = qsum(lsum);
    const float inv = lsum > 0.f ? 1.f / lsum : 0.f;
#pragma unroll
    for (int jt = 0; jt < 8; ++jt) {
      s[jt] = s[jt] * inv;
      const int k = 4 * jt + quad;
      impA[(w * 16 + l15) * 32 + k] = s[jt][0] + s[jt][1] + s[jt][2] + 0.5f * s[jt][3];
      impB[(w * 16 + l15) * 33 + k + 1] = 0.5f * s[jt][3];
    }
    f4v oc[4];
#pragma unroll
    for (int dt = 0; dt < 4; ++dt) oc[dt] = fz();
#pragma unroll
    for (int kp = 0; kp < 4; ++kp) {
      if (2 * kp < njt) {
        const s8v pb = pack8(s[2 * kp], s[2 * kp + 1]);
#pragma unroll
        for (int dt = 0; dt < 4; ++dt) {
          const u16* vr = vcs + (16 * dt + l15) * VS + 32 * kp + quad * 4;
          oc[dt] = MFMA16(cat44(ld4(vr), ld4(vr + 16)), pb, oc[dt]);
        }
      }
    }
    {
      const float g0 = sigmoidf_(bf2f(P[trow * LDP + C_G + H * 3 + 0]));
      u16* oo = (u16*)(p.ws + O_OCMP) + trow * 1024 + H * 64 + quad * 4;
#pragma unroll
      for (int dt = 0; dt < 4; ++dt) st4bf(oo + 16 * dt, oc[dt][0] * g0, oc[dt][1] * g0, oc[dt][2] * g0, oc[dt][3] * g0);
    }
    __syncthreads();
#pragma unroll
    for (int r = 0; r < 2; ++r) {
      const int idx = tid + 256 * r, q = idx >> 5, k = idx & 31;
      float im = 0.f;
#pragma unroll
      for (int hh = 0; hh < 4; ++hh) {
        im += impA[(hh * 16 + q) * 32 + k];
        if (k > 0) im += impB[(hh * 16 + q) * 33 + k];
      }
      const int blk = (q0 + q) >> 6;
      const bool forced = (k == 0) | (k == blk) | (k == blk - 1);
      scl[q * 32 + k] = forced ? im + 1000.f : ((k <= blk) ? im : -1.f);
    }
    __syncthreads();
    unsigned* sel = (unsigned*)(p.ws + O_SEL) + (size_t)(b * 4 + g) * SEQ + q0;
#pragma unroll
    for (int r = 0; r < 2; ++r) {
      const int idx = tid + 256 * r, q = idx >> 5, k = idx & 31;
      const float me = scl[q * 32 + k];
      int cnt = 0;
#pragma unroll
      for (int k2 = 0; k2 < 32; ++k2) {
        const float o = scl[q * 32 + k2];
        cnt += (o > me || (o == me && k2 < k)) ? 1 : 0;
      }
      const unsigned long long bal = __ballot(cnt < 16);
      if (k == 0) sel[q] = (unsigned)(bal >> (32 * (lane >> 5)));
    }
    __syncthreads();
  }
}

DI void phaseE(const Params& p, float* smf, int sub, int pass, int rep) {
  constexpr int N_SSD = NBG * 256;
  for (int it = blockIdx.x; it < N_SSD; it += gridDim.x) ssd_item(p, it, (u16*)smf);
}

DI void scan_item(const Params& p, int it) {
  const int gid = it * 256 + tidx();
  const int e = gid & 1023, hd = (gid >> 10) & 31, b = gid >> 15;
  u16* stb = (u16*)(p.ws + O_ST);
  const float* acs = (const float*)(p.ws + O_ACS) + ((size_t)b * 32 + hd) * SEQ;
  float carry[8];
#pragma unroll
  for (int j = 0; j < 8; ++j) carry[j] = 0.f;
  s8v sv[16];
  float dec[16];
#pragma unroll
  for (int c = 0; c < 16; ++c) {
    sv[c] = ld8(stb + (((size_t)(b * 16 + c) * 32 + hd) * 8192) + e * 8);
    dec[c] = acs[c * 128 + 127];
  }
#pragma unroll
  for (int c = 0; c < 16; ++c) {
    u16* ptr = stb + (((size_t)(b * 16 + c) * 32 + hd) * 8192) + e * 8;
    const float dc = __expf(dec[c]);
    const s8v pv = pack8f(carry);
#pragma unroll
    for (int j = 0; j < 8; ++j) carry[j] = carry[j] * dc + bfs(sv[c][j]);
    *reinterpret_cast<s8v*>(ptr) = pv;
  }
}

template <bool WIN, bool MASKED>
DI void attn_tile(const u16* Kt, const u16* Vt, const s8v (&qf)[2], const f4v (&cb)[4], int t, int kb, int q0, bool selb,
                  float slope2, float& m, float& l, f4v (&o)[4]) {
  const int lane = tidx() & 63, l15 = lane & 15, quad = lane >> 4;
  constexpr int LS = 72;
  const float bkb = slope2 * (float)(64 * kb - q0);
  f4v s[4];
#pragma unroll
  for (int kt = 0; kt < 4; ++kt) {
    s[kt] = cb[kt] + bkb;
    const u16* kr = Kt + (16 * kt + l15) * LS + quad * 8;
    s[kt] = MFMA16(ld8(kr), qf[0], s[kt]);
    s[kt] = MFMA16(ld8(kr + 32), qf[1], s[kt]);
  }
  if (MASKED) {
    const int dd0 = t - (64 * kb + 4 * quad);
#pragma unroll
    for (int kt = 0; kt < 4; ++kt)
#pragma unroll
      for (int i = 0; i < 4; ++i) {
        const int dd = dd0 - (16 * kt + i);
        const bool ok = WIN ? ((unsigned)dd < 512u) : (selb && dd >= 0);
        s[kt][i] = ok ? s[kt][i] : NEGB;
      }
  }
  float mx = fmaxf(fmaxf(fmaxf(s[0][0], s[0][1]), fmaxf(s[0][2], s[0][3])), fmaxf(fmaxf(s[1][0], s[1][1]), fmaxf(s[1][2], s[1][3])));
  mx = fmaxf(mx, fmaxf(fmaxf(fmaxf(s[2][0], s[2][1]), fmaxf(s[2][2], s[2][3])), fmaxf(fmaxf(s[3][0], s[3][1]), fmaxf(s[3][2], s[3][3]))));
  mx = qmax(mx);
  if (__ballot(mx > m) != 0ull) {
    const float mn = fmaxf(m, mx);
    const float alpha = __builtin_amdgcn_exp2f(m - mn);
    m = mn;
    l *= alpha;
#pragma unroll
    for (int dt = 0; dt < 4; ++dt) o[dt] = o[dt] * alpha;
  }
  float ps = 0.f;
#pragma unroll
  for (int kt = 0; kt < 4; ++kt)
#pragma unroll
    for (int i = 0; i < 4; ++i) {
      float e = __builtin_amdgcn_exp2f(s[kt][i] - m);
      if (MASKED) e = (s[kt][i] > -1e29f) ? e : 0.f;
      s[kt][i] = e;
      ps += e;
    }
  l += ps;
#pragma unroll
  for (int kp = 0; kp < 2; ++kp) {
    const s8v pb = pack8(s[2 * kp], s[2 * kp + 1]);
#pragma unroll
    for (int dt = 0; dt < 4; ++dt) {
      const u16* vr = Vt + (16 * dt + l15) * LS + 32 * kp + quad * 4;
      o[dt] = MFMA16(cat44(ld4(vr), ld4(vr + 16)), pb, o[dt]);
    }
  }
}

template <bool WIN, int AV>
DI void attn_pass(const u16* __restrict__ Kbase  , const u16* __restrict__ VT  ,
                  const s8v (&qf)[2], const f4v (&cb)[4], int t, int q0, unsigned mymask, float slope2, unsigned tiles, f4v (&o)[4],
                  float& lout, u16* sm) {
  const int tid = tidx();
  constexpr int LS = 72, TB = 64 * LS;
  const int lrow = tid >> 3, lseg = tid & 7;
  const int blk = q0 >> 6;
  float m = NEGB, l = 0.f;
#pragma unroll
  for (int dt = 0; dt < 4; ++dt) o[dt] = fz();
  const u16* kp0 = Kbase + (size_t)lrow * LDP + lseg * 8;
  const u16* vp0 = VT + (size_t)lrow * TS + lseg * 8;
#define AT_LOAD(RK, RV, KB)                                                            \
  do {                                                                                 \
    RK[0] = ld8(kp0 + (size_t)(64 * (KB)) * LDP);                                       \
    RK[1] = ld8(kp0 + (size_t)(64 * (KB) + 32) * LDP);                                  \
    RV[0] = ld8(vp0 + 64 * (KB));                                                       \
    RV[1] = ld8(vp0 + (size_t)32 * TS + 64 * (KB));                                    \
  } while (0)
#define AT_STORE(RK, RV, BUF)                                                          \
  do {                                                                                 \
    u16* _d = sm + (BUF) * 2 * TB + lrow * LS + lseg * 8;                               \
    *reinterpret_cast<s8v*>(_d) = RK[0];                                                \
    *reinterpret_cast<s8v*>(_d + 32 * LS) = RK[1];                                      \
    *reinterpret_cast<s8v*>(_d + TB) = RV[0];                                           \
    *reinterpret_cast<s8v*>(_d + TB + 32 * LS) = RV[1];                                 \
  } while (0)
#define AT_POPL() do { if (tl) { kbl = 31 - __builtin_clz(tl); tl &= ~(1u << kbl); } } while (0)
#define AT_STEP(RK, RV)                                                                                              \
  {                                                                                                                  \
    const int kb = 31 - __builtin_clz(tc);                                                                            \
    tc &= ~(1u << kb);                                                                                                \
    const u16* Kt = sm + cur * 2 * TB;                                                                                \
    const bool selb = WIN ? true : (((mymask >> kb) & 1u) != 0u);                                                     \
    const bool need = WIN ? ((kb == blk) || (64 * kb <= q0 - 497)) : ((kb == blk) || (__ballot(selb) != ~0ull));      \
    if (AV != 2) {                                                                                                    \
    if (need) attn_tile<WIN, true>(Kt, Kt + TB, qf, cb, t, kb, q0, selb, slope2, m, l, o);                            \
    else attn_tile<WIN, false>(Kt, Kt + TB, qf, cb, t, kb, q0, selb, slope2, m, l, o);                                \
    }                                                                                                                 \
    if (AV != 1) {                                                                                                    \
    if (tc) AT_STORE(RK, RV, cur ^ 1);                                                                                \
    AT_POPL();                                                                                                        \
    AT_LOAD(RK, RV, kbl);                                                                                             \
    }                                                                                                                 \
    __syncthreads();                                                                                                  \
    if (!tc) break;                                                                                                   \
    cur ^= 1;                                                                                                         \
  }
  unsigned tc = tiles, tl = tiles;
  s8v ak[2], av[2], bk[2], bv[2];
  int kbl = 0;
  AT_POPL();
  AT_LOAD(ak, av, kbl);
  AT_STORE(ak, av, 0);
  AT_POPL();
  AT_LOAD(ak, av, kbl);
  AT_POPL();
  AT_LOAD(bk, bv, kbl);
  __syncthreads();
  int cur = 0;
  while (true) {
    AT_STEP(ak, av)
    AT_STEP(bk, bv)
  }
#undef AT_LOAD
#undef AT_STORE
#undef AT_POPL
#undef AT_STEP
  lout = qsum(l);
}

DI void cmp_part(const Params& p, int b, int g, int q0, const s8v (&qf)[2], unsigned char* smraw, f4v (&oc)[4], unsigned& mymask) {
  const int tid = tidx(), lane = tid & 63, w = tid >> 6, l15 = lane & 15, quad = lane >> 4;
  const int H = g * 4 + w;
  const float slope = exp2f(-0.5f * (float)(H + 1));
  const u16* P = (const u16*)(p.ws + O_P);
  const u16* kcg = (const u16*)(p.ws + O_KCMP) + (size_t)(b * 4 + g) * 128 * 64;
  const u16* vcg = (const u16*)(p.ws + O_VCT) + (size_t)(b * 4 + g) * 64 * 128;
  constexpr int KS = 72, VS = 136;
  u16* kcs = reinterpret_cast<u16*>(smraw);
  u16* vcs = kcs + 128 * KS;
  float* impA = reinterpret_cast<float*>(smraw + 36864);
  float* impB = impA + 2048;
  float* scl = impB + 2112;
  unsigned* selm = reinterpret_cast<unsigned*>(scl + 512);
  const int njt = (q0 >= 16) ? (((q0 - 16) >> 8) + 1) : 0;
  {
    s8v r0[4], r1[4];
#pragma unroll
    for (int r = 0; r < 4; ++r) {
      const int idx = tid + 256 * r;
      r0[r] = ld8(kcg + (size_t)(idx >> 3) * 64 + (idx & 7) * 8);
      r1[r] = ld8(vcg + (size_t)(idx >> 4) * 128 + (idx & 15) * 8);
    }
#pragma unroll
    for (int r = 0; r < 4; ++r) {
      const int idx = tid + 256 * r;
      *reinterpret_cast<s8v*>(kcs + (idx >> 3) * KS + (idx & 7) * 8) = r0[r];
      *reinterpret_cast<s8v*>(vcs + (idx >> 4) * VS + (idx & 15) * 8) = r1[r];
    }
  }
  __syncthreads();
  const int t = q0 + l15;
  const size_t trow = (size_t)(b * SEQ + t);
  f4v s[8];
#pragma unroll
  for (int jt = 0; jt < 8; ++jt) {
    s[jt] = fz();
    if (jt < njt) {
#pragma unroll
      for (int ks = 0; ks < 2; ++ks) s[jt] = MFMA16(ld8(kcs + (16 * jt + l15) * KS + ks * 32 + quad * 8), qf[ks], s[jt]);
    }
  }
  float mx = NEGB;
#pragma unroll
  for (int jt = 0; jt < 8; ++jt)
#pragma unroll
    for (int i = 0; i < 4; ++i) {
      const int j = 16 * jt + 4 * quad + i;
      const int dist = t - (16 * j + 31);
      const float sc = (dist >= 0) ? s[jt][i] * 0.125f - slope * (float)dist : NEGB;
      s[jt][i] = sc;
      mx = fmaxf(mx, sc);
    }
  mx = qmax(mx);
  float lsum = 0.f;
#pragma unroll
  for (int jt = 0; jt < 8; ++jt)
#pragma unroll
    for (int i = 0; i < 4; ++i) {
      const float e = (s[jt][i] > -1e29f) ? __expf(s[jt][i] - mx) : 0.f;
      s[jt][i] = e;
      lsum += e;
    }
  lsum = qsum(lsum);
  const float inv = lsum > 0.f ? 1.f / lsum : 0.f;
#pragma unroll
  for (int jt = 0; jt < 8; ++jt) {
    s[jt] = s[jt] * inv;
    const int k = 4 * jt + quad;
    impA[(w * 16 + l15) * 32 + k] = s[jt][0] + s[jt][1] + s[jt][2] + 0.5f * s[jt][3];
    impB[(w * 16 + l15) * 33 + k + 1] = 0.5f * s[jt][3];
  }
#pragma unroll
  for (int dt = 0; dt < 4; ++dt) oc[dt] = fz();
#pragma unroll
  for (int kp = 0; kp < 4; ++kp) {
    if (2 * kp < njt) {
      const s8v pb = pack8(s[2 * kp], s[2 * kp + 1]);
#pragma unroll
      for (int dt = 0; dt < 4; ++dt) {
        const u16* vr = vcs + (16 * dt + l15) * VS + 32 * kp + quad * 4;
        oc[dt] = MFMA16(cat44(ld4(vr), ld4(vr + 16)), pb, oc[dt]);
      }
    }
  }
  {
    const float g0 = sigmoidf_(bf2f(P[trow * LDP + C_G + H * 3 + 0]));
#pragma unroll
    for (int dt = 0; dt < 4; ++dt) oc[dt] = oc[dt] * g0;
  }
  __syncthreads();
#pragma unroll
  for (int r = 0; r < 2; ++r) {
    const int idx = tid + 256 * r, q = idx >> 5, k = idx & 31;
    float im = 0.f;
#pragma unroll
    for (int hh = 0; hh < 4; ++hh) {
      im += impA[(hh * 16 + q) * 32 + k];
      if (k > 0) im += impB[(hh * 16 + q) * 33 + k];
    }
    const int blk = (q0 + q) >> 6;
    const bool forced = (k == 0) | (k == blk) | (k == blk - 1);
    scl[q * 32 + k] = forced ? im + 1000.f : ((k <= blk) ? im : -1.f);
  }
  __syncthreads();
#pragma unroll
  for (int r = 0; r < 2; ++r) {
    const int idx = tid + 256 * r, q = idx >> 5, k = idx & 31;
    const float me = scl[q * 32 + k];
    int cnt = 0;
#pragma unroll
    for (int k2 = 0; k2 < 32; ++k2) {
      const float o = scl[q * 32 + k2];
      cnt += (o > me || (o == me && k2 < k)) ? 1 : 0;
    }
    const unsigned long long bal = __ballot(cnt < 16);
    if (k == 0) selm[q] = (unsigned)(bal >> (32 * (lane >> 5)));
  }
  __syncthreads();
  mymask = selm[l15];
  __syncthreads();
}

template <int AV>
DI void attn_item(const Params& p, int it, u16* sm) {
  const int tid = tidx(), lane = tid & 63, w = tid >> 6, l15 = lane & 15, quad = lane >> 4;
  const int tq = it & 127, g = (it >> 7) & 3, b = it >> 9;
  const int q0 = tq * 16;
  const int H = g * 4 + w;
  const float slope2 = exp2f(-0.5f * (float)(H + 1)) * 1.4426950408889634f;
  constexpr float SCALE2 = 0.125f * 1.4426950408889634f;
  const u16* P = (const u16*)(p.ws + O_P);
  const int t = q0 + l15;
  const size_t trow = (size_t)(b * SEQ + t);
  s8v qf[2], qraw[2];
#pragma unroll
  for (int ks = 0; ks < 2; ++ks) {
    const s8v raw = ld8(P + trow * LDP + C_Q + H * 64 + ks * 32 + quad * 8);
    qraw[ks] = raw;
    float qs[8];
#pragma unroll
    for (int j = 0; j < 8; ++j) qs[j] = bfs(raw[j]) * SCALE2;
    qf[ks] = pack8f(qs);
  }
  f4v ocm[4];
  unsigned mymask;
  cmp_part(p, b, g, q0, qraw, reinterpret_cast<unsigned char*>(sm), ocm, mymask);
  f4v cb[4];
#pragma unroll
  for (int kt = 0; kt < 4; ++kt)
#pragma unroll
    for (int i = 0; i < 4; ++i) cb[kt][i] = slope2 * (float)(16 * kt + 4 * quad + i);
  const int blk = q0 >> 6;
  const unsigned upto = (blk >= 31) ? 0xffffffffu : ((2u << blk) - 1u);
  unsigned um = mymask;
#pragma unroll
  for (int o = 1; o < 64; o <<= 1) um |= (unsigned)__shfl_xor((int)um, o);
  um = (unsigned)__builtin_amdgcn_readfirstlane((int)(um & upto));
  f4v os[4], ow[4];
  float ls, lw;
  attn_pass<false, AV>(P + (size_t)(b * SEQ) * LDP + C_KS + g * 64, (const u16*)(p.ws + O_VST) + (size_t)(b * 4 + g) * 64 * TS, qf, cb, t,
                   q0, mymask, slope2, um, os, ls, sm);
  const int wlo = (q0 - 511 > 0 ? q0 - 511 : 0) >> 6;
  const unsigned wm_ = (unsigned)__builtin_amdgcn_readfirstlane((int)(upto & ~((1u << wlo) - 1u)));
  attn_pass<true, AV>(P + (size_t)(b * SEQ) * LDP + C_KW + g * 64, (const u16*)(p.ws + O_VWT) + (size_t)(b * 4 + g) * 64 * TS, qf, cb, t,
                  q0, 0u, slope2, wm_, ow, lw, sm);
  if (AV != 0) { if (ls + lw + os[0][0] + ow[3][3] != 12345.678f) return; }
  const float g1 = sigmoidf_(bf2f(P[trow * LDP + C_G + H * 3 + 1])) / ls;
  const float g2 = sigmoidf_(bf2f(P[trow * LDP + C_G + H * 3 + 2])) / lw;
  const u16* za = P + trow * LDP + C_ZA + H * 64;
  u16* oo = (u16*)(p.ws + O_O) + trow * 1024 + H * 64;
  f4v rr[4];
  s4v zq[4];
  ld8bf_pair(za, quad, zq[0], zq[1]);
  ld8bf_pair(za + 32, quad, zq[2], zq[3]);
#pragma unroll
  for (int dt = 0; dt < 4; ++dt) {
#pragma unroll
    for (int i = 0; i < 4; ++i) rr[dt][i] = (ocm[dt][i] + g1 * os[dt][i] + g2 * ow[dt][i]) * siluf_(bfs(zq[dt][i]));
  }
  st8bf_pair(oo, rr[0], rr[1], quad);
  st8bf_pair(oo + 32, rr[2], rr[3], quad);
}

DI void phaseF(const Params& p, bool noscan, u16* sm, int pass, int rep) {
  constexpr int N_AT = NBG * 512, N_SC = NBG * 32 * 1024 / 256;
  unsigned* ctr = q_counter(p, pass, 2, rep);
  const int nend = noscan ? N_AT : N_AT + N_SC;
  bool first = true;
  while (true) {
    const int it = first ? (int)blockIdx.x : q_next(ctr) + (int)gridDim.x;
    first = false;
    if (it >= nend) break;
    if (it < N_AT) {
      const int tq = 127 - (it >> 3), gb = it & 7;
      if (APROBE != 0 && rep) attn_item<APROBE>(p, (gb >> 2) * 512 + (gb & 3) * 128 + tq, sm);
      else attn_item<0>(p, (gb >> 2) * 512 + (gb & 3) * 128 + tq, sm);
    } else scan_item(p, it - N_AT);
  }
}

DI void phaseG(const Params& p, float* smf) {
  const int tid = tidx(), lane = tid & 63, w = tid >> 6, l15 = lane & 15, quad = lane >> 4;
  const u16* xc = (const u16*)(p.ws + O_XC);
  const u16* P = (const u16*)(p.ws + O_P);
  const u16* yd = (const u16*)(p.ws + O_YD);
  const u16* stb = (const u16*)(p.ws + O_ST);
  const float* acsb = (const float*)(p.ws + O_ACS);
  u16* yn = (u16*)(p.ws + O_YN);
  for (int it = blockIdx.x; it < NBG * 256; it += gridDim.x) {
    const int lq = it & 3, g = (it >> 2) & 3, c = (it >> 4) & 15, b = it >> 8;
    const int t0 = b * SEQ + c * 128 + 32 * lq + l15;
    s8v cf[2][4];
#pragma unroll
    for (int li = 0; li < 2; ++li)
#pragma unroll
      for (int ks = 0; ks < 4; ++ks) cf[li][ks] = ld8(xc + (size_t)(t0 + 16 * li) * 3072 + 2560 + g * 128 + ks * 32 + quad * 8);
    f4v y[2][4][2];
    f4v* park = reinterpret_cast<f4v*>(smf + 1024);
    float ss[2] = {0.f, 0.f};
#pragma unroll
    for (int hh = 0; hh < 2; ++hh) {
      const int hd = g * 8 + 2 * w + hh;
      const u16* pv = stb + (((size_t)(b * 16 + c) * 32 + hd) * 64) * 128;
      s8v pf[4][4];
      s4v d4[4], z4[4];
#pragma unroll
      for (int pt = 0; pt < 4; ++pt) {
#pragma unroll
        for (int ks = 0; ks < 4; ++ks) pf[pt][ks] = ld8(pv + (size_t)(16 * pt + l15) * 128 + ks * 32 + quad * 8);
      }
#pragma unroll
      for (int pp = 0; pp < 2; ++pp) {
        ld8bf_pair(yd + (size_t)t0 * 2048 + hd * 64 + 32 * pp, quad, d4[2 * pp], d4[2 * pp + 1]);
        ld8bf_pair(P + (size_t)t0 * LDP + C_Z + hd * 64 + 32 * pp, quad, z4[2 * pp], z4[2 * pp + 1]);
      }
      float ea[2];
#pragma unroll
      for (int li = 0; li < 2; ++li) ea[li] = __expf(acsb[((size_t)b * 32 + hd) * SEQ + (t0 + 16 * li - b * SEQ)]);
      __builtin_amdgcn_sched_barrier(0);
#pragma unroll
      for (int pt = 0; pt < 4; ++pt) {
        y[hh][pt][0] = fz(); y[hh][pt][1] = fz();
#pragma unroll
        for (int ks = 0; ks < 4; ++ks) {
          y[hh][pt][0] = MFMA16(pf[pt][ks], cf[0][ks], y[hh][pt][0]);
          y[hh][pt][1] = MFMA16(pf[pt][ks], cf[1][ks], y[hh][pt][1]);
        }
      }
      __builtin_amdgcn_sched_barrier(0);
      s4v d5[4], z5[4];
#pragma unroll
      for (int pp = 0; pp < 2; ++pp) {
        ld8bf_pair(yd + (size_t)(t0 + 16) * 2048 + hd * 64 + 32 * pp, quad, d5[2 * pp], d5[2 * pp + 1]);
        ld8bf_pair(P + (size_t)(t0 + 16) * LDP + C_Z + hd * 64 + 32 * pp, quad, z5[2 * pp], z5[2 * pp + 1]);
      }
      __builtin_amdgcn_sched_barrier(0);
#pragma unroll
      for (int pt = 0; pt < 4; ++pt)
#pragma unroll
        for (int i = 0; i < 4; ++i) {
          const float v = (bfs(d4[pt][i]) + y[hh][pt][0][i] * ea[0]) * siluf_(bfs(z4[pt][i]));
          y[hh][pt][0][i] = v;
          ss[0] += v * v;
        }
      __builtin_amdgcn_sched_barrier(0);
#pragma unroll
      for (int pt = 0; pt < 4; ++pt)
#pragma unroll
        for (int i = 0; i < 4; ++i) {
          const float v = (bfs(d5[pt][i]) + y[hh][pt][1][i] * ea[1]) * siluf_(bfs(z5[pt][i]));
          y[hh][pt][1][i] = v;
          ss[1] += v * v;
        }
      if (hh == 0) {
#pragma unroll
        for (int pt = 0; pt < 4; ++pt) { park[(2 * pt) * 256 + tid] = y[0][pt][0]; park[(2 * pt + 1) * 256 + tid] = y[0][pt][1]; }
      }
    }
    ss[0] = qsum(ss[0]); ss[1] = qsum(ss[1]);
    if (quad == 0) { smf[w * 32 + l15] = ss[0]; smf[w * 32 + 16 + l15] = ss[1]; }
    f4v gnv[2][4];
#pragma unroll
    for (int hh = 0; hh < 2; ++hh)
#pragma unroll
      for (int pt = 0; pt < 4; ++pt) gnv[hh][pt] = ldf4(p.g_ssm_norm + (g * 8 + 2 * w + hh) * 64 + 16 * pt + quad * 4);
    __syncthreads();
    float rs[2];
#pragma unroll
    for (int li = 0; li < 2; ++li) {
      const float tot = smf[16 * li + l15] + smf[32 + 16 * li + l15] + smf[64 + 16 * li + l15] + smf[96 + 16 * li + l15];
      rs[li] = rsqrtf(tot * (1.f / 512.f) + EPS);
    }
#pragma unroll
    for (int hh = 0; hh < 2; ++hh) {
      const int hd = g * 8 + 2 * w + hh;
#pragma unroll
      for (int li = 0; li < 2; ++li) {
        f4v nv[4];
#pragma unroll
        for (int pt = 0; pt < 4; ++pt) {
          const f4v v = (hh == 0) ? park[(2 * pt + li) * 256 + tid] : y[1][pt][li];
          nv[pt] = v * gnv[hh][pt] * rs[li];
        }
        u16* nrow = yn + (size_t)(t0 + 16 * li) * 2048 + hd * 64;
        st8bf_pair(nrow, nv[0], nv[1], quad);
        st8bf_pair(nrow + 32, nv[2], nv[3], quad);
      }
    }
    __syncthreads();
  }
}

DI void phaseH(const Params& p, u16* smem) {
  const int lane = tidx() & 63, w = tidx() >> 6, wm = w >> 1, wn = w & 1, l15 = lane & 15, quad = lane >> 4;
  const u16* P = (const u16*)(p.ws + O_P);
  u16* mg = (u16*)(p.ws + O_H);
  float* tmp = (float*)(p.ws + O_YD);
  constexpr int MT = MP / 128;
  for (int it = blockIdx.x; it < MT * 16; it += gridDim.x) {
    const int mi = it % MT, ni = it / MT;
    f4v acc[4][2];
    u2v keep[4][2];
    zero_acc<2>(acc);
    gemm_k64(acc, (const u16*)(p.ws + O_YN), 2048, (const u16*)(p.ws + O_WSSM), 2048, 2048, mi * 128, ni * 64, smem);
    s4v gq[4][2];
#pragma unroll
    for (int mt = 0; mt < 4; ++mt)
      ld8bf_pair(P + (size_t)(mi * 128 + wm * 64 + mt * 16 + l15) * LDP + C_MG + ni * 64 + wn * 32, quad, gq[mt][0], gq[mt][1]);
    __builtin_amdgcn_sched_barrier(0);
#pragma unroll
    for (int mt = 0; mt < 4; ++mt)
#pragma unroll
      for (int nt = 0; nt < 2; ++nt) {
        const int m = mi * 128 + wm * 64 + mt * 16 + l15, n = ni * 64 + wn * 32 + nt * 16 + quad * 4;
        const s4v g0 = gq[mt][nt];
        f4v r;
#pragma unroll
        for (int i = 0; i < 4; ++i) r[i] = sigmoidf_(bfs(g0[i])) * acc[mt][nt][i];
        u2v kp = {pk2(r[0], r[1]), pk2(r[2], r[3])};
        keep[mt][nt] = kp;
      }
    zero_acc<2>(acc);
    gemm_k64(acc, (const u16*)(p.ws + O_O), 1024, (const u16*)(p.ws + O_WNSA), 1024, 1024, mi * 128, ni * 64, smem);
    f4v tq[4][2];
#pragma unroll
    for (int mt = 0; mt < 4; ++mt)
      ld8bf_pair(P + (size_t)(mi * 128 + wm * 64 + mt * 16 + l15) * LDP + C_MG + 1024 + ni * 64 + wn * 32, quad, gq[mt][0], gq[mt][1]);
#pragma unroll
    for (int mt = 0; mt < 4; ++mt)
#pragma unroll
      for (int nt = 0; nt < 2; ++nt) {
        const u2v kp = keep[mt][nt];
        f4v tv = {__uint_as_float(kp[0] << 16), __uint_as_float(kp[0] & 0xffff0000u), __uint_as_float(kp[1] << 16),
                  __uint_as_float(kp[1] & 0xffff0000u)};
        tq[mt][nt] = tv;
      }
    __builtin_amdgcn_sched_barrier(0);
#pragma unroll
    for (int mt = 0; mt < 4; ++mt) {
      f4v rr[2];
#pragma unroll
      for (int nt = 0; nt < 2; ++nt) {
        const s4v g1 = gq[mt][nt];
        const f4v t0 = tq[mt][nt];
#pragma unroll
        for (int i = 0; i < 4; ++i) rr[nt][i] = t0[i] + sigmoidf_(bfs(g1[i])) * acc[mt][nt][i];
      }
      st8bf_pair(mg + (size_t)(mi * 128 + wm * 64 + mt * 16 + l15) * 1024 + ni * 64 + wn * 32, rr[0], rr[1], quad);
    }
  }
}

DI void phaseI(const Params& p, u16* smem) {
  const int lane = tidx() & 63, w = tidx() >> 6, wm = w >> 1, wn = w & 1, l15 = lane & 15, quad = lane >> 4;
  u16* outb = (u16*)(p.ws + O_OUTF);
  float* rsq = (float*)(p.ws + O_RSQ);
  constexpr int MT = MP / 128;
  for (int it = blockIdx.x; it < MT * 16; it += gridDim.x) {
    const int mi = it % MT, ni = it / MT;
    f4v acc[4][2];
    zero_acc<2>(acc);
    gemm_k64(acc, (const u16*)(p.ws + O_H), 1024, (const u16*)(p.ws + O_WOUT), 1024, 1024, mi * 128, ni * 64, smem);
#pragma unroll
    for (int mt = 0; mt < 4; ++mt) {
      const int m = mi * 128 + wm * 64 + mt * 16 + l15;
      float ss = 0.f;
#pragma unroll
      for (int nt = 0; nt < 2; ++nt) {
        const f4v v = acc[mt][nt];
        ss += v[0] * v[0] + v[1] * v[1] + v[2] * v[2] + v[3] * v[3];
      }
      st8bf_pair(outb + (size_t)m * 1024 + ni * 64 + wn * 32, acc[mt][0], acc[mt][1], quad);
      ss = qsum(ss);
      if (quad == 0) rsq[(size_t)m * 32 + ni * 2 + wn] = ss;
    }
  }
}

DI void phaseJ(const Params& p, int pass) {
  const int tid = tidx(), lane = tid & 63, w = tid >> 6;
  const u16* outb = (const u16*)(p.ws + O_OUTF);
  const float* rsq = (const float*)(p.ws + O_RSQ);
  const float* ada = (const float*)(p.ws + O_ADA);
  for (int it = blockIdx.x; it < MP / 4; it += gridDim.x) {
    const int r = it * 4 + w;
    const int tg = pass * MP + r, b = tg >> 11;
    float part = (lane < 32) ? rsq[(size_t)r * 32 + lane] : 0.f;
    s4v ob[4];
    f4v xv[4], gp[4], gt[4];
#pragma unroll
    for (int i = 0; i < 4; ++i) {
      const int c0 = i * 256 + lane * 4;
      ob[i] = ld4(outb + (size_t)r * 1024 + c0);
      xv[i] = ldf4(p.x + (size_t)tg * 1024 + c0);
      gp[i] = ldf4(p.g_post + c0);
      gt[i] = ldf4(ada + b * 3072 + 2048 + c0);
    }
    __builtin_amdgcn_sched_barrier(0);
#pragma unroll
    for (int o = 1; o < 64; o <<= 1) part += __shfl_xor(part, o);
    const float rstd = rsqrtf(part * (1.f / 1024.f) + EPS);
#pragma unroll
    for (int i = 0; i < 4; ++i) {
      const int c0 = i * 256 + lane * 4;
      f4v rr;
#pragma unroll
      for (int k = 0; k < 4; ++k) rr[k] = xv[i][k] + gt[i][k] * (bfs(ob[i][k]) * rstd * gp[i][k]);
      *reinterpret_cast<f4v*>(p.out + (size_t)tg * 1024 + c0) = rr;
    }
  }
}

#define XB_TMO      128
#define XB_XCNT(j)  (256  + 64 * (j))
#define XB_XSUB(j)  (1280 + 64 * (j))
#define XB_XGEN(j)  (2304 + 64 * (j))
#define XB_TOP      3328
#define XB_TOPGEN   3392
#define XCD_BAR_WORDS 3456
#define XB_SPIN_CAP (1u << 18)
#define LAS __attribute__((address_space(3)))
DI unsigned xb_ld(unsigned* p)              { return __hip_atomic_load(p, __ATOMIC_RELAXED, __HIP_MEMORY_SCOPE_AGENT); }
DI unsigned xb_add(unsigned* p, unsigned v) { return __hip_atomic_fetch_add(p, v, __ATOMIC_RELAXED, __HIP_MEMORY_SCOPE_AGENT); }
DI unsigned xb_xcc_id() { return (unsigned)__builtin_amdgcn_s_getreg((3 << 11) | 20) & 0xFu; }
#define XB_SPIN(cond, bar) do { unsigned _sp = 0; while (cond) { __builtin_amdgcn_s_sleep(1); \
    if ((++_sp & 255u) == 0u) { if (xb_ld(&(bar)[XB_TMO])) break; if (_sp > XB_SPIN_CAP) { atomicAdd(&(bar)[XB_TMO], 1u); break; } } } } while (0)
struct XcdBarrier { unsigned* bar; unsigned x; volatile LAS unsigned* st; };
DI XcdBarrier xcd_barrier_post(unsigned* bar, volatile LAS unsigned* st) {
  XcdBarrier b; b.bar = bar; b.x = xb_xcc_id(); b.st = st;
  if (threadIdx.x == 0) (void)xb_add(&bar[XB_XCNT(b.x)], 1u);
  return b;
}
DI void xcd_barrier_complete(unsigned* bar, unsigned x, unsigned& nloc, unsigned& nx) {
  const unsigned G = gridDim.x * gridDim.y * gridDim.z;
  unsigned sum, cnt, mine, sp = 0u;
  for (;;) {
    sum = 0u; cnt = 0u; mine = 0u;
#pragma unroll
    for (unsigned j = 0; j < 16; ++j) { const unsigned c = xb_ld(&bar[XB_XCNT(j)]); sum += c; cnt += (c > 0u) ? 1u : 0u; mine = (j == x) ? c : mine; }
    if (sum == G) break;
    __builtin_amdgcn_s_sleep(1);
    if ((++sp & 255u) == 0u) { if (xb_ld(&bar[XB_TMO])) break; if (sp > XB_SPIN_CAP) { atomicAdd(&bar[XB_TMO], 1u); break; } }
  }
  nloc = mine > 0u ? mine : 1u; nx = cnt > 0u ? cnt : 1u;
}
DI void xcd_barrier(const XcdBarrier& b) {
  asm volatile("s_waitcnt vmcnt(0)" ::: "memory");
  __syncthreads();
  if (threadIdx.x == 0) {
    unsigned* bar = b.bar;
    __builtin_amdgcn_s_waitcnt(0);
    unsigned nloc = b.st[0], nx = b.st[1];
    if (nloc == 0u) { xcd_barrier_complete(bar, b.x, nloc, nx); b.st[0] = nloc; b.st[1] = nx; }
    const unsigned old = xb_add(&bar[XB_XSUB(b.x)], 1u);
    const unsigned gen = old / nloc;
    if (old + 1u == (gen + 1u) * nloc) {
      __builtin_amdgcn_fence(__ATOMIC_RELEASE, "agent");
      asm volatile("s_waitcnt vmcnt(0)" ::: "memory");
      const unsigned og = xb_add(&bar[XB_TOP], 1u);
      const unsigned tg = og / nx;
      if (og + 1u == (tg + 1u) * nx) xb_add(&bar[XB_TOPGEN], 1u);
      else XB_SPIN(xb_ld(&bar[XB_TOPGEN]) == tg, bar);
      __builtin_amdgcn_fence(__ATOMIC_ACQUIRE, "agent");
      xb_add(&bar[XB_XGEN(b.x)], 1u);
      asm volatile("s_waitcnt vmcnt(0)" ::: "memory");
    } else {
      XB_SPIN(xb_ld(&bar[XB_XGEN(b.x)]) == gen, bar);
      __builtin_amdgcn_fence(__ATOMIC_ACQUIRE, "agent");
      asm volatile("s_waitcnt vmcnt(0)" ::: "memory");
    }
  }
  __syncthreads();
}

constexpr int PH_PER_PASS = 8;
constexpr int N_PHASES = 2 + NPASS * PH_PER_PASS;

constexpr int REP_MASK = 0;
constexpr int REP_SUB = 0;
constexpr int REP_A = 0;
constexpr int CPROBE = 0;
__global__ void __launch_bounds__(256, 2) mega_kernel(Params p, int ph_lo, int ph_hi) {
  __shared__ __attribute__((aligned(16))) unsigned char smem[73728];
  __shared__ uint4 xb_words;
  cg::grid_group grid = cg::this_grid();
  if (threadIdx.x == 0) xb_words = make_uint4(0u, 0u, 0u, 0u);
  __syncthreads();
  const XcdBarrier xb = xcd_barrier_post((unsigned*)(p.ws + O_BAR), (volatile LAS unsigned*)&xb_words);
  for (int ph = ph_lo; ph < ph_hi; ++ph) {
    if (ph == 0) {
      phaseA(p, smem);
      if (REP_A) { xcd_barrier(xb); phaseA(p, smem); }
    } else if (ph == 1) {
      phaseB(p, 0);
    } else {
      const int pass = (ph - 2) / PH_PER_PASS, k = (ph - 2) % PH_PER_PASS;
      Params q = p;
      const int nrep = ((REP_MASK >> k) & 1) ? 2 : 1;
      for (int rep = 0; rep < nrep; ++rep) {
        if (rep) xcd_barrier(xb);
        if (rep && REP_SUB == 9) continue;
        switch (k) {
          case 0: if (REP_MASK != 0 && rep) phaseC<CPROBE>(q, (u16*)smem); else phaseC<0>(q, (u16*)smem); break;
          case 1: phaseD(q, (u16*)smem, rep ? REP_SUB : 0, pass, rep); break;
          case 2: phaseE(q, (float*)smem, rep ? REP_SUB : 0, pass, rep); break;
          case 3: phaseF(q, rep > 0, (u16*)smem, pass, rep); break;
          case 4: phaseG(q, (float*)smem); break;
          case 5: phaseH(q, (u16*)smem); break;
          case 6: phaseI(q, (u16*)smem); break;
          default:
            phaseJ(q, pass);
            if (pass + 1 < NPASS) phaseB(q, pass + 1);
            break;
        }
      }
    }
    if (ph + 1 < ph_hi) {
      if (ph_hi < 0) grid.sync();
      xcd_barrier(xb);
    }
  }
}

extern "C" void kernel_launch(void* const* d_in, const int* in_sizes, int n_in, void* d_out, int out_size, void* d_ws,
                              size_t ws_size, hipStream_t stream) {
  static int grid_blocks = 0;
  if (!grid_blocks) {
    int dev = 0, cus = 0, per_cu = 0;
    hipGetDevice(&dev);
    hipDeviceGetAttribute(&cus, hipDeviceAttributeMultiprocessorCount, dev);
    hipOccupancyMaxActiveBlocksPerMultiprocessor(&per_cu, mega_kernel, 256, 0);
    if (per_cu < 1) per_cu = 1;
    if (per_cu > 2) per_cu = 2;
    grid_blocks = cus * per_cu;
  }
  if (ws_size < O_END) { fprintf(stderr, "workspace too small: %zu < %zu\n", ws_size, (size_t)O_END); return; }
  Params p{};
  const float** pp = reinterpret_cast<const float**>(&p);
  for (int i = 0; i < 22; ++i) pp[i] = (const float*)d_in[i];
  p.out = (float*)d_out;
  p.ws = (unsigned char*)d_ws;
  hipMemsetAsync((unsigned char*)d_ws + O_BAR, 0, 16384, stream);
  int lo = 0, hi = N_PHASES;
  void* args[] = {&p, &lo, &hi};
  hipError_t e = hipLaunchCooperativeKernel((void*)mega_kernel, dim3(grid_blocks), dim3(256), args, 0, stream);
  if (e != hipSuccess) fprintf(stderr, "cooperative launch failed: %s (grid %d)\n", hipGetErrorString(e), grid_blocks);
}
```

```cpp
#include <hip/hip_runtime.h>
#include <hip/hip_cooperative_groups.h>
#include <cstdio>
namespace cg = cooperative_groups;

typedef unsigned short u16;
typedef short s8v __attribute__((ext_vector_type(8)));
typedef short s4v __attribute__((ext_vector_type(4)));
typedef float f4v __attribute__((ext_vector_type(4)));
#define DI __device__ __forceinline__
#define MFMA16(a, b, c) __builtin_amdgcn_mfma_f32_16x16x32_bf16((a), (b), (c), 0, 0, 0)

constexpr int SEQ = 2048, DM = 1024, NB = 8;
constexpr int TS = SEQ + 64;
constexpr int NBG = 2;
constexpr int MP = NBG * SEQ;
constexpr int NPASS = NB / NBG;
constexpr int NIN = 10832, LDP = 10880;
constexpr int C_Z = 0, C_XBC = 2048, C_DT = 5120, C_Q = 5152, C_KC = 6176, C_VC = 6432, C_KS = 6688, C_VS = 6944,
              C_KW = 7200, C_VW = 7456, C_G = 7712, C_ZA = 7760, C_MG = 8784;
constexpr float EPS = 1e-6f;
constexpr float NEGB = -1e30f;
constexpr int APROBE = 0;

constexpr size_t al256(size_t x) { return (x + 255) & ~size_t(255); }
constexpr size_t O_WIN = 0;
constexpr size_t O_WSSM = O_WIN + al256((size_t)LDP * 1024 * 2);
constexpr size_t O_WNSA = O_WSSM + al256((size_t)1024 * 2048 * 2);
constexpr size_t O_WOUT = O_WNSA + al256((size_t)1024 * 1024 * 2);
constexpr size_t O_W1K = O_WOUT + al256((size_t)1024 * 1024 * 2);
constexpr size_t O_W1V = O_W1K + al256((size_t)256 * 2048 * 2);
constexpr size_t O_W2K = O_W1V + al256((size_t)256 * 2048 * 2);
constexpr size_t O_W2V = O_W2K + al256((size_t)64 * 256 * 2);
constexpr size_t O_POSB = O_W2V + al256((size_t)64 * 256 * 2);
constexpr size_t O_ADA = O_POSB + al256(2 * 256 * 4);
constexpr size_t O_H = O_ADA + al256((size_t)8 * 3072 * 4);
constexpr size_t O_P = O_H + al256((size_t)MP * 1024 * 2);
constexpr size_t O_XC = O_P + al256((size_t)MP * LDP * 2);
constexpr size_t O_XCT = O_XC + al256((size_t)MP * 3072 * 2);
constexpr size_t O_DT = O_XCT + al256((size_t)NBG * 2560 * TS * 2);
constexpr size_t O_ACS = O_DT + al256((size_t)NBG * 32 * 2048 * 4);
constexpr size_t O_ST = O_ACS + al256((size_t)NBG * 32 * 2048 * 4);
constexpr size_t O_YD = O_ST + al256((size_t)NBG * 16 * 32 * 64 * 128 * 2);
constexpr size_t O_YN = O_YD + al256((size_t)MP * 2048 * 2);
constexpr size_t O_KCMP = O_YN + al256((size_t)MP * 2048 * 2);
constexpr size_t O_VCT = O_KCMP + al256((size_t)NBG * 4 * 128 * 64 * 2);
constexpr size_t O_VST = O_VCT + al256((size_t)NBG * 4 * 128 * 64 * 2);
constexpr size_t O_VWT = O_VST + al256((size_t)NBG * 4 * 64 * TS * 2);
constexpr size_t O_SEL = O_VWT + al256((size_t)NBG * 4 * 64 * TS * 2);
constexpr size_t O_OCMP = O_SEL + al256((size_t)NBG * 4 * 2048 * 4);
constexpr size_t O_O = O_OCMP + al256((size_t)MP * 1024 * 2);
constexpr size_t O_BAR = O_O + al256((size_t)MP * 1024 * 2);
constexpr size_t O_END = O_BAR + 16384;
static_assert(O_END <= (size_t)256 * 1024 * 1024, "workspace map must fit the guaranteed 256 MiB");
constexpr size_t O_OUTF = O_P;
constexpr size_t O_RSQ = O_P + al256((size_t)MP * 1024 * 4);

struct Params {
  const float *x, *c, *w_ada, *b_ada, *g_pre, *g_post, *w_in, *conv_w, *conv_b, *dt_bias, *a_log, *d_skip, *g_ssm_norm,
      *w_ssm_out, *cmp_pos_k, *cmp_w1_k, *cmp_w2_k, *cmp_pos_v, *cmp_w1_v, *cmp_w2_v, *w_nsa_out, *w_out;
  float* out;
  unsigned char* ws;
};

DI u16 f2bf(float f) { unsigned u = __float_as_uint(f); u += 0x7fffu + ((u >> 16) & 1u); return (u16)(u >> 16); }
DI float bf2f(u16 h) { return __uint_as_float(((unsigned)h) << 16); }
DI float bfs(short h) { return __uint_as_float(((unsigned)(u16)h) << 16); }
DI s8v ld8(const u16* p) { return *reinterpret_cast<const s8v*>(p); }
DI s4v ld4(const u16* p) { return *reinterpret_cast<const s4v*>(p); }
DI f4v ldf4(const float* p) { return *reinterpret_cast<const f4v*>(p); }
typedef __bf16 bf2v __attribute__((ext_vector_type(2)));
typedef float f2v __attribute__((ext_vector_type(2)));
typedef unsigned u2v __attribute__((ext_vector_type(2)));
typedef unsigned u4v __attribute__((ext_vector_type(4)));
DI unsigned pk2(float a, float b) {
  f2v v = {a, b};
  return __builtin_bit_cast(unsigned, __builtin_convertvector(v, bf2v));
}
DI void st4bf(u16* p, float a, float b, float c, float d) {
  u2v v = {pk2(a, b), pk2(c, d)};
  *reinterpret_cast<u2v*>(p) = v;
}
DI void st8bf_pair(u16* p, f4v a, f4v b, int quad) {
  unsigned ax = pk2(a[0], a[1]), ay = pk2(a[2], a[3]), bx = pk2(b[0], b[1]), by = pk2(b[2], b[3]);
  const auto r0 = __builtin_amdgcn_permlane16_swap(ax, bx, false, false);
  const auto r1 = __builtin_amdgcn_permlane16_swap(ay, by, false, false);
  u4v v = {r0[0], r1[0], r0[1], r1[1]};
  *reinterpret_cast<u4v*>(p + (quad & 1) * 16 + (quad >> 1) * 8) = v;
}
DI void ld8bf_pair(const u16* p, int quad, s4v& a, s4v& b) {
  const u4v x = *reinterpret_cast<const u4v*>(p + (quad & 1) * 16 + (quad >> 1) * 8);
  const auto r0 = __builtin_amdgcn_permlane16_swap(x[0], x[2], false, false);
  const auto r1 = __builtin_amdgcn_permlane16_swap(x[1], x[3], false, false);
  u2v ua = {r0[0], r1[0]}, ub = {r0[1], r1[1]};
  a = __builtin_bit_cast(s4v, ua);
  b = __builtin_bit_cast(s4v, ub);
}
DI s8v pack8(f4v a, f4v b) {
  u4v v = {pk2(a[0], a[1]), pk2(a[2], a[3]), pk2(b[0], b[1]), pk2(b[2], b[3])};
  return __builtin_bit_cast(s8v, v);
}
DI s8v pack8f(const float* x) {
  u4v v = {pk2(x[0], x[1]), pk2(x[2], x[3]), pk2(x[4], x[5]), pk2(x[6], x[7])};
  return __builtin_bit_cast(s8v, v);
}
DI s8v cat44(s4v a, s4v b) { s8v v; v[0]=a[0]; v[1]=a[1]; v[2]=a[2]; v[3]=a[3]; v[4]=b[0]; v[5]=b[1]; v[6]=b[2]; v[7]=b[3]; return v; }
DI float sigmoidf_(float x) { return __builtin_amdgcn_rcpf(1.f + __expf(-x)); }
DI float siluf_(float x) { return x * __builtin_amdgcn_rcpf(1.f + __expf(-x)); }
DI float softplusf_(float x) {
  const float y = __expf(x);
  const float small = y * (1.f - y * (0.5f - y * (0.33333334f - 0.25f * y)));
  const float big = __logf(1.f + y);
  return x > 20.f ? x : (y < 0.03f ? small : big);
}
DI float qmax(float v) { v = fmaxf(v, __shfl_xor(v, 16)); v = fmaxf(v, __shfl_xor(v, 32)); return v; }
DI float qsum(float v) { v += __shfl_xor(v, 16); v += __shfl_xor(v, 32); return v; }
DI int tidx() { int t = __builtin_amdgcn_workitem_id_x(); asm volatile("" : "+v"(t)); return t; }
DI f4v fz() { f4v z = {0.f, 0.f, 0.f, 0.f}; return z; }

DI int lds_byte32(int r, int c) {
  const int ob = (r & 15) * 64 + c * 2;
  return (r >> 4) * 1024 + (ob ^ (((ob >> 9) & 1) << 5));
}
DI void stage_rc32(int b, int& R, int& C) {
  const int st = b >> 10, sb = b & 1023, swz = sb ^ (((sb >> 9) & 1) << 5);
  R = st * 16 + (swz >> 6);
  C = (swz & 63) >> 1;
}
template <int N> DI void wait_vm() {
  if constexpr (N == 0) asm volatile("s_waitcnt vmcnt(0)" ::: "memory");
  else if constexpr (N == 3) asm volatile("s_waitcnt vmcnt(3)" ::: "memory");
  else if constexpr (N == 4) asm volatile("s_waitcnt vmcnt(4)" ::: "memory");
  else if constexpr (N == 6) asm volatile("s_waitcnt vmcnt(6)" ::: "memory");
  else asm volatile("s_waitcnt vmcnt(8)" ::: "memory");
}
template <int NT, int MODE = 0>
DI void gemm_mainloop(f4v (&acc)[4][NT], const u16* __restrict__ A, int lda, const u16* __restrict__ Bt, int ldb, int K,
                      int m0, int n0, u16* smem) {
  const int tid = tidx(), lane = tid & 63, w = tid >> 6, wm = w >> 1, wn = w & 1;
  const int l15 = lane & 15, quad = lane >> 4;
  constexpr int TA = 8192, TBB = NT * 2048, TBUF = TA + TBB;
  constexpr int NBP = NT / 2;
  constexpr int L = 2 + NBP;
  char* sbase = reinterpret_cast<char*>(smem);
  const unsigned lbase = (unsigned)(size_t)sbase;
  int Rr[2], Cc[2];
#pragma unroll
  for (int i = 0; i < 2; ++i) stage_rc32(tid * 16 + i * 4096, Rr[i], Cc[i]);
  const u16* ga0 = A + (size_t)(m0 + Rr[0]) * lda + Cc[0];
  const u16* ga1 = A + (size_t)(m0 + Rr[1]) * lda + Cc[1];
  const u16* gb0 = Bt + (size_t)(n0 + Rr[0]) * ldb + Cc[0];
  const u16* gb1 = Bt + (size_t)(n0 + Rr[NBP - 1]) * ldb + Cc[NBP - 1];
  unsigned offa[4], offb[NT];
#pragma unroll
  for (int t = 0; t < 4; ++t) offa[t] = lds_byte32(wm * 64 + t * 16 + l15, quad * 8);
#pragma unroll
  for (int t = 0; t < NT; ++t) offb[t] = TA + lds_byte32(wn * 16 * NT + t * 16 + l15, quad * 8);
  const int ns = K >> 5;
#define GEMM_STAGE(j)                                                                                                 \
  do {                                                                                                               \
    char* _d = sbase + ((j) & 3) * TBUF + tid * 16;                                                                   \
    __builtin_amdgcn_global_load_lds((const unsigned*)(ga0 + (j) * 32), (unsigned*)(_d), 16, 0, 0);                   \
    __builtin_amdgcn_global_load_lds((const unsigned*)(ga1 + (j) * 32), (unsigned*)(_d + 4096), 16, 0, 0);            \
    __builtin_amdgcn_global_load_lds((const unsigned*)(gb0 + (j) * 32), (unsigned*)(_d + TA), 16, 0, 0);              \
    if (NBP == 2) __builtin_amdgcn_global_load_lds((const unsigned*)(gb1 + (j) * 32), (unsigned*)(_d + TA + 4096), 16, 0, 0); \
  } while (0)
  asm volatile("s_waitcnt vmcnt(0)" ::: "memory");
  if (MODE != 1) { GEMM_STAGE(0); GEMM_STAGE(1); GEMM_STAGE(2); }
  for (int j = 0; j < ns; ++j) {
    if (j + 2 < ns) wait_vm<2 * L>();
    else if (j + 1 < ns) wait_vm<L>();
    else wait_vm<0>();
    asm volatile("s_waitcnt lgkmcnt(0)" ::: "memory");
    __builtin_amdgcn_s_barrier();
    if (MODE != 1 && j + 3 < ns) GEMM_STAGE(j + 3);
    if (MODE == 2) continue;
    const unsigned sl = lbase + (unsigned)((j & 3) * TBUF);
    s8v af[4], bg[NT];
    if constexpr (NT == 4) {
      asm volatile(
          "ds_read_b128 %0, %8\n\tds_read_b128 %1, %9\n\tds_read_b128 %2, %10\n\tds_read_b128 %3, %11\n\t"
          "ds_read_b128 %4, %12\n\tds_read_b128 %5, %13\n\tds_read_b128 %6, %14\n\tds_read_b128 %7, %15\n\t"
          "s_waitcnt lgkmcnt(0)"
          : "=&v"(af[0]), "=&v"(af[1]), "=&v"(af[2]), "=&v"(af[3]), "=&v"(bg[0]), "=&v"(bg[1]), "=&v"(bg[2]), "=&v"(bg[3])
          : "v"(sl + offa[0]), "v"(sl + offa[1]), "v"(sl + offa[2]), "v"(sl + offa[3]), "v"(sl + offb[0]), "v"(sl + offb[1]),
            "v"(sl + offb[2]), "v"(sl + offb[3])
          : "memory");
    } else {
      asm volatile(
          "ds_read_b128 %0, %6\n\tds_read_b128 %1, %7\n\tds_read_b128 %2, %8\n\tds_read_b128 %3, %9\n\t"
          "ds_read_b128 %4, %10\n\tds_read_b128 %5, %11\n\t"
          "s_waitcnt lgkmcnt(0)"
          : "=&v"(af[0]), "=&v"(af[1]), "=&v"(af[2]), "=&v"(af[3]), "=&v"(bg[0]), "=&v"(bg[1])
          : "v"(sl + offa[0]), "v"(sl + offa[1]), "v"(sl + offa[2]), "v"(sl + offa[3]), "v"(sl + offb[0]), "v"(sl + offb[1])
          : "memory");
    }
#pragma unroll
    for (int mt = 0; mt < 4; ++mt)
#pragma unroll
      for (int nt = 0; nt < NT; ++nt) acc[mt][nt] = MFMA16(bg[nt], af[mt], acc[mt][nt]);
  }
#undef GEMM_STAGE
  asm volatile("s_waitcnt lgkmcnt(0)" ::: "memory");
  __builtin_amdgcn_s_barrier();
}
template <int NT>
DI void zero_acc(f4v (&acc)[4][NT]) {
#pragma unroll
  for (int i = 0; i < 4; ++i)
#pragma unroll
    for (int j = 0; j < NT; ++j) acc[i][j] = fz();
}

DI void gemm_big_prefetch(const u16* __restrict__ A, int lda, const u16* __restrict__ Bt, int ldb, int m0, int n0, u16* smem) {
  const int tid = tidx();
  char* sbase = reinterpret_cast<char*>(smem);
#pragma unroll
  for (int sl = 0; sl < 2; ++sl) {
    char* d = sbase + sl * 24576 + tid * 16;
#pragma unroll
    for (int i = 0; i < 4; ++i) {
      int R, C;
      stage_rc32(tid * 16 + i * 4096, R, C);
      __builtin_amdgcn_global_load_lds((const unsigned*)(A + (size_t)(m0 + R) * lda + C + sl * 32), (unsigned*)(d + i * 4096), 16, 0, 0);
      if (i < 2)
        __builtin_amdgcn_global_load_lds((const unsigned*)(Bt + (size_t)(n0 + R) * ldb + C + sl * 32), (unsigned*)(d + 16384 + i * 4096), 16, 0, 0);
    }
  }
}
DI void gemm_big(f4v (&acc)[8][4], const u16* __restrict__ A, int lda, const u16* __restrict__ Bt, int ldb, int K, int m0, int n0,
                 u16* smem, bool prestaged) {
  const int tid = tidx(), lane = tid & 63, w = tid >> 6, wm = w >> 1, wn = w & 1;
  const int l15 = lane & 15, quad = lane >> 4;
  constexpr int TA = 16384, TBUF = 24576;
  char* sbase = reinterpret_cast<char*>(smem);
  const unsigned lbase = (unsigned)(size_t)sbase;
  const u16* ga[4];
  const u16* gb[2];
#pragma unroll
  for (int i = 0; i < 4; ++i) {
    int R, C;
    stage_rc32(tid * 16 + i * 4096, R, C);
    ga[i] = A + (size_t)(m0 + R) * lda + C;
    if (i < 2) gb[i] = Bt + (size_t)(n0 + R) * ldb + C;
  }
  unsigned offa[8], offb[4];
#pragma unroll
  for (int t = 0; t < 8; ++t) offa[t] = lds_byte32(wm * 128 + t * 16 + l15, quad * 8);
#pragma unroll
  for (int t = 0; t < 4; ++t) offb[t] = TA + lds_byte32(wn * 64 + t * 16 + l15, quad * 8);
  const int ns = K >> 5;
#define BIG_STAGE(j, slot)                                                                                            \
  do {                                                                                                               \
    char* _d = sbase + (slot) * TBUF + tid * 16;                                                                      \
    _Pragma("unroll") for (int _i = 0; _i < 4; ++_i)                                                                 \
      __builtin_amdgcn_global_load_lds((const unsigned*)(ga[_i] + (j) * 32), (unsigned*)(_d + _i * 4096), 16, 0, 0);  \
    _Pragma("unroll") for (int _i = 0; _i < 2; ++_i)                                                                 \
      __builtin_amdgcn_global_load_lds((const unsigned*)(gb[_i] + (j) * 32), (unsigned*)(_d + TA + _i * 4096), 16, 0, 0); \
  } while (0)
  if (!prestaged) {
    asm volatile("s_waitcnt vmcnt(0)" ::: "memory");
    BIG_STAGE(0, 0);
    BIG_STAGE(1, 1);
  }
  int slot = 0;
  for (int j = 0; j < ns; ++j) {
    if (j + 1 < ns) wait_vm<6>();
    else wait_vm<0>();
    asm volatile("s_waitcnt lgkmcnt(0)" ::: "memory");
    __builtin_amdgcn_s_barrier();
    const int s2 = (slot == 0) ? 2 : slot - 1;
    if (j + 2 < ns) BIG_STAGE(j + 2, s2);
    const unsigned sl = lbase + (unsigned)(slot * TBUF);
    s8v af[8], bg[4];
    asm volatile(
        "ds_read_b128 %0, %12\n\tds_read_b128 %1, %13\n\tds_read_b128 %2, %14\n\tds_read_b128 %3, %15\n\t"
        "ds_read_b128 %4, %16\n\tds_read_b128 %5, %17\n\tds_read_b128 %6, %18\n\tds_read_b128 %7, %19\n\t"
        "ds_read_b128 %8, %20\n\tds_read_b128 %9, %21\n\tds_read_b128 %10, %22\n\tds_read_b128 %11, %23\n\t"
        "s_waitcnt lgkmcnt(0)"
        : "=&v"(bg[0]), "=&v"(bg[1]), "=&v"(bg[2]), "=&v"(bg[3]), "=&v"(af[0]), "=&v"(af[1]), "=&v"(af[2]), "=&v"(af[3]),
          "=&v"(af[4]), "=&v"(af[5]), "=&v"(af[6]), "=&v"(af[7])
        : "v"(sl + offb[0]), "v"(sl + offb[1]), "v"(sl + offb[2]), "v"(sl + offb[3]), "v"(sl + offa[0]), "v"(sl + offa[1]),
          "v"(sl + offa[2]), "v"(sl + offa[3]), "v"(sl + offa[4]), "v"(sl + offa[5]), "v"(sl + offa[6]), "v"(sl + offa[7])
        : "memory");
#pragma unroll
    for (int mt = 0; mt < 8; ++mt)
#pragma unroll
      for (int nt = 0; nt < 4; ++nt) acc[mt][nt] = MFMA16(bg[nt], af[mt], acc[mt][nt]);
    slot = (slot == 2) ? 0 : slot + 1;
  }
#undef BIG_STAGE
  asm volatile("s_waitcnt lgkmcnt(0)" ::: "memory");
  __builtin_amdgcn_s_barrier();
}

DI void gemm_k64(f4v (&acc)[4][2], const u16* __restrict__ A, int lda, const u16* __restrict__ Bt, int ldb, int K, int m0, int n0,
                 u16* smem) {
  const int tid = tidx(), lane = tid & 63, w = tid >> 6, wm = w >> 1, wn = w & 1;
  const int l15 = lane & 15, quad = lane >> 4;
  constexpr int TA = 16384, TBUF = 24576;
  char* sbase = reinterpret_cast<char*>(smem);
  const unsigned lbase = (unsigned)(size_t)sbase;
  const u16* ga[4];
  const u16* gb[2];
#pragma unroll
  for (int i = 0; i < 4; ++i) {
    int R, C;
    stage_rc32(tid * 16 + (i & 1) * 4096, R, C);
    ga[i] = A + (size_t)(m0 + R) * lda + C + 32 * (i >> 1);
  }
  {
    int R, C;
    stage_rc32(tid * 16, R, C);
    gb[0] = Bt + (size_t)(n0 + R) * ldb + C;
    gb[1] = gb[0] + 32;
  }
  unsigned offa[8], offb[4];
#pragma unroll
  for (int t = 0; t < 8; ++t) offa[t] = (t >> 2) * 8192 + lds_byte32(wm * 64 + (t & 3) * 16 + l15, quad * 8);
#pragma unroll
  for (int t = 0; t < 4; ++t) offb[t] = TA + (t >> 1) * 4096 + lds_byte32(wn * 32 + (t & 1) * 16 + l15, quad * 8);
  const int ns = K >> 6;
#define K64_STAGE(j, slot)                                                                                            \
  do {                                                                                                               \
    char* _d = sbase + (slot) * TBUF + tid * 16;                                                                      \
    _Pragma("unroll") for (int _i = 0; _i < 4; ++_i)                                                                 \
      __builtin_amdgcn_global_load_lds((const unsigned*)(ga[_i] + (j) * 64), (unsigned*)(_d + _i * 4096), 16, 0, 0);  \
    _Pragma("unroll") for (int _i = 0; _i < 2; ++_i)                                                                 \
      __builtin_amdgcn_global_load_lds((const unsigned*)(gb[_i] + (j) * 64), (unsigned*)(_d + TA + _i * 4096), 16, 0, 0); \
  } while (0)
  asm volatile("s_waitcnt vmcnt(0)" ::: "memory");
  K64_STAGE(0, 0);
  if (ns > 1) K64_STAGE(1, 1);
  int slot = 0;
  for (int j = 0; j < ns; ++j) {
    if (j + 1 < ns) wait_vm<6>();
    else wait_vm<0>();
    asm volatile("s_waitcnt lgkmcnt(0)" ::: "memory");
    __builtin_amdgcn_s_barrier();
    const int s2 = (slot == 0) ? 2 : slot - 1;
    if (j + 2 < ns) K64_STAGE(j + 2, s2);
    const unsigned sl = lbase + (unsigned)(slot * TBUF);
    s8v af[8], bg[4];
    asm volatile(
        "ds_read_b128 %0, %12\n\tds_read_b128 %1, %13\n\tds_read_b128 %2, %14\n\tds_read_b128 %3, %15\n\t"
        "ds_read_b128 %4, %16\n\tds_read_b128 %5, %17\n\tds_read_b128 %6, %18\n\tds_read_b128 %7, %19\n\t"
        "ds_read_b128 %8, %20\n\tds_read_b128 %9, %21\n\tds_read_b128 %10, %22\n\tds_read_b128 %11, %23\n\t"
        "s_waitcnt lgkmcnt(0)"
        : "=&v"(bg[0]), "=&v"(bg[1]), "=&v"(bg[2]), "=&v"(bg[3]), "=&v"(af[0]), "=&v"(af[1]), "=&v"(af[2]), "=&v"(af[3]),
          "=&v"(af[4]), "=&v"(af[5]), "=&v"(af[6]), "=&v"(af[7])
        : "v"(sl + offb[0]), "v"(sl + offb[1]), "v"(sl + offb[2]), "v"(sl + offb[3]), "v"(sl + offa[0]), "v"(sl + offa[1]),
          "v"(sl + offa[2]), "v"(sl + offa[3]), "v"(sl + offa[4]), "v"(sl + offa[5]), "v"(sl + offa[6]), "v"(sl + offa[7])
        : "memory");
#pragma unroll
    for (int h = 0; h < 2; ++h)
#pragma unroll
      for (int mt = 0; mt < 4; ++mt)
#pragma unroll
        for (int nt = 0; nt < 2; ++nt) acc[mt][nt] = MFMA16(bg[h * 2 + nt], af[h * 4 + mt], acc[mt][nt]);
    slot = (slot == 2) ? 0 : slot + 1;
  }
#undef K64_STAGE
  asm volatile("s_waitcnt lgkmcnt(0)" ::: "memory");
  __builtin_amdgcn_s_barrier();
}

DI void convT_tile(const float* __restrict__ w, int K, int N, u16* __restrict__ wt, int tile, float* sm) {
  const int tid = tidx();
  const int tiles_k = K >> 6;
  const int tk = tile % tiles_k, tn = tile / tiles_k;
  const int k0 = tk * 64, n0 = tn * 64;
  {
    const int c = tid & 63, r0 = tid >> 6;
    const bool ok = (n0 + c) < N;
    float v[16];
#pragma unroll
    for (int i = 0; i < 16; ++i) v[i] = ok ? w[(size_t)(k0 + r0 + 4 * i) * N + n0 + c] : 0.f;
    __builtin_amdgcn_sched_barrier(0);
#pragma unroll
    for (int i = 0; i < 16; ++i) sm[(r0 + 4 * i) * 65 + c] = v[i];
  }
  __syncthreads();
  {
    const int n = tid >> 2, ks = (tid & 3) * 16;
    float t0[8], t1[8];
#pragma unroll
    for (int j = 0; j < 8; ++j) { t0[j] = sm[(ks + j) * 65 + n]; t1[j] = sm[(ks + 8 + j) * 65 + n]; }
    const s8v v0 = pack8f(t0), v1 = pack8f(t1);
    u16* dst = wt + (size_t)(n0 + n) * K + k0 + ks;
    *reinterpret_cast<s8v*>(dst) = v0;
    *reinterpret_cast<s8v*>(dst + 8) = v1;
  }
  __syncthreads();
}

template <int NR>
DI void gemv_cols(const float* __restrict__ vec, int K, const float* __restrict__ W, int N, const float* __restrict__ bias,
                  float* __restrict__ out, int col0, float* sm) {
  const int tid = tidx(), kg = tid >> 6, cl = tid & 63;
  const int kper = K >> 2;
  float acc[NR];
#pragma unroll
  for (int r = 0; r < NR; ++r) acc[r] = 0.f;
  for (int k0 = kg * kper; k0 < (kg + 1) * kper; k0 += 16) {
    float wv[16];
#pragma unroll
    for (int j = 0; j < 16; ++j) wv[j] = W[(size_t)(k0 + j) * N + col0 + cl];
    __builtin_amdgcn_sched_barrier(0);
#pragma unroll
    for (int j = 0; j < 16; ++j)
#pragma unroll
      for (int r = 0; r < NR; ++r) acc[r] += vec[r * K + k0 + j] * wv[j];
    __builtin_amdgcn_sched_barrier(0);
  }
#pragma unroll
  for (int r = 0; r < NR; ++r) sm[(kg * NR + r) * 64 + cl] = acc[r];
  __syncthreads();
  for (int idx = tid; idx < NR * 64; idx += 256) {
    const int r = idx >> 6, c2 = idx & 63;
    float s = bias ? bias[col0 + c2] : 0.f;
#pragma unroll
    for (int g = 0; g < 4; ++g) s += sm[(g * NR + r) * 64 + c2];
    out[(size_t)r * N + col0 + c2] = s;
  }
  __syncthreads();
}

DI void phaseA(const Params& p, unsigned char* smem_raw) {
  float* smf = reinterpret_cast<float*>(smem_raw);
  unsigned char* ws = p.ws;
  constexpr int T0 = 16 * 170, T1 = T0 + 32 * 16, T2 = T1 + 16 * 16, T3 = T2 + 16 * 16, T4 = T3 + 32 * 4, T5 = T4 + 32 * 4,
                T6 = T5 + 4, T7 = T6 + 4, T8 = T7 + 48, T9 = T8 + 8;
  for (int it = blockIdx.x; it < T9; it += gridDim.x) {
    if (it < T0) convT_tile(p.w_in, 1024, NIN, (u16*)(ws + O_WIN), it, smf);
    else if (it < T1) convT_tile(p.w_ssm_out, 2048, 1024, (u16*)(ws + O_WSSM), it - T0, smf);
    else if (it < T2) convT_tile(p.w_nsa_out, 1024, 1024, (u16*)(ws + O_WNSA), it - T1, smf);
    else if (it < T3) convT_tile(p.w_out, 1024, 1024, (u16*)(ws + O_WOUT), it - T2, smf);
    else if (it < T4) convT_tile(p.cmp_w1_k, 2048, 256, (u16*)(ws + O_W1K), it - T3, smf);
    else if (it < T5) convT_tile(p.cmp_w1_v, 2048, 256, (u16*)(ws + O_W1V), it - T4, smf);
    else if (it < T6) convT_tile(p.cmp_w2_k, 256, 64, (u16*)(ws + O_W2K), it - T5, smf);
    else if (it < T7) convT_tile(p.cmp_w2_v, 256, 64, (u16*)(ws + O_W2V), it - T6, smf);
    else if (it < T8) gemv_cols<8>(p.c, 1024, p.w_ada, 3072, p.b_ada, (float*)(ws + O_ADA), (it - T7) * 64, smf);
    else {
      const int j = it - T8, kind = j >> 2, cb = j & 3;
      gemv_cols<1>(kind ? p.cmp_pos_v : p.cmp_pos_k, 2048, kind ? p.cmp_w1_v : p.cmp_w1_k, 256, nullptr,
                   (float*)(ws + O_POSB) + kind * 256, cb * 64, smf);
    }
  }
}

DI void phaseB(const Params& p, int pass) {
  const int tid = tidx(), lane = tid & 63, w = tid >> 6;
  const float* ada = (const float*)(p.ws + O_ADA);
  u16* h = (u16*)(p.ws + O_H);
  for (int it = blockIdx.x; it < MP / 4; it += gridDim.x) {
    const int r = it * 4 + w;
    const int tg = pass * MP + r;
    const int b = tg >> 11;
    const float* xr = p.x + (size_t)tg * DM;
    f4v v[4];
    float ss = 0.f;
#pragma unroll
    for (int i = 0; i < 4; ++i) {
      v[i] = ldf4(xr + i * 256 + lane * 4);
      ss += v[i][0] * v[i][0] + v[i][1] * v[i][1] + v[i][2] * v[i][2] + v[i][3] * v[i][3];
    }
#pragma unroll
    for (int o = 1; o < 64; o <<= 1) ss += __shfl_xor(ss, o);
    const float rstd = rsqrtf(ss * (1.f / DM) + EPS);
    f4v gg[4], shh[4], scc[4];
#pragma unroll
    for (int i = 0; i < 4; ++i) {
      const int c0 = i * 256 + lane * 4;
      gg[i] = ldf4(p.g_pre + c0);
      shh[i] = ldf4(ada + b * 3072 + c0);
      scc[i] = ldf4(ada + b * 3072 + 1024 + c0);
    }
    __builtin_amdgcn_sched_barrier(0);
#pragma unroll
    for (int i = 0; i < 4; ++i) {
      const int c0 = i * 256 + lane * 4;
      const f4v g = gg[i], sh = shh[i], sc = scc[i];
      float o0 = v[i][0] * rstd * g[0] * (1.f + sc[0]) + sh[0];
      float o1 = v[i][1] * rstd * g[1] * (1.f + sc[1]) + sh[1];
      float o2 = v[i][2] * rstd * g[2] * (1.f + sc[2]) + sh[2];
      float o3 = v[i][3] * rstd * g[3] * (1.f + sc[3]) + sh[3];
      st4bf(h + (size_t)r * DM + c0, o0, o1, o2, o3);
    }
  }
}

template <int MODE>
DI void phaseC(const Params& p, u16* smem) {
  const int lane = tidx() & 63, w = tidx() >> 6, wm = w >> 1, wn = w & 1, l15 = lane & 15, quad = lane >> 4;
  const u16* A = (const u16*)(p.ws + O_H);
  const u16* Bt = (const u16*)(p.ws + O_WIN);
  u16* P = (u16*)(p.ws + O_P);
  constexpr int NTN = LDP / 128;
  const int xcd = blockIdx.x & 7, lb = blockIdx.x >> 3, nlb = gridDim.x >> 3;
  bool pre = false;
  for (int t = lb;; t += nlb) {
    const int mi = (xcd & 3) * 4 + (t & 3);
    const int ni = 2 * (t >> 2) + (xcd >> 2);
    if (ni >= NTN) break;
    f4v acc[8][4];
#pragma unroll
    for (int i = 0; i < 8; ++i)
#pragma unroll
      for (int j = 0; j < 4; ++j) acc[i][j] = fz();
    gemm_big(acc, A, 1024, Bt, 1024, 1024, mi * 256, ni * 128, smem, pre);
    {
      const int t2 = t + nlb;
      const int ni2 = 2 * (t2 >> 2) + (xcd >> 2);
      pre = ni2 < NTN;
      if (pre) gemm_big_prefetch(A, 1024, Bt, 1024, ((xcd & 3) * 4 + (t2 & 3)) * 256, ni2 * 128, smem);
    }
    if (MODE != 0) { if (acc[0][0][0] + acc[7][3][3] != 12345.678f) continue; }
#pragma unroll
    for (int mt = 0; mt < 8; ++mt) {
      u16* prow = P + (size_t)(mi * 256 + wm * 128 + mt * 16 + l15) * LDP + ni * 128 + wn * 64;
      st8bf_pair(prow, acc[mt][0], acc[mt][1], quad);
      st8bf_pair(prow + 32, acc[mt][2], acc[mt][3], quad);
    }
  }
}

DI void conv_item(const Params& p, int it) {
  const int tid = tidx();
  const int cb = it % 24, tb = (it / 24) & 31, b = it / (24 * 32);
  const int ch0 = cb * 128 + 2 * (tid & 63);
  const int t0 = tb * 64 + 16 * (tid >> 6);
  const u16* P = (const u16*)(p.ws + O_P);
  u16* xc = (u16*)(p.ws + O_XC);
  u16* xcT = (u16*)(p.ws + O_XCT);
  unsigned raw[19];
#pragma unroll
  for (int i = 0; i < 19; ++i) {
    const int t = t0 - 3 + i;
    raw[i] = (t >= 0) ? *reinterpret_cast<const unsigned*>(P + (size_t)(b * SEQ + t) * LDP + C_XBC + ch0) : 0u;
  }
  const int hd = ch0 >> 6;
  u16 dtr[16];
  const bool isx = ch0 < 2048, isxb = ch0 < 2560;
  if (isx) {
#pragma unroll
    for (int i = 0; i < 16; ++i) dtr[i] = P[(size_t)(b * SEQ + t0 + i) * LDP + C_DT + hd];
  }
  float wv[4][2];
#pragma unroll
  for (int k = 0; k < 4; ++k) { wv[k][0] = p.conv_w[k * 3072 + ch0]; wv[k][1] = p.conv_w[k * 3072 + ch0 + 1]; }
  const float b0 = p.conv_b[ch0], b1 = p.conv_b[ch0 + 1];
  float y0[16], y1[16];
#pragma unroll
  for (int i = 0; i < 16; ++i) {
    float a0 = b0, a1 = b1;
#pragma unroll
    for (int k = 0; k < 4; ++k) {
      a0 += wv[k][0] * __uint_as_float(raw[i + k] << 16);
      a1 += wv[k][1] * __uint_as_float(raw[i + k] & 0xffff0000u);
    }
    y0[i] = siluf_(a0); y1[i] = siluf_(a1);
    const unsigned pk = pk2(y0[i], y1[i]);
    if (ch0 >= 2048) *reinterpret_cast<unsigned*>(xc + (size_t)(b * SEQ + t0 + i) * 3072 + ch0) = pk;
  }
  if (isxb) {
    if (isx) {
      const float db = p.dt_bias[hd];
#pragma unroll
      for (int i = 0; i < 16; ++i) {
        const float dtv = softplusf_(bf2f(dtr[i]) + db);
        y0[i] *= dtv; y1[i] *= dtv;
      }
    }
    u16* d0 = xcT + ((size_t)b * 2560 + ch0) * TS + t0;
    *reinterpret_cast<s8v*>(d0) = pack8f(y0);
    *reinterpret_cast<s8v*>(d0 + 8) = pack8f(y0 + 8);
    *reinterpret_cast<s8v*>(d0 + TS) = pack8f(y1);
    *reinterpret_cast<s8v*>(d0 + TS + 8) = pack8f(y1 + 8);
  }
}
DI void dt_item(const Params& p, int it, float* sm) {
  const int tid = tidx(), hd = tid & 31, seg = tid >> 5;
  const int c = it & 15, b = it >> 4;
  const u16* P = (const u16*)(p.ws + O_P);
  float* dtb = (float*)(p.ws + O_DT);
  float* acs = (float*)(p.ws + O_ACS);
  const float db = p.dt_bias[hd];
  const float a = -expf(p.a_log[hd]);
  const int tbase = c * 128 + seg * 16;
  float v[16], cs[16];
#pragma unroll
  for (int i = 0; i < 16; ++i) v[i] = bf2f(P[(size_t)(b * SEQ + tbase + i) * LDP + C_DT + hd]);
  float run = 0.f;
#pragma unroll
  for (int i = 0; i < 16; ++i) { v[i] = softplusf_(v[i] + db); run += v[i] * a; cs[i] = run; }
  sm[seg * 32 + hd] = run;
  __syncthreads();
  float off = 0.f;
#pragma unroll
  for (int s2 = 0; s2 < 8; ++s2) off += (s2 < seg) ? sm[s2 * 32 + hd] : 0.f;
  float* d0 = dtb + ((size_t)b * 32 + hd) * SEQ + tbase;
  float* d1 = acs + ((size_t)b * 32 + hd) * SEQ + tbase;
#pragma unroll
  for (int i = 0; i < 4; ++i) {
    f4v x0 = {v[4 * i], v[4 * i + 1], v[4 * i + 2], v[4 * i + 3]};
    f4v x1 = {cs[4 * i] + off, cs[4 * i + 1] + off, cs[4 * i + 2] + off, cs[4 * i + 3] + off};
    *reinterpret_cast<f4v*>(d0 + 4 * i) = x0;
    *reinterpret_cast<f4v*>(d1 + 4 * i) = x1;
  }
  __syncthreads();
}
DI void vtr_item(const Params& p, int it) {
  const int tid = tidx();
  const int tb = it & 31, g = (it >> 5) & 3, b = (it >> 7) % NBG, kind = it / (128 * NBG);
  const u16* P = (const u16*)(p.ws + O_P);
  u16* dst = (u16*)(p.ws + (kind ? O_VWT : O_VST));
  const int d = tid & 63, tq = tid >> 6;
  const int t0 = tb * 64 + tq * 16;
  const int col = (kind ? C_VW : C_VS) + g * 64 + d;
  s8v v0, v1;
#pragma unroll
  for (int i = 0; i < 8; ++i) {
    v0[i] = (short)P[(size_t)(b * SEQ + t0 + i) * LDP + col];
    v1[i] = (short)P[(size_t)(b * SEQ + t0 + 8 + i) * LDP + col];
  }
  u16* o = dst + (((size_t)b * 4 + g) * 64 + d) * TS + t0;
  *reinterpret_cast<s8v*>(o) = v0;
  *reinterpret_cast<s8v*>(o + 8) = v1;
}
DI void cmp_item(const Params& p, int it, u16* sm) {
  const int tid = tidx(), lane = tid & 63, w = tid >> 6, l15 = lane & 15, quad = lane >> 4;
  const int jt = it & 7, g = (it >> 3) & 3, b = (it >> 5) % NBG, kind = it / (32 * NBG);
  const u16* P = (const u16*)(p.ws + O_P);
  const u16* W1 = (const u16*)(p.ws + (kind ? O_W1V : O_W1K));
  const u16* W2 = (const u16*)(p.ws + (kind ? O_W2V : O_W2K));
  const float* posb = (const float*)(p.ws + O_POSB) + kind * 256;
  const int col0 = (kind ? C_VC : C_KC) + g * 64;
  const int j = jt * 16 + l15;
  const bool rv = j < 127;
  const u16* arow = P + (size_t)(b * SEQ + (rv ? j : 0) * 16) * LDP + col0 + quad * 8;
  f4v hid[16];
#pragma unroll
  for (int nt = 0; nt < 16; ++nt) hid[nt] = fz();
  s8v zero8 = {0, 0, 0, 0, 0, 0, 0, 0};
#define CMP_LOAD(AF, BW, K2R)                                                                        \
  do {                                                                                               \
    const int _kk = 16 * w + (((K2R) + it) & 15);                        \
    const int _l = _kk >> 1, _d0 = (_kk & 1) * 32;                                                    \
    AF = rv ? ld8(arow + (size_t)_l * LDP + _d0) : zero8;                                             \
    const u16* _wb = W1 + (size_t)l15 * 2048 + _kk * 32 + quad * 8;                                   \
    _Pragma("unroll") for (int nt = 0; nt < 16; ++nt) BW[nt] = ld8(_wb + (size_t)nt * 16 * 2048);    \
  } while (0)
#define CMP_MMA(AF, BW)                                                                              \
  do {                                                                                               \
    _Pragma("unroll") for (int nt = 0; nt < 16; ++nt) hid[nt] = MFMA16(AF, BW[nt], hid[nt]);         \
  } while (0)
  {
    s8v a0, a1, b0[16], b1[16];
    CMP_LOAD(a0, b0, 0);
#pragma unroll 1
    for (int k2r = 0; k2r < 16; k2r += 2) {
      CMP_LOAD(a1, b1, k2r + 1);
      __builtin_amdgcn_sched_barrier(0);
      CMP_MMA(a0, b0);
      __builtin_amdgcn_sched_barrier(0);
      CMP_LOAD(a0, b0, k2r + 2);
      __builtin_amdgcn_sched_barrier(0);
      CMP_MMA(a1, b1);
      __builtin_amdgcn_sched_barrier(0);
    }
  }
#undef CMP_LOAD
#undef CMP_MMA
  float* red = reinterpret_cast<float*>(sm);
#pragma unroll
  for (int nt = 0; nt < 16; ++nt)
#pragma unroll
    for (int i = 0; i < 4; ++i) red[(w * 16 + quad * 4 + i) * 260 + nt * 16 + l15] = hid[nt][i];
  __syncthreads();
  u16 hb[16];
  {
    const float pb = posb[tid];
#pragma unroll
    for (int r = 0; r < 16; ++r) {
      const float v = red[r * 260 + tid] + red[(16 + r) * 260 + tid] + red[(32 + r) * 260 + tid] + red[(48 + r) * 260 + tid] + pb;
      hb[r] = f2bf(siluf_(v));
    }
  }
  __syncthreads();
  constexpr int HS = 264;
#pragma unroll
  for (int r = 0; r < 16; ++r) sm[r * HS + tid] = hb[r];
  __syncthreads();
  f4v res = fz();
#pragma unroll
  for (int ks = 0; ks < 8; ++ks) {
    const s8v a = ld8(sm + l15 * HS + ks * 32 + quad * 8);
    const s8v bw = ld8(W2 + (size_t)(w * 16 + l15) * 256 + ks * 32 + quad * 8);
    res = MFMA16(a, bw, res);
  }
  const int d = w * 16 + l15;
  const int jb = jt * 16 + quad * 4;
  if (kind == 0) {
    u16* kc = (u16*)(p.ws + O_KCMP) + ((size_t)(b * 4 + g) * 128) * 64;
#pragma unroll
    for (int i = 0; i < 4; ++i) kc[(size_t)(jb + i) * 64 + d] = (jb + i < 127) ? f2bf(res[i]) : (u16)0;
  } else {
    u16* vc = (u16*)(p.ws + O_VCT) + ((size_t)(b * 4 + g) * 64 + d) * 128 + jb;
    st4bf(vc, res[0], res[1], res[2], (jb + 3 < 127) ? res[3] : 0.f);
  }
  __syncthreads();
}

DI int q_next(unsigned* ctr) {
  __shared__ int q_slot;
  if (tidx() == 0) q_slot = (int)atomicAdd(ctr, 1u);
  __syncthreads();
  const int it = q_slot;
  __syncthreads();
  return it;
}
DI unsigned* q_counter(const Params& p, int pass, int phase, int rep) {
  return (unsigned*)(p.ws + O_BAR) + 3520 + 8 * (((pass * 4 + phase) * 2) + rep);
}

DI void phaseD(const Params& p, u16* smem, int sub, int pass, int rep) {
  constexpr int N_CMP = 2 * NBG * 32, N_CONV = NBG * 128 * 6, N_VTR = 2 * NBG * 128, N_DT = NBG * 16;
  constexpr int E1 = N_CONV, E2 = E1 + N_VTR, E3 = E2 + N_DT;
  const int ncb = ((int)gridDim.x >= 2 * N_CMP) ? N_CMP : 0;
  constexpr int TAIL = 320;
  int lo, hi, start, step;
  if (ncb == 0) {
    for (int it = blockIdx.x; it < N_CMP; it += gridDim.x)
      if (sub == 0 || sub == 1) cmp_item(p, it, smem);
    lo = 0; hi = E3; start = blockIdx.x; step = gridDim.x;
  } else if ((int)blockIdx.x < ncb) {
    if (sub == 0 || sub == 1) cmp_item(p, blockIdx.x, smem);
    lo = E3 - TAIL; hi = E3; start = lo + blockIdx.x; step = ncb;
  } else {
    lo = 0; hi = E3 - TAIL; start = (int)blockIdx.x - ncb; step = (int)gridDim.x - ncb;
  }
  for (int it = start; it < hi; it += step) {
    if (it < E1) { if (sub == 0 || sub == 2) conv_item(p, it); }
    else if (it < E2) { if (sub == 0 || sub == 3) vtr_item(p, it - E1); }
    else { if (sub == 0 || sub == 3) dt_item(p, it - E2, (float*)smem); }
  }
}

DI void ssd_item(const Params& p, int it, u16* sm) {
  const int tid = tidx(), lane = tid & 63, w = tid >> 6, l15 = lane & 15, quad = lane >> 4;
  const int qr = (it >> 3) & 3, cgx = ((it >> 5) << 3) | (it & 7);
  const int g = cgx & 3, c = (cgx >> 2) & 15, b = cgx >> 6;
  const int t0 = c * 128;
  const u16* xc = (const u16*)(p.ws + O_XC);
  const u16* xcT = (const u16*)(p.ws + O_XCT);
  const float* acsb = (const float*)(p.ws + O_ACS);
  const float* dtb = (const float*)(p.ws + O_DT);
  u16* yd = (u16*)(p.ws + O_YD);
  u16* stb = (u16*)(p.ws + O_ST);
  const u16* Bbase = xc + (size_t)(b * SEQ + t0) * 3072 + 2048 + g * 128;
  const u16* Cbase = xc + (size_t)(b * SEQ + t0) * 3072 + 2560 + g * 128;
  const u16* BT = xcT + ((size_t)b * 2560 + 2048 + g * 128) * TS + t0;
  const int h0 = g * 8 + qr * 2;
  constexpr int LS = 136;
  u16* Bs = sm;
  u16* Xs = sm + 128 * LS;
  float* As = reinterpret_cast<float*>(sm + 256 * LS);
  {
    s8v rb[8], rx[8];
#pragma unroll
    for (int r = 0; r < 8; ++r) {
      const int idx = tid + 256 * r, row = idx >> 4, seg = idx & 15;
      rb[r] = ld8(Bbase + (size_t)row * 3072 + seg * 8);
      rx[r] = ld8(xcT + ((size_t)b * 2560 + h0 * 64 + row) * TS + t0 + seg * 8);
    }
#pragma unroll
    for (int r = 0; r < 8; ++r) {
      const int idx = tid + 256 * r, row = idx >> 4, seg = idx & 15;
      *reinterpret_cast<s8v*>(Bs + row * LS + seg * 8) = rb[r];
      *reinterpret_cast<s8v*>(Xs + row * LS + seg * 8) = rx[r];
    }
    As[tid] = acsb[((size_t)b * 32 + h0 + (tid >> 7)) * SEQ + t0 + (tid & 127)];
  }
  __syncthreads();

#pragma unroll 1
  for (int li = 0; li < 2; ++li) {
    const int lt = li ? 7 - w : w;
    const int l = 16 * lt + l15;
    s8v cf[4];
#pragma unroll
    for (int ks = 0; ks < 4; ++ks) cf[ks] = ld8(Cbase + (size_t)l * 3072 + ks * 32 + quad * 8);
    f4v y[2][4];
#pragma unroll
    for (int hh = 0; hh < 2; ++hh)
#pragma unroll
      for (int pt = 0; pt < 4; ++pt) y[hh][pt] = fz();
    float acl[2];
#pragma unroll
    for (int hh = 0; hh < 2; ++hh) acl[hh] = As[hh * 128 + l];
    const int spn = lt >> 1;
    for (int sp = 0; sp <= spn; ++sp) {
      f4v cb[2];
#pragma unroll
      for (int si = 0; si < 2; ++si) {
        cb[si] = fz();
#pragma unroll
        for (int ks = 0; ks < 4; ++ks)
          cb[si] = MFMA16(ld8(Bs + (32 * sp + 16 * si + l15) * LS + ks * 32 + quad * 8), cf[ks], cb[si]);
      }
#pragma unroll
      for (int hh = 0; hh < 2; ++hh) {
        const float* ah = As + hh * 128;
        const f4v as0 = ldf4(ah + 32 * sp + quad * 4);
        const f4v as1 = ldf4(ah + 32 * sp + 16 + quad * 4);
        f4v m0, m1;
#pragma unroll
        for (int i = 0; i < 4; ++i) {
          const int s0 = 32 * sp + quad * 4 + i, s1 = s0 + 16;
          m0[i] = (s0 <= l) ? cb[0][i] * __expf(acl[hh] - as0[i]) : 0.f;
          m1[i] = (s1 <= l) ? cb[1][i] * __expf(acl[hh] - as1[i]) : 0.f;
        }
        const s8v pb = pack8(m0, m1);
#pragma unroll
        for (int pt = 0; pt < 4; ++pt) {
          const u16* xr = Xs + (hh * 64 + 16 * pt + l15) * LS + 32 * sp + quad * 4;
          y[hh][pt] = MFMA16(cat44(ld4(xr), ld4(xr + 16)), pb, y[hh][pt]);
        }
      }
    }
#pragma unroll
    for (int hh = 0; hh < 2; ++hh) {
      const float dinv = p.d_skip[h0 + hh] / dtb[((size_t)b * 32 + h0 + hh) * SEQ + t0 + l];
#pragma unroll
      for (int pt = 0; pt < 4; ++pt) {
#pragma unroll
        for (int i = 0; i < 4; ++i) y[hh][pt][i] += dinv * bf2f(Xs[(hh * 64 + 16 * pt + 4 * quad + i) * LS + l]);
      }
      u16* yrow = yd + (size_t)(b * SEQ + t0 + l) * 2048 + (h0 + hh) * 64;
      st8bf_pair(yrow, y[hh][0], y[hh][1], quad);
      st8bf_pair(yrow + 32, y[hh][2], y[hh][3], quad);
    }
  }
#pragma unroll 1
  for (int hh = 0; hh < 2; ++hh) {
    const int hd = h0 + hh;
    const float* ah = As + hh * 128;
    const float alast = ah[127];
    f4v st[2][4];
#pragma unroll
    for (int ni = 0; ni < 2; ++ni)
#pragma unroll
      for (int pt = 0; pt < 4; ++pt) st[ni][pt] = fz();
    s8v bt[4][2];
#pragma unroll
    for (int ks = 0; ks < 4; ++ks)
#pragma unroll
      for (int ni = 0; ni < 2; ++ni) bt[ks][ni] = ld8(BT + (size_t)(16 * (2 * w + ni) + l15) * TS + ks * 32 + quad * 8);
    __builtin_amdgcn_sched_barrier(0);
#pragma unroll
    for (int ks = 0; ks < 4; ++ks) {
      const f4v a0 = ldf4(ah + ks * 32 + quad * 8), a1 = ldf4(ah + ks * 32 + quad * 8 + 4);
      float wl[8];
#pragma unroll
      for (int j = 0; j < 4; ++j) { wl[j] = __expf(alast - a0[j]); wl[4 + j] = __expf(alast - a1[j]); }
#pragma unroll
      for (int pt = 0; pt < 4; ++pt) {
        const s8v raw = ld8(Xs + (hh * 64 + 16 * pt + l15) * LS + ks * 32 + quad * 8);
        float xf[8];
#pragma unroll
        for (int j = 0; j < 8; ++j) xf[j] = bfs(raw[j]) * wl[j];
        const s8v xw = pack8f(xf);
        st[0][pt] = MFMA16(bt[ks][0], xw, st[0][pt]);
        st[1][pt] = MFMA16(bt[ks][1], xw, st[1][pt]);
      }
    }
    u16* so = stb + (((size_t)(b * 16 + c) * 32 + hd) * 64) * 128;
#pragma unroll
    for (int pt = 0; pt < 4; ++pt) st8bf_pair(so + (size_t)(16 * pt + l15) * 128 + 32 * w, st[0][pt], st[1][pt], quad);
  }
  __syncthreads();
}

DI void cmpattn_item(const Params& p, int it, unsigned char* smraw) {
  const int tid = tidx(), lane = tid & 63, w = tid >> 6, l15 = lane & 15, quad = lane >> 4;
  const int tq2 = it & 63, g = (it >> 6) & 3, b = it >> 8;
  const int H = g * 4 + w;
  const float slope = exp2f(-0.5f * (float)(H + 1));
  const u16* P = (const u16*)(p.ws + O_P);
  const u16* kcg = (const u16*)(p.ws + O_KCMP) + (size_t)(b * 4 + g) * 128 * 64;
  const u16* vcg = (const u16*)(p.ws + O_VCT) + (size_t)(b * 4 + g) * 64 * 128;
  constexpr int KS = 72, VS = 136;
  u16* kcs = reinterpret_cast<u16*>(smraw);
  u16* vcs = kcs + 128 * KS;
  float* impA = reinterpret_cast<float*>(smraw + 36864);
  float* impB = impA + 2048;
  float* scl = impB + 2112;
  {
    s8v r0[4], r1[4];
#pragma unroll
    for (int r = 0; r < 4; ++r) {
      const int idx = tid + 256 * r;
      r0[r] = ld8(kcg + (size_t)(idx >> 3) * 64 + (idx & 7) * 8);
      r1[r] = ld8(vcg + (size_t)(idx >> 4) * 128 + (idx & 15) * 8);
    }
#pragma unroll
    for (int r = 0; r < 4; ++r) {
      const int idx = tid + 256 * r;
      *reinterpret_cast<s8v*>(kcs + (idx >> 3) * KS + (idx & 7) * 8) = r0[r];
      *reinterpret_cast<s8v*>(vcs + (idx >> 4) * VS + (idx & 15) * 8) = r1[r];
    }
  }
  __syncthreads();
#pragma unroll 1
  for (int sub = 0; sub < 2; ++sub) {
    const int q0 = tq2 * 32 + sub * 16;
    const int njt = (q0 >= 16) ? (((q0 - 16) >> 8) + 1) : 0;
    const int t = q0 + l15;
    const size_t trow = (size_t)(b * SEQ + t);
    s8v qf[2];
    qf[0] = ld8(P + trow * LDP + C_Q + H * 64 + quad * 8);
    qf[1] = ld8(P + trow * LDP + C_Q + H * 64 + 32 + quad * 8);
    f4v s[8];
#pragma unroll
    for (int jt = 0; jt < 8; ++jt) {
      s[jt] = fz();
      if (jt < njt) {
#pragma unroll
        for (int ks = 0; ks < 2; ++ks) s[jt] = MFMA16(ld8(kcs + (16 * jt + l15) * KS + ks * 32 + quad * 8), qf[ks], s[jt]);
      }
    }
    float mx = NEGB;
#pragma unroll
    for (int jt = 0; jt < 8; ++jt)
#pragma unroll
      for (int i = 0; i < 4; ++i) {
        const int j = 16 * jt + 4 * quad + i;
        const int dist = t - (16 * j + 31);
        const float sc = (dist >= 0) ? s[jt][i] * 0.125f - slope * (float)dist : NEGB;
        s[jt][i] = sc;
        mx = fmaxf(mx, sc);
      }
    mx = qmax(mx);
    float lsum = 0.f;
#pragma unroll
    for (int jt = 0; jt < 8; ++jt)
#pragma unroll
      for (int i = 0; i < 4; ++i) {
        const float e = (s[jt][i] > -1e29f) ? __expf(s[jt][i] - mx) : 0.f;
        s[jt][i] = e;
        lsum += e;
      }
    lsum = qsum(lsum);
    const float inv = lsum > 0.f ? 1.f / lsum : 0.f;
#pragma unroll
    for (int jt = 0; jt < 8; ++jt) {
      s[jt] = s[jt] * inv;
      const int k = 4 * jt + quad;
      impA[(w * 16 + l15) * 32 + k] = s[jt][0] + s[jt][1] + s[jt][2] + 0.5f * s[jt][3];
      impB[(w * 16 + l15) * 33 + k + 1] = 0.5f * s[jt][3];
    }
    f4v oc[4];
#pragma unroll
    for (int dt = 0; dt < 4; ++dt) oc[dt] = fz();
#pragma unroll
    for (int kp = 0; kp < 4; ++kp) {
      if (2 * kp < njt) {
        const s8v pb = pack8(s[2 * kp], s[2 * kp + 1]);
#pragma unroll
        for (int dt = 0; dt < 4; ++dt) {
          const u16* vr = vcs + (16 * dt + l15) * VS + 32 * kp + quad * 4;
          oc[dt] = MFMA16(cat44(ld4(vr), ld4(vr + 16)), pb, oc[dt]);
        }
      }
    }
    {
      const float g0 = sigmoidf_(bf2f(P[trow * LDP + C_G + H * 3 + 0]));
      u16* oo = (u16*)(p.ws + O_OCMP) + trow * 1024 + H * 64 + quad * 4;
#pragma unroll
      for (int dt = 0; dt < 4; ++dt) st4bf(oo + 16 * dt, oc[dt][0] * g0, oc[dt][1] * g0, oc[dt][2] * g0, oc[dt][3] * g0);
    }
    __syncthreads();
#pragma unroll
    for (int r = 0; r < 2; ++r) {
      const int idx = tid + 256 * r, q = idx >> 5, k = idx & 31;
      float im = 0.f;
#pragma unroll
      for (int hh = 0; hh < 4; ++hh) {
        im += impA[(hh * 16 + q) * 32 + k];
        if (k > 0) im += impB[(hh * 16 + q) * 33 + k];
      }
      const int blk = (q0 + q) >> 6;
      const bool forced = (k == 0) | (k == blk) | (k == blk - 1);
      scl[q * 32 + k] = forced ? im + 1000.f : ((k <= blk) ? im : -1.f);
    }
    __syncthreads();
    unsigned* sel = (unsigned*)(p.ws + O_SEL) + (size_t)(b * 4 + g) * SEQ + q0;
#pragma unroll
    for (int r = 0; r < 2; ++r) {
      const int idx = tid + 256 * r, q = idx >> 5, k = idx & 31;
      const float me = scl[q * 32 + k];
      int cnt = 0;
#pragma unroll
      for (int k2 = 0; k2 < 32; ++k2) {
        const float o = scl[q * 32 + k2];
        cnt += (o > me || (o == me && k2 < k)) ? 1 : 0;
      }
      const unsigned long long bal = __ballot(cnt < 16);
      if (k == 0) sel[q] = (unsigned)(bal >> (32 * (lane >> 5)));
    }
    __syncthreads();
  }
}

DI void phaseE(const Params& p, float* smf, int sub, int pass, int rep) {
  constexpr int N_SSD = NBG * 256;
  for (int it = blockIdx.x; it < N_SSD; it += gridDim.x) ssd_item(p, it, (u16*)smf);
}

DI void scan_item(const Params& p, int it) {
  const int gid = it * 256 + tidx();
  const int e = gid & 1023, hd = (gid >> 10) & 31, b = gid >> 15;
  u16* stb = (u16*)(p.ws + O_ST);
  const float* acs = (const float*)(p.ws + O_ACS) + ((size_t)b * 32 + hd) * SEQ;
  float carry[8];
#pragma unroll
  for (int j = 0; j < 8; ++j) carry[j] = 0.f;
  s8v sv[16];
  float dec[16];
#pragma unroll
  for (int c = 0; c < 16; ++c) {
    sv[c] = ld8(stb + (((size_t)(b * 16 + c) * 32 + hd) * 8192) + e * 8);
    dec[c] = acs[c * 128 + 127];
  }
#pragma unroll
  for (int c = 0; c < 16; ++c) {
    u16* ptr = stb + (((size_t)(b * 16 + c) * 32 + hd) * 8192) + e * 8;
    const float dc = __expf(dec[c]);
    const s8v pv = pack8f(carry);
#pragma unroll
    for (int j = 0; j < 8; ++j) carry[j] = carry[j] * dc + bfs(sv[c][j]);
    *reinterpret_cast<s8v*>(ptr) = pv;
  }
}

template <bool WIN, bool MASKED>
DI void attn_tile(const u16* Kt, const u16* Vt, const s8v (&qf)[2], const f4v (&cb)[4], int t, int kb, int q0, bool selb,
                  float slope2, float& m, float& l, f4v (&o)[4]) {
  const int lane = tidx() & 63, l15 = lane & 15, quad = lane >> 4;
  constexpr int LS = 72;
  const float bkb = slope2 * (float)(64 * kb - q0);
  f4v s[4];
#pragma unroll
  for (int kt = 0; kt < 4; ++kt) {
    s[kt] = cb[kt] + bkb;
    const u16* kr = Kt + (16 * kt + l15) * LS + quad * 8;
    s[kt] = MFMA16(ld8(kr), qf[0], s[kt]);
    s[kt] = MFMA16(ld8(kr + 32), qf[1], s[kt]);
  }
  if (MASKED) {
    const int dd0 = t - (64 * kb + 4 * quad);
#pragma unroll
    for (int kt = 0; kt < 4; ++kt)
#pragma unroll
      for (int i = 0; i < 4; ++i) {
        const int dd = dd0 - (16 * kt + i);
        const bool ok = WIN ? ((unsigned)dd < 512u) : (selb && dd >= 0);
        s[kt][i] = ok ? s[kt][i] : NEGB;
      }
  }
  float mx = fmaxf(fmaxf(fmaxf(s[0][0], s[0][1]), fmaxf(s[0][2], s[0][3])), fmaxf(fmaxf(s[1][0], s[1][1]), fmaxf(s[1][2], s[1][3])));
  mx = fmaxf(mx, fmaxf(fmaxf(fmaxf(s[2][0], s[2][1]), fmaxf(s[2][2], s[2][3])), fmaxf(fmaxf(s[3][0], s[3][1]), fmaxf(s[3][2], s[3][3]))));
  mx = qmax(mx);
  if (__ballot(mx > m) != 0ull) {
    const float mn = fmaxf(m, mx);
    const float alpha = __builtin_amdgcn_exp2f(m - mn);
    m = mn;
    l *= alpha;
#pragma unroll
    for (int dt = 0; dt < 4; ++dt) o[dt] = o[dt] * alpha;
  }
  float ps = 0.f;
#pragma unroll
  for (int kt = 0; kt < 4; ++kt)
#pragma unroll
    for (int i = 0; i < 4; ++i) {
      float e = __builtin_amdgcn_exp2f(s[kt][i] - m);
      if (MASKED) e = (s[kt][i] > -1e29f) ? e : 0.f;
      s[kt][i] = e;
      ps += e;
    }
  l += ps;
#pragma unroll
  for (int kp = 0; kp < 2; ++kp) {
    const s8v pb = pack8(s[2 * kp], s[2 * kp + 1]);
#pragma unroll
    for (int dt = 0; dt < 4; ++dt) {
      const u16* vr = Vt + (16 * dt + l15) * LS + 32 * kp + quad * 4;
      o[dt] = MFMA16(cat44(ld4(vr), ld4(vr + 16)), pb, o[dt]);
    }
  }
}

template <bool WIN, int AV>
DI void attn_pass(const u16* __restrict__ Kbase  , const u16* __restrict__ VT  ,
                  const s8v (&qf)[2], const f4v (&cb)[4], int t, int q0, unsigned mymask, float slope2, unsigned tiles, f4v (&o)[4],
                  float& lout, u16* sm) {
  const int tid = tidx();
  constexpr int LS = 72, TB = 64 * LS;
  const int lrow = tid >> 3, lseg = tid & 7;
  const int blk = q0 >> 6;
  float m = NEGB, l = 0.f;
#pragma unroll
  for (int dt = 0; dt < 4; ++dt) o[dt] = fz();
  const u16* kp0 = Kbase + (size_t)lrow * LDP + lseg * 8;
  const u16* vp0 = VT + (size_t)lrow * TS + lseg * 8;
#define AT_LOAD(RK, RV, KB)                                                            \
  do {                                                                                 \
    RK[0] = ld8(kp0 + (size_t)(64 * (KB)) * LDP);                                       \
    RK[1] = ld8(kp0 + (size_t)(64 * (KB) + 32) * LDP);                                  \
    RV[0] = ld8(vp0 + 64 * (KB));                                                       \
    RV[1] = ld8(vp0 + (size_t)32 * TS + 64 * (KB));                                    \
  } while (0)
#define AT_STORE(RK, RV, BUF)                                                          \
  do {                                                                                 \
    u16* _d = sm + (BUF) * 2 * TB + lrow * LS + lseg * 8;                               \
    *reinterpret_cast<s8v*>(_d) = RK[0];                                                \
    *reinterpret_cast<s8v*>(_d + 32 * LS) = RK[1];                                      \
    *reinterpret_cast<s8v*>(_d + TB) = RV[0];                                           \
    *reinterpret_cast<s8v*>(_d + TB + 32 * LS) = RV[1];                                 \
  } while (0)
#define AT_POPL() do { if (tl) { kbl = 31 - __builtin_clz(tl); tl &= ~(1u << kbl); } } while (0)
#define AT_STEP(RK, RV)                                                                                              \
  {                                                                                                                  \
    const int kb = 31 - __builtin_clz(tc);                                                                            \
    tc &= ~(1u << kb);                                                                                                \
    const u16* Kt = sm + cur * 2 * TB;                                                                                \
    const bool selb = WIN ? true : (((mymask >> kb) & 1u) != 0u);                                                     \
    const bool need = WIN ? ((kb == blk) || (64 * kb <= q0 - 497)) : ((kb == blk) || (__ballot(selb) != ~0ull));      \
    if (AV != 2) {                                                                                                    \
    if (need) attn_tile<WIN, true>(Kt, Kt + TB, qf, cb, t, kb, q0, selb, slope2, m, l, o);                            \
    else attn_tile<WIN, false>(Kt, Kt + TB, qf, cb, t, kb, q0, selb, slope2, m, l, o);                                \
    }                                                                                                                 \
    if (AV != 1) {                                                                                                    \
    if (tc) AT_STORE(RK, RV, cur ^ 1);                                                                                \
    AT_POPL();                                                                                                        \
    AT_LOAD(RK, RV, kbl);                                                                                             \
    }                                                                                                                 \
    __syncthreads();                                                                                                  \
    if (!tc) break;                                                                                                   \
    cur ^= 1;                                                                                                         \
  }
  unsigned tc = tiles, tl = tiles;
  s8v ak[2], av[2], bk[2], bv[2];
  int kbl = 0;
  AT_POPL();
  AT_LOAD(ak, av, kbl);
  AT_STORE(ak, av, 0);
  AT_POPL();
  AT_LOAD(ak, av, kbl);
  AT_POPL();
  AT_LOAD(bk, bv, kbl);
  __syncthreads();
  int cur = 0;
  while (true) {
    AT_STEP(ak, av)
    AT_STEP(bk, bv)
  }
#undef AT_LOAD
#undef AT_STORE
#undef AT_POPL
#undef AT_STEP
  lout = qsum(l);
}

DI void cmp_part(const Params& p, int b, int g, int q0, const s8v (&qf)[2], unsigned char* smraw, f4v (&oc)[4], unsigned& mymask) {
  const int tid = tidx(), lane = tid & 63, w = tid >> 6, l15 = lane & 15, quad = lane >> 4;
  const int H = g * 4 + w;
  const float slope = exp2f(-0.5f * (float)(H + 1));
  const u16* P = (const u16*)(p.ws + O_P);
  const u16* kcg = (const u16*)(p.ws + O_KCMP) + (size_t)(b * 4 + g) * 128 * 64;
  const u16* vcg = (const u16*)(p.ws + O_VCT) + (size_t)(b * 4 + g) * 64 * 128;
  constexpr int KS = 72, VS = 136;
  u16* kcs = reinterpret_cast<u16*>(smraw);
  u16* vcs = kcs + 128 * KS;
  float* impA = reinterpret_cast<float*>(smraw + 36864);
  float* impB = impA + 2048;
  float* scl = impB + 2112;
  unsigned* selm = reinterpret_cast<unsigned*>(scl + 512);
  const int njt = (q0 >= 16) ? (((q0 - 16) >> 8) + 1) : 0;
  {
    s8v r0[4], r1[4];
#pragma unroll
    for (int r = 0; r < 4; ++r) {
      const int idx = tid + 256 * r;
      r0[r] = ld8(kcg + (size_t)(idx >> 3) * 64 + (idx & 7) * 8);
      r1[r] = ld8(vcg + (size_t)(idx >> 4) * 128 + (idx & 15) * 8);
    }
#pragma unroll
    for (int r = 0; r < 4; ++r) {
      const int idx = tid + 256 * r;
      *reinterpret_cast<s8v*>(kcs + (idx >> 3) * KS + (idx & 7) * 8) = r0[r];
      *reinterpret_cast<s8v*>(vcs + (idx >> 4) * VS + (idx & 15) * 8) = r1[r];
    }
  }
  __syncthreads();
  const int t = q0 + l15;
  const size_t trow = (size_t)(b * SEQ + t);
  f4v s[8];
#pragma unroll
  for (int jt = 0; jt < 8; ++jt) {
    s[jt] = fz();
    if (jt < njt) {
#pragma unroll
      for (int ks = 0; ks < 2; ++ks) s[jt] = MFMA16(ld8(kcs + (16 * jt + l15) * KS + ks * 32 + quad * 8), qf[ks], s[jt]);
    }
  }
  float mx = NEGB;
#pragma unroll
  for (int jt = 0; jt < 8; ++jt)
#pragma unroll
    for (int i = 0; i < 4; ++i) {
      const int j = 16 * jt + 4 * quad + i;
      const int dist = t - (16 * j + 31);
      const float sc = (dist >= 0) ? s[jt][i] * 0.125f - slope * (float)dist : NEGB;
      s[jt][i] = sc;
      mx = fmaxf(mx, sc);
    }
  mx = qmax(mx);
  float lsum = 0.f;
#pragma unroll
  for (int jt = 0; jt < 8; ++jt)
#pragma unroll
    for (int i = 0; i < 4; ++i) {
      const float e = (s[jt][i] > -1e29f) ? __expf(s[jt][i] - mx) : 0.f;
      s[jt][i] = e;
      lsum += e;
    }
  lsum = qsum(lsum);
  const float inv = lsum > 0.f ? 1.f / lsum : 0.f;
#pragma unroll
  for (int jt = 0; jt < 8; ++jt) {
    s[jt] = s[jt] * inv;
    const int k = 4 * jt + quad;
    impA[(w * 16 + l15) * 32 + k] = s[jt][0] + s[jt][1] + s[jt][2] + 0.5f * s[jt][3];
    impB[(w * 16 + l15) * 33 + k + 1] = 0.5f * s[jt][3];
  }
#pragma unroll
  for (int dt = 0; dt < 4; ++dt) oc[dt] = fz();
#pragma unroll
  for (int kp = 0; kp < 4; ++kp) {
    if (2 * kp < njt) {
      const s8v pb = pack8(s[2 * kp], s[2 * kp + 1]);
#pragma unroll
      for (int dt = 0; dt < 4; ++dt) {
        const u16* vr = vcs + (16 * dt + l15) * VS + 32 * kp + quad * 4;
        oc[dt] = MFMA16(cat44(ld4(vr), ld4(vr + 16)), pb, oc[dt]);
      }
    }
  }
  {
    const float g0 = sigmoidf_(bf2f(P[trow * LDP + C_G + H * 3 + 0]));
#pragma unroll
    for (int dt = 0; dt < 4; ++dt) oc[dt] = oc[dt] * g0;
  }
  __syncthreads();
#pragma unroll
  for (int r = 0; r < 2; ++r) {
    const int idx = tid + 256 * r, q = idx >> 5, k = idx & 31;
    float im = 0.f;
#pragma unroll
    for (int hh = 0; hh < 4; ++hh) {
      im += impA[(hh * 16 + q) * 32 + k];
      if (k > 0) im += impB[(hh * 16 + q) * 33 + k];
    }
    const int blk = (q0 + q) >> 6;
    const bool forced = (k == 0) | (k == blk) | (k == blk - 1);
    scl[q * 32 + k] = forced ? im + 1000.f : ((k <= blk) ? im : -1.f);
  }
  __syncthreads();
#pragma unroll
  for (int r = 0; r < 2; ++r) {
    const int idx = tid + 256 * r, q = idx >> 5, k = idx & 31;
    const float me = scl[q * 32 + k];
    int cnt = 0;
#pragma unroll
    for (int k2 = 0; k2 < 32; ++k2) {
      const float o = scl[q * 32 + k2];
      cnt += (o > me || (o == me && k2 < k)) ? 1 : 0;
    }
    const unsigned long long bal = __ballot(cnt < 16);
    if (k == 0) selm[q] = (unsigned)(bal >> (32 * (lane >> 5)));
  }
  __syncthreads();
  mymask = selm[l15];
  __syncthreads();
}

template <int AV>
DI void attn_item(const Params& p, int it, u16* sm) {
  const int tid = tidx(), lane = tid & 63, w = tid >> 6, l15 = lane & 15, quad = lane >> 4;
  const int tq = it & 127, g = (it >> 7) & 3, b = it >> 9;
  const int q0 = tq * 16;
  const int H = g * 4 + w;
  const float slope2 = exp2f(-0.5f * (float)(H + 1)) * 1.4426950408889634f;
  constexpr float SCALE2 = 0.125f * 1.4426950408889634f;
  const u16* P = (const u16*)(p.ws + O_P);
  const int t = q0 + l15;
  const size_t trow = (size_t)(b * SEQ + t);
  s8v qf[2], qraw[2];
#pragma unroll
  for (int ks = 0; ks < 2; ++ks) {
    const s8v raw = ld8(P + trow * LDP + C_Q + H * 64 + ks * 32 + quad * 8);
    qraw[ks] = raw;
    float qs[8];
#pragma unroll
    for (int j = 0; j < 8; ++j) qs[j] = bfs(raw[j]) * SCALE2;
    qf[ks] = pack8f(qs);
  }
  f4v ocm[4];
  unsigned mymask;
  cmp_part(p, b, g, q0, qraw, reinterpret_cast<unsigned char*>(sm), ocm, mymask);
  f4v cb[4];
#pragma unroll
  for (int kt = 0; kt < 4; ++kt)
#pragma unroll
    for (int i = 0; i < 4; ++i) cb[kt][i] = slope2 * (float)(16 * kt + 4 * quad + i);
  const int blk = q0 >> 6;
  const unsigned upto = (blk >= 31) ? 0xffffffffu : ((2u << blk) - 1u);
  unsigned um = mymask;
#pragma unroll
  for (int o = 1; o < 64; o <<= 1) um |= (unsigned)__shfl_xor((int)um, o);
  um = (unsigned)__builtin_amdgcn_readfirstlane((int)(um & upto));
  f4v os[4], ow[4];
  float ls, lw;
  attn_pass<false, AV>(P + (size_t)(b * SEQ) * LDP + C_KS + g * 64, (const u16*)(p.ws + O_VST) + (size_t)(b * 4 + g) * 64 * TS, qf, cb, t,
                   q0, mymask, slope2, um, os, ls, sm);
  const int wlo = (q0 - 511 > 0 ? q0 - 511 : 0) >> 6;
  const unsigned wm_ = (unsigned)__builtin_amdgcn_readfirstlane((int)(upto & ~((1u << wlo) - 1u)));
  attn_pass<true, AV>(P + (size_t)(b * SEQ) * LDP + C_KW + g * 64, (const u16*)(p.ws + O_VWT) + (size_t)(b * 4 + g) * 64 * TS, qf, cb, t,
                  q0, 0u, slope2, wm_, ow, lw, sm);
  if (AV != 0) { if (ls + lw + os[0][0] + ow[3][3] != 12345.678f) return; }
  const float g1 = sigmoidf_(bf2f(P[trow * LDP + C_G + H * 3 + 1])) / ls;
  const float g2 = sigmoidf_(bf2f(P[trow * LDP + C_G + H * 3 + 2])) / lw;
  const u16* za = P + trow * LDP + C_ZA + H * 64;
  u16* oo = (u16*)(p.ws + O_O) + trow * 1024 + H * 64;
  f4v rr[4];
  s4v zq[4];
  ld8bf_pair(za, quad, zq[0], zq[1]);
  ld8bf_pair(za + 32, quad, zq[2], zq[3]);
#pragma unroll
  for (int dt = 0; dt < 4; ++dt) {
#pragma unroll
    for (int i = 0; i < 4; ++i) rr[dt][i] = (ocm[dt][i] + g1 * os[dt][i] + g2 * ow[dt][i]) * siluf_(bfs(zq[dt][i]));
  }
  st8bf_pair(oo, rr[0], rr[1], quad);
  st8bf_pair(oo + 32, rr[2], rr[3], quad);
}

DI void phaseF(const Params& p, bool noscan, u16* sm, int pass, int rep) {
  constexpr int N_AT = NBG * 512, N_SC = NBG * 32 * 1024 / 256;
  unsigned* ctr = q_counter(p, pass, 2, rep);
  const int nend = noscan ? N_AT : N_AT + N_SC;
  bool first = true;
  while (true) {
    const int it = first ? (int)blockIdx.x : q_next(ctr) + (int)gridDim.x;
    first = false;
    if (it >= nend) break;
    if (it < N_AT) {
      const int tq = 127 - (it >> 3), gb = it & 7;
      if (APROBE != 0 && rep) attn_item<APROBE>(p, (gb >> 2) * 512 + (gb & 3) * 128 + tq, sm);
      else attn_item<0>(p, (gb >> 2) * 512 + (gb & 3) * 128 + tq, sm);
    } else scan_item(p, it - N_AT);
  }
}

DI void phaseG(const Params& p, float* smf) {
  const int tid = tidx(), lane = tid & 63, w = tid >> 6, l15 = lane & 15, quad = lane >> 4;
  const u16* xc = (const u16*)(p.ws + O_XC);
  const u16* P = (const u16*)(p.ws + O_P);
  const u16* yd = (const u16*)(p.ws + O_YD);
  const u16* stb = (const u16*)(p.ws + O_ST);
  const float* acsb = (const float*)(p.ws + O_ACS);
  u16* yn = (u16*)(p.ws + O_YN);
  for (int it = blockIdx.x; it < NBG * 256; it += gridDim.x) {
    const int lq = (it >> 3) & 3, cgx = ((it >> 5) << 3) | (it & 7);
    const int g = cgx & 3, c = (cgx >> 2) & 15, b = cgx >> 6;
    const int t0 = b * SEQ + c * 128 + 32 * lq + l15;
    s8v cf[2][4];
#pragma unroll
    for (int li = 0; li < 2; ++li)
#pragma unroll
      for (int ks = 0; ks < 4; ++ks) cf[li][ks] = ld8(xc + (size_t)(t0 + 16 * li) * 3072 + 2560 + g * 128 + ks * 32 + quad * 8);
    f4v y[2][4][2];
    f4v* park = reinterpret_cast<f4v*>(smf + 1024);
    float ss[2] = {0.f, 0.f};
#pragma unroll
    for (int hh = 0; hh < 2; ++hh) {
      const int hd = g * 8 + 2 * w + hh;
      const u16* pv = stb + (((size_t)(b * 16 + c) * 32 + hd) * 64) * 128;
      s8v pf[4][4];
      s4v d4[4], z4[4];
#pragma unroll
      for (int pt = 0; pt < 4; ++pt) {
#pragma unroll
        for (int ks = 0; ks < 4; ++ks) pf[pt][ks] = ld8(pv + (size_t)(16 * pt + l15) * 128 + ks * 32 + quad * 8);
      }
#pragma unroll
      for (int pp = 0; pp < 2; ++pp) {
        ld8bf_pair(yd + (size_t)t0 * 2048 + hd * 64 + 32 * pp, quad, d4[2 * pp], d4[2 * pp + 1]);
        ld8bf_pair(P + (size_t)t0 * LDP + C_Z + hd * 64 + 32 * pp, quad, z4[2 * pp], z4[2 * pp + 1]);
      }
      float ea[2];
#pragma unroll
      for (int li = 0; li < 2; ++li) ea[li] = __expf(acsb[((size_t)b * 32 + hd) * SEQ + (t0 + 16 * li - b * SEQ)]);
      __builtin_amdgcn_sched_barrier(0);
#pragma unroll
      for (int pt = 0; pt < 4; ++pt) {
        y[hh][pt][0] = fz(); y[hh][pt][1] = fz();
#pragma unroll
        for (int ks = 0; ks < 4; ++ks) {
          y[hh][pt][0] = MFMA16(pf[pt][ks], cf[0][ks], y[hh][pt][0]);
          y[hh][pt][1] = MFMA16(pf[pt][ks], cf[1][ks], y[hh][pt][1]);
        }
      }
      __builtin_amdgcn_sched_barrier(0);
      s4v d5[4], z5[4];
#pragma unroll
      for (int pp = 0; pp < 2; ++pp) {
        ld8bf_pair(yd + (size_t)(t0 + 16) * 2048 + hd * 64 + 32 * pp, quad, d5[2 * pp], d5[2 * pp + 1]);
        ld8bf_pair(P + (size_t)(t0 + 16) * LDP + C_Z + hd * 64 + 32 * pp, quad, z5[2 * pp], z5[2 * pp + 1]);
      }
      __builtin_amdgcn_sched_barrier(0);
#pragma unroll
      for (int pt = 0; pt < 4; ++pt)
#pragma unroll
        for (int i = 0; i < 4; ++i) {
          const float v = (bfs(d4[pt][i]) + y[hh][pt][0][i] * ea[0]) * siluf_(bfs(z4[pt][i]));
          y[hh][pt][0][i] = v;
          ss[0] += v * v;
        }
      __builtin_amdgcn_sched_barrier(0);
#pragma unroll
      for (int pt = 0; pt < 4; ++pt)
#pragma unroll
        for (int i = 0; i < 4; ++i) {
          const float v = (bfs(d5[pt][i]) + y[hh][pt][1][i] * ea[1]) * siluf_(bfs(z5[pt][i]));
          y[hh][pt][1][i] = v;
          ss[1] += v * v;
        }
      if (hh == 0) {
#pragma unroll
        for (int pt = 0; pt < 4; ++pt) { park[(2 * pt) * 256 + tid] = y[0][pt][0]; park[(2 * pt + 1) * 256 + tid] = y[0][pt][1]; }
      }
    }
    ss[0] = qsum(ss[0]); ss[1] = qsum(ss[1]);
    if (quad == 0) { smf[w * 32 + l15] = ss[0]; smf[w * 32 + 16 + l15] = ss[1]; }
    f4v gnv[2][4];
#pragma unroll
    for (int hh = 0; hh < 2; ++hh)
#pragma unroll
      for (int pt = 0; pt < 4; ++pt) gnv[hh][pt] = ldf4(p.g_ssm_norm + (g * 8 + 2 * w + hh) * 64 + 16 * pt + quad * 4);
    __syncthreads();
    float rs[2];
#pragma unroll
    for (int li = 0; li < 2; ++li) {
      const float tot = smf[16 * li + l15] + smf[32 + 16 * li + l15] + smf[64 + 16 * li + l15] + smf[96 + 16 * li + l15];
      rs[li] = rsqrtf(tot * (1.f / 512.f) + EPS);
    }
#pragma unroll
    for (int hh = 0; hh < 2; ++hh) {
      const int hd = g * 8 + 2 * w + hh;
#pragma unroll
      for (int li = 0; li < 2; ++li) {
        f4v nv[4];
#pragma unroll
        for (int pt = 0; pt < 4; ++pt) {
          const f4v v = (hh == 0) ? park[(2 * pt + li) * 256 + tid] : y[1][pt][li];
          nv[pt] = v * gnv[hh][pt] * rs[li];
        }
        u16* nrow = yn + (size_t)(t0 + 16 * li) * 2048 + hd * 64;
        st8bf_pair(nrow, nv[0], nv[1], quad);
        st8bf_pair(nrow + 32, nv[2], nv[3], quad);
      }
    }
    __syncthreads();
  }
}

DI void phaseH(const Params& p, u16* smem) {
  const int lane = tidx() & 63, w = tidx() >> 6, wm = w >> 1, wn = w & 1, l15 = lane & 15, quad = lane >> 4;
  const u16* P = (const u16*)(p.ws + O_P);
  u16* mg = (u16*)(p.ws + O_H);
  float* tmp = (float*)(p.ws + O_YD);
  constexpr int MT = MP / 128;
  for (int it = blockIdx.x; it < MT * 16; it += gridDim.x) {
    const int mi = it % MT, ni = it / MT;
    f4v acc[4][2];
    u2v keep[4][2];
    zero_acc<2>(acc);
    gemm_k64(acc, (const u16*)(p.ws + O_YN), 2048, (const u16*)(p.ws + O_WSSM), 2048, 2048, mi * 128, ni * 64, smem);
    s4v gq[4][2];
#pragma unroll
    for (int mt = 0; mt < 4; ++mt)
      ld8bf_pair(P + (size_t)(mi * 128 + wm * 64 + mt * 16 + l15) * LDP + C_MG + ni * 64 + wn * 32, quad, gq[mt][0], gq[mt][1]);
    __builtin_amdgcn_sched_barrier(0);
#pragma unroll
    for (int mt = 0; mt < 4; ++mt)
#pragma unroll
      for (int nt = 0; nt < 2; ++nt) {
        const int m = mi * 128 + wm * 64 + mt * 16 + l15, n = ni * 64 + wn * 32 + nt * 16 + quad * 4;
        const s4v g0 = gq[mt][nt];
        f4v r;
#pragma unroll
        for (int i = 0; i < 4; ++i) r[i] = sigmoidf_(bfs(g0[i])) * acc[mt][nt][i];
        u2v kp = {pk2(r[0], r[1]), pk2(r[2], r[3])};
        keep[mt][nt] = kp;
      }
    zero_acc<2>(acc);
    gemm_k64(acc, (const u16*)(p.ws + O_O), 1024, (const u16*)(p.ws + O_WNSA), 1024, 1024, mi * 128, ni * 64, smem);
    f4v tq[4][2];
#pragma unroll
    for (int mt = 0; mt < 4; ++mt)
      ld8bf_pair(P + (size_t)(mi * 128 + wm * 64 + mt * 16 + l15) * LDP + C_MG + 1024 + ni * 64 + wn * 32, quad, gq[mt][0], gq[mt][1]);
#pragma unroll
    for (int mt = 0; mt < 4; ++mt)
#pragma unroll
      for (int nt = 0; nt < 2; ++nt) {
        const u2v kp = keep[mt][nt];
        f4v tv = {__uint_as_float(kp[0] << 16), __uint_as_float(kp[0] & 0xffff0000u), __uint_as_float(kp[1] << 16),
                  __uint_as_float(kp[1] & 0xffff0000u)};
        tq[mt][nt] = tv;
      }
    __builtin_amdgcn_sched_barrier(0);
#pragma unroll
    for (int mt = 0; mt < 4; ++mt) {
      f4v rr[2];
#pragma unroll
      for (int nt = 0; nt < 2; ++nt) {
        const s4v g1 = gq[mt][nt];
        const f4v t0 = tq[mt][nt];
#pragma unroll
        for (int i = 0; i < 4; ++i) rr[nt][i] = t0[i] + sigmoidf_(bfs(g1[i])) * acc[mt][nt][i];
      }
      st8bf_pair(mg + (size_t)(mi * 128 + wm * 64 + mt * 16 + l15) * 1024 + ni * 64 + wn * 32, rr[0], rr[1], quad);
    }
  }
}

DI void phaseI(const Params& p, u16* smem) {
  const int lane = tidx() & 63, w = tidx() >> 6, wm = w >> 1, wn = w & 1, l15 = lane & 15, quad = lane >> 4;
  u16* outb = (u16*)(p.ws + O_OUTF);
  float* rsq = (float*)(p.ws + O_RSQ);
  constexpr int MT = MP / 128;
  for (int it = blockIdx.x; it < MT * 16; it += gridDim.x) {
    const int mi = it % MT, ni = it / MT;
    f4v acc[4][2];
    zero_acc<2>(acc);
    gemm_k64(acc, (const u16*)(p.ws + O_H), 1024, (const u16*)(p.ws + O_WOUT), 1024, 1024, mi * 128, ni * 64, smem);
#pragma unroll
    for (int mt = 0; mt < 4; ++mt) {
      const int m = mi * 128 + wm * 64 + mt * 16 + l15;
      float ss = 0.f;
#pragma unroll
      for (int nt = 0; nt < 2; ++nt) {
        const f4v v = acc[mt][nt];
        ss += v[0] * v[0] + v[1] * v[1] + v[2] * v[2] + v[3] * v[3];
      }
      st8bf_pair(outb + (size_t)m * 1024 + ni * 64 + wn * 32, acc[mt][0], acc[mt][1], quad);
      ss = qsum(ss);
      if (quad == 0) rsq[(size_t)m * 32 + ni * 2 + wn] = ss;
    }
  }
}

DI void phaseJ(const Params& p, int pass) {
  const int tid = tidx(), lane = tid & 63, w = tid >> 6;
  const u16* outb = (const u16*)(p.ws + O_OUTF);
  const float* rsq = (const float*)(p.ws + O_RSQ);
  const float* ada = (const float*)(p.ws + O_ADA);
  for (int it = blockIdx.x; it < MP / 4; it += gridDim.x) {
    const int r = it * 4 + w;
    const int tg = pass * MP + r, b = tg >> 11;
    float part = (lane < 32) ? rsq[(size_t)r * 32 + lane] : 0.f;
    s4v ob[4];
    f4v xv[4], gp[4], gt[4];
#pragma unroll
    for (int i = 0; i < 4; ++i) {
      const int c0 = i * 256 + lane * 4;
      ob[i] = ld4(outb + (size_t)r * 1024 + c0);
      xv[i] = ldf4(p.x + (size_t)tg * 1024 + c0);
      gp[i] = ldf4(p.g_post + c0);
      gt[i] = ldf4(ada + b * 3072 + 2048 + c0);
    }
    __builtin_amdgcn_sched_barrier(0);
#pragma unroll
    for (int o = 1; o < 64; o <<= 1) part += __shfl_xor(part, o);
    const float rstd = rsqrtf(part * (1.f / 1024.f) + EPS);
#pragma unroll
    for (int i = 0; i < 4; ++i) {
      const int c0 = i * 256 + lane * 4;
      f4v rr;
#pragma unroll
      for (int k = 0; k < 4; ++k) rr[k] = xv[i][k] + gt[i][k] * (bfs(ob[i][k]) * rstd * gp[i][k]);
      *reinterpret_cast<f4v*>(p.out + (size_t)tg * 1024 + c0) = rr;
    }
  }
}

#define XB_TMO      128
#define XB_XCNT(j)  (256  + 64 * (j))
#define XB_XSUB(j)  (1280 + 64 * (j))
#define XB_XGEN(j)  (2304 + 64 * (j))
#define XB_TOP      3328
#define XB_TOPGEN   3392
#define XCD_BAR_WORDS 3456
#define XB_SPIN_CAP (1u << 18)
#define LAS __attribute__((address_space(3)))
DI unsigned xb_ld(unsigned* p)              { return __hip_atomic_load(p, __ATOMIC_RELAXED, __HIP_MEMORY_SCOPE_AGENT); }
DI unsigned xb_add(unsigned* p, unsigned v) { return __hip_atomic_fetch_add(p, v, __ATOMIC_RELAXED, __HIP_MEMORY_SCOPE_AGENT); }
DI unsigned xb_xcc_id() { return (unsigned)__builtin_amdgcn_s_getreg((3 << 11) | 20) & 0xFu; }
#define XB_SPIN(cond, bar) do { unsigned _sp = 0; while (cond) { __builtin_amdgcn_s_sleep(1); \
    if ((++_sp & 255u) == 0u) { if (xb_ld(&(bar)[XB_TMO])) break; if (_sp > XB_SPIN_CAP) { atomicAdd(&(bar)[XB_TMO], 1u); break; } } } } while (0)
struct XcdBarrier { unsigned* bar; unsigned x; volatile LAS unsigned* st; };
DI XcdBarrier xcd_barrier_post(unsigned* bar, volatile LAS unsigned* st) {
  XcdBarrier b; b.bar = bar; b.x = xb_xcc_id(); b.st = st;
  if (threadIdx.x == 0) (void)xb_add(&bar[XB_XCNT(b.x)], 1u);
  return b;
}
DI void xcd_barrier_complete(unsigned* bar, unsigned x, unsigned& nloc, unsigned& nx) {
  const unsigned G = gridDim.x * gridDim.y * gridDim.z;
  unsigned sum, cnt, mine, sp = 0u;
  for (;;) {
    sum = 0u; cnt = 0u; mine = 0u;
#pragma unroll
    for (unsigned j = 0; j < 16; ++j) { const unsigned c = xb_ld(&bar[XB_XCNT(j)]); sum += c; cnt += (c > 0u) ? 1u : 0u; mine = (j == x) ? c : mine; }
    if (sum == G) break;
    __builtin_amdgcn_s_sleep(1);
    if ((++sp & 255u) == 0u) { if (xb_ld(&bar[XB_TMO])) break; if (sp > XB_SPIN_CAP) { atomicAdd(&bar[XB_TMO], 1u); break; } }
  }
  nloc = mine > 0u ? mine : 1u; nx = cnt > 0u ? cnt : 1u;
}
DI void xcd_barrier(const XcdBarrier& b) {
  asm volatile("s_waitcnt vmcnt(0)" ::: "memory");
  __syncthreads();
  if (threadIdx.x == 0) {
    unsigned* bar = b.bar;
    __builtin_amdgcn_s_waitcnt(0);
    unsigned nloc = b.st[0], nx = b.st[1];
    if (nloc == 0u) { xcd_barrier_complete(bar, b.x, nloc, nx); b.st[0] = nloc; b.st[1] = nx; }
    const unsigned old = xb_add(&bar[XB_XSUB(b.x)], 1u);
    const unsigned gen = old / nloc;
    if (old + 1u == (gen + 1u) * nloc) {
      __builtin_amdgcn_fence(__ATOMIC_RELEASE, "agent");
      asm volatile("s_waitcnt vmcnt(0)" ::: "memory");
      const unsigned og = xb_add(&bar[XB_TOP], 1u);
      const unsigned tg = og / nx;
      if (og + 1u == (tg + 1u) * nx) xb_add(&bar[XB_TOPGEN], 1u);
      else XB_SPIN(xb_ld(&bar[XB_TOPGEN]) == tg, bar);
      __builtin_amdgcn_fence(__ATOMIC_ACQUIRE, "agent");
      xb_add(&bar[XB_XGEN(b.x)], 1u);
      asm volatile("s_waitcnt vmcnt(0)" ::: "memory");
    } else {
      XB_SPIN(xb_ld(&bar[XB_XGEN(b.x)]) == gen, bar);
      __builtin_amdgcn_fence(__ATOMIC_ACQUIRE, "agent");
      asm volatile("s_waitcnt vmcnt(0)" ::: "memory");
    }
  }
  __syncthreads();
}

constexpr int PH_PER_PASS = 8;
constexpr int N_PHASES = 2 + NPASS * PH_PER_PASS;

constexpr int REP_MASK = 0;
constexpr int REP_SUB = 0;
constexpr int REP_A = 0;
constexpr int CPROBE = 0;
__global__ void __launch_bounds__(256, 2) mega_kernel(Params p, int ph_lo, int ph_hi) {
  __shared__ __attribute__((aligned(16))) unsigned char smem[73728];
  __shared__ uint4 xb_words;
  cg::grid_group grid = cg::this_grid();
  if (threadIdx.x == 0) xb_words = make_uint4(0u, 0u, 0u, 0u);
  __syncthreads();
  const XcdBarrier xb = xcd_barrier_post((unsigned*)(p.ws + O_BAR), (volatile LAS unsigned*)&xb_words);
  for (int ph = ph_lo; ph < ph_hi; ++ph) {
    if (ph == 0) {
      phaseA(p, smem);
      if (REP_A) { xcd_barrier(xb); phaseA(p, smem); }
    } else if (ph == 1) {
      phaseB(p, 0);
    } else {
      const int pass = (ph - 2) / PH_PER_PASS, k = (ph - 2) % PH_PER_PASS;
      Params q = p;
      const int nrep = ((REP_MASK >> k) & 1) ? 2 : 1;
      for (int rep = 0; rep < nrep; ++rep) {
        if (rep) xcd_barrier(xb);
        if (rep && REP_SUB == 9) continue;
        switch (k) {
          case 0: if (REP_MASK != 0 && rep) phaseC<CPROBE>(q, (u16*)smem); else phaseC<0>(q, (u16*)smem); break;
          case 1: phaseD(q, (u16*)smem, rep ? REP_SUB : 0, pass, rep); break;
          case 2: phaseE(q, (float*)smem, rep ? REP_SUB : 0, pass, rep); break;
          case 3: phaseF(q, rep > 0, (u16*)smem, pass, rep); break;
          case 4: phaseG(q, (float*)smem); break;
          case 5: phaseH(q, (u16*)smem); break;
          case 6: phaseI(q, (u16*)smem); break;
          default:
            phaseJ(q, pass);
            if (pass + 1 < NPASS) phaseB(q, pass + 1);
            break;
        }
      }
    }
    if (ph + 1 < ph_hi) {
      if (ph_hi < 0) grid.sync();
      xcd_barrier(xb);
    }
  }
}

extern "C" void kernel_launch(void* const* d_in, const int* in_sizes, int n_in, void* d_out, int out_size, void* d_ws,
                              size_t ws_size, hipStream_t stream) {
  static int grid_blocks = 0;
  if (!grid_blocks) {
    int dev = 0, cus = 0, per_cu = 0;
    hipGetDevice(&dev);
    hipDeviceGetAttribute(&cus, hipDeviceAttributeMultiprocessorCount, dev);
    hipOccupancyMaxActiveBlocksPerMultiprocessor(&per_cu, mega_kernel, 256, 0);
    if (per_cu < 1) per_cu = 1;
    if (per_cu > 2) per_cu = 2;
    grid_blocks = cus * per_cu;
  }
  if (ws_size < O_END) { fprintf(stderr, "workspace too small: %zu < %zu\n", ws_size, (size_t)O_END); return; }
  Params p{};
  const float** pp = reinterpret_cast<const float**>(&p);
  for (int i = 0; i < 22; ++i) pp[i] = (const float*)d_in[i];
  p.out = (float*)d_out;
  p.ws = (unsigned char*)d_ws;
  hipMemsetAsync((unsigned char*)d_ws + O_BAR, 0, 16384, stream);
  int lo = 0, hi = N_PHASES;
  void* args[] = {&p, &lo, &hi};
  hipError_t e = hipLaunchCooperativeKernel((void*)mega_kernel, dim3(grid_blocks), dim3(256), args, 0, stream);
  if (e != hipSuccess) fprintf(stderr, "cooperative launch failed: %s (grid %d)\n", hipGetErrorString(e), grid_blocks);
}
```

```cpp
#include <hip/hip_runtime.h>
#include <hip/hip_cooperative_groups.h>
#include <cstdio>
namespace cg = cooperative_groups;

typedef unsigned short u16;
typedef short s8v __attribute__((ext_vector_type(8)));
typedef short s4v __attribute__((ext_vector_type(4)));
typedef float f4v __attribute__((ext_vector_type(4)));
#define DI __device__ __forceinline__
#define MFMA16(a, b, c) __builtin_amdgcn_mfma_f32_16x16x32_bf16((a), (b), (c), 0, 0, 0)

constexpr int SEQ = 2048, DM = 1024, NB = 8;
constexpr int TS = SEQ + 64;
constexpr int NBG = 2;
constexpr int MP = NBG * SEQ;
constexpr int NPASS = NB / NBG;
constexpr int NIN = 10832, LDP = 10880;
constexpr int C_Z = 0, C_XBC = 2048, C_DT = 5120, C_Q = 5152, C_KC = 6176, C_VC = 6432, C_KS = 6688, C_VS = 6944,
              C_KW = 7200, C_VW = 7456, C_G = 7712, C_ZA = 7760, C_MG = 8784;
constexpr float EPS = 1e-6f;
constexpr float NEGB = -1e30f;
constexpr int APROBE = 0;

constexpr size_t al256(size_t x) { return (x + 255) & ~size_t(255); }
constexpr size_t O_WIN = 0;
constexpr size_t O_WSSM = O_WIN + al256((size_t)LDP * 1024 * 2);
constexpr size_t O_WNSA = O_WSSM + al256((size_t)1024 * 2048 * 2);
constexpr size_t O_WOUT = O_WNSA + al256((size_t)1024 * 1024 * 2);
constexpr size_t O_W1K = O_WOUT + al256((size_t)1024 * 1024 * 2);
constexpr size_t O_W1V = O_W1K + al256((size_t)256 * 2048 * 2);
constexpr size_t O_W2K = O_W1V + al256((size_t)256 * 2048 * 2);
constexpr size_t O_W2V = O_W2K + al256((size_t)64 * 256 * 2);
constexpr size_t O_POSB = O_W2V + al256((size_t)64 * 256 * 2);
constexpr size_t O_ADA = O_POSB + al256(2 * 256 * 4);
constexpr size_t O_H = O_ADA + al256((size_t)8 * 3072 * 4);
constexpr size_t O_P = O_H + al256((size_t)MP * 1024 * 2);
constexpr size_t O_XC = O_P + al256((size_t)MP * LDP * 2);
constexpr size_t O_XCT = O_XC + al256((size_t)MP * 3072 * 2);
constexpr size_t O_DT = O_XCT + al256((size_t)NBG * 2560 * TS * 2);
constexpr size_t O_ACS = O_DT + al256((size_t)NBG * 32 * 2048 * 4);
constexpr size_t O_ST = O_ACS + al256((size_t)NBG * 32 * 2048 * 4);
constexpr size_t O_YD = O_ST + al256((size_t)NBG * 16 * 32 * 64 * 128 * 2);
constexpr size_t O_YN = O_YD + al256((size_t)MP * 2048 * 2);
constexpr size_t O_KCMP = O_YN + al256((size_t)MP * 2048 * 2);
constexpr size_t O_VCT = O_KCMP + al256((size_t)NBG * 4 * 128 * 64 * 2);
constexpr size_t O_VST = O_VCT + al256((size_t)NBG * 4 * 128 * 64 * 2);
constexpr size_t O_VWT = O_VST + al256((size_t)NBG * 4 * 64 * TS * 2);
constexpr size_t O_SEL = O_VWT + al256((size_t)NBG * 4 * 64 * TS * 2);
constexpr size_t O_OCMP = O_SEL + al256((size_t)NBG * 4 * 2048 * 4);
constexpr size_t O_O = O_OCMP + al256((size_t)MP * 1024 * 2);
constexpr size_t O_BAR = O_O + al256((size_t)MP * 1024 * 2);
constexpr size_t O_END = O_BAR + 16384;
static_assert(O_END <= (size_t)256 * 1024 * 1024, "workspace map must fit the guaranteed 256 MiB");
constexpr size_t O_OUTF = O_P;
constexpr size_t O_RSQ = O_P + al256((size_t)MP * 1024 * 4);

struct Params {
  const float *x, *c, *w_ada, *b_ada, *g_pre, *g_post, *w_in, *conv_w, *conv_b, *dt_bias, *a_log, *d_skip, *g_ssm_norm,
      *w_ssm_out, *cmp_pos_k, *cmp_w1_k, *cmp_w2_k, *cmp_pos_v, *cmp_w1_v, *cmp_w2_v, *w_nsa_out, *w_out;
  float* out;
  unsigned char* ws;
};

DI u16 f2bf(float f) { unsigned u = __float_as_uint(f); u += 0x7fffu + ((u >> 16) & 1u); return (u16)(u >> 16); }
DI float bf2f(u16 h) { return __uint_as_float(((unsigned)h) << 16); }
DI float bfs(short h) { return __uint_as_float(((unsigned)(u16)h) << 16); }
DI s8v ld8(const u16* p) { return *reinterpret_cast<const s8v*>(p); }
DI s4v ld4(const u16* p) { return *reinterpret_cast<const s4v*>(p); }
DI f4v ldf4(const float* p) { return *reinterpret_cast<const f4v*>(p); }
typedef __bf16 bf2v __attribute__((ext_vector_type(2)));
typedef float f2v __attribute__((ext_vector_type(2)));
typedef unsigned u2v __attribute__((ext_vector_type(2)));
typedef unsigned u4v __attribute__((ext_vector_type(4)));
DI unsigned pk2(float a, float b) {
  f2v v = {a, b};
  return __builtin_bit_cast(unsigned, __builtin_convertvector(v, bf2v));
}
DI void st4bf(u16* p, float a, float b, float c, float d) {
  u2v v = {pk2(a, b), pk2(c, d)};
  *reinterpret_cast<u2v*>(p) = v;
}
DI void st8bf_pair(u16* p, f4v a, f4v b, int quad) {
  unsigned ax = pk2(a[0], a[1]), ay = pk2(a[2], a[3]), bx = pk2(b[0], b[1]), by = pk2(b[2], b[3]);
  const auto r0 = __builtin_amdgcn_permlane16_swap(ax, bx, false, false);
  const auto r1 = __builtin_amdgcn_permlane16_swap(ay, by, false, false);
  u4v v = {r0[0], r1[0], r0[1], r1[1]};
  *reinterpret_cast<u4v*>(p + (quad & 1) * 16 + (quad >> 1) * 8) = v;
}
DI void ld8bf_pair(const u16* p, int quad, s4v& a, s4v& b) {
  const u4v x = *reinterpret_cast<const u4v*>(p + (quad & 1) * 16 + (quad >> 1) * 8);
  const auto r0 = __builtin_amdgcn_permlane16_swap(x[0], x[2], false, false);
  const auto r1 = __builtin_amdgcn_permlane16_swap(x[1], x[3], false, false);
  u2v ua = {r0[0], r1[0]}, ub = {r0[1], r1[1]};
  a = __builtin_bit_cast(s4v, ua);
  b = __builtin_bit_cast(s4v, ub);
}
DI s8v pack8(f4v a, f4v b) {
  u4v v = {pk2(a[0], a[1]), pk2(a[2], a[3]), pk2(b[0], b[1]), pk2(b[2], b[3])};
  return __builtin_bit_cast(s8v, v);
}
DI s8v pack8f(const float* x) {
  u4v v = {pk2(x[0], x[1]), pk2(x[2], x[3]), pk2(x[4], x[5]), pk2(x[6], x[7])};
  return __builtin_bit_cast(s8v, v);
}
DI s8v cat44(s4v a, s4v b) { s8v v; v[0]=a[0]; v[1]=a[1]; v[2]=a[2]; v[3]=a[3]; v[4]=b[0]; v[5]=b[1]; v[6]=b[2]; v[7]=b[3]; return v; }
DI float sigmoidf_(float x) { return __builtin_amdgcn_rcpf(1.f + __expf(-x)); }
DI float siluf_(float x) { return x * __builtin_amdgcn_rcpf(1.f + __expf(-x)); }
DI float softplusf_(float x) {
  const float y = __expf(x);
  const float small = y * (1.f - y * (0.5f - y * (0.33333334f - 0.25f * y)));
  const float big = __logf(1.f + y);
  return x > 20.f ? x : (y < 0.03f ? small : big);
}
DI float qmax(float v) { v = fmaxf(v, __shfl_xor(v, 16)); v = fmaxf(v, __shfl_xor(v, 32)); return v; }
DI float qsum(float v) { v += __shfl_xor(v, 16); v += __shfl_xor(v, 32); return v; }
DI int tidx() { int t = __builtin_amdgcn_workitem_id_x(); asm volatile("" : "+v"(t)); return t; }
DI f4v fz() { f4v z = {0.f, 0.f, 0.f, 0.f}; return z; }

DI int lds_byte32(int r, int c) {
  const int ob = (r & 15) * 64 + c * 2;
  return (r >> 4) * 1024 + (ob ^ (((ob >> 9) & 1) << 5));
}
DI void stage_rc32(int b, int& R, int& C) {
  const int st = b >> 10, sb = b & 1023, swz = sb ^ (((sb >> 9) & 1) << 5);
  R = st * 16 + (swz >> 6);
  C = (swz & 63) >> 1;
}
template <int N> DI void wait_vm() {
  if constexpr (N == 0) asm volatile("s_waitcnt vmcnt(0)" ::: "memory");
  else if constexpr (N == 3) asm volatile("s_waitcnt vmcnt(3)" ::: "memory");
  else if constexpr (N == 4) asm volatile("s_waitcnt vmcnt(4)" ::: "memory");
  else if constexpr (N == 6) asm volatile("s_waitcnt vmcnt(6)" ::: "memory");
  else asm volatile("s_waitcnt vmcnt(8)" ::: "memory");
}
template <int NT, int MODE = 0>
DI void gemm_mainloop(f4v (&acc)[4][NT], const u16* __restrict__ A, int lda, const u16* __restrict__ Bt, int ldb, int K,
                      int m0, int n0, u16* smem) {
  const int tid = tidx(), lane = tid & 63, w = tid >> 6, wm = w >> 1, wn = w & 1;
  const int l15 = lane & 15, quad = lane >> 4;
  constexpr int TA = 8192, TBB = NT * 2048, TBUF = TA + TBB;
  constexpr int NBP = NT / 2;
  constexpr int L = 2 + NBP;
  char* sbase = reinterpret_cast<char*>(smem);
  const unsigned lbase = (unsigned)(size_t)sbase;
  int Rr[2], Cc[2];
#pragma unroll
  for (int i = 0; i < 2; ++i) stage_rc32(tid * 16 + i * 4096, Rr[i], Cc[i]);
  const u16* ga0 = A + (size_t)(m0 + Rr[0]) * lda + Cc[0];
  const u16* ga1 = A + (size_t)(m0 + Rr[1]) * lda + Cc[1];
  const u16* gb0 = Bt + (size_t)(n0 + Rr[0]) * ldb + Cc[0];
  const u16* gb1 = Bt + (size_t)(n0 + Rr[NBP - 1]) * ldb + Cc[NBP - 1];
  unsigned offa[4], offb[NT];
#pragma unroll
  for (int t = 0; t < 4; ++t) offa[t] = lds_byte32(wm * 64 + t * 16 + l15, quad * 8);
#pragma unroll
  for (int t = 0; t < NT; ++t) offb[t] = TA + lds_byte32(wn * 16 * NT + t * 16 + l15, quad * 8);
  const int ns = K >> 5;
#define GEMM_STAGE(j)                                                                                                 \
  do {                                                                                                               \
    char* _d = sbase + ((j) & 3) * TBUF + tid * 16;                                                                   \
    __builtin_amdgcn_global_load_lds((const unsigned*)(ga0 + (j) * 32), (unsigned*)(_d), 16, 0, 0);                   \
    __builtin_amdgcn_global_load_lds((const unsigned*)(ga1 + (j) * 32), (unsigned*)(_d + 4096), 16, 0, 0);            \
    __builtin_amdgcn_global_load_lds((const unsigned*)(gb0 + (j) * 32), (unsigned*)(_d + TA), 16, 0, 0);              \
    if (NBP == 2) __builtin_amdgcn_global_load_lds((const unsigned*)(gb1 + (j) * 32), (unsigned*)(_d + TA + 4096), 16, 0, 0); \
  } while (0)
  asm volatile("s_waitcnt vmcnt(0)" ::: "memory");
  if (MODE != 1) { GEMM_STAGE(0); GEMM_STAGE(1); GEMM_STAGE(2); }
  for (int j = 0; j < ns; ++j) {
    if (j + 2 < ns) wait_vm<2 * L>();
    else if (j + 1 < ns) wait_vm<L>();
    else wait_vm<0>();
    asm volatile("s_waitcnt lgkmcnt(0)" ::: "memory");
    __builtin_amdgcn_s_barrier();
    if (MODE != 1 && j + 3 < ns) GEMM_STAGE(j + 3);
    if (MODE == 2) continue;
    const unsigned sl = lbase + (unsigned)((j & 3) * TBUF);
    s8v af[4], bg[NT];
    if constexpr (NT == 4) {
      asm volatile(
          "ds_read_b128 %0, %8\n\tds_read_b128 %1, %9\n\tds_read_b128 %2, %10\n\tds_read_b128 %3, %11\n\t"
          "ds_read_b128 %4, %12\n\tds_read_b128 %5, %13\n\tds_read_b128 %6, %14\n\tds_read_b128 %7, %15\n\t"
          "s_waitcnt lgkmcnt(0)"
          : "=&v"(af[0]), "=&v"(af[1]), "=&v"(af[2]), "=&v"(af[3]), "=&v"(bg[0]), "=&v"(bg[1]), "=&v"(bg[2]), "=&v"(bg[3])
          : "v"(sl + offa[0]), "v"(sl + offa[1]), "v"(sl + offa[2]), "v"(sl + offa[3]), "v"(sl + offb[0]), "v"(sl + offb[1]),
            "v"(sl + offb[2]), "v"(sl + offb[3])
          : "memory");
    } else {
      asm volatile(
          "ds_read_b128 %0, %6\n\tds_read_b128 %1, %7\n\tds_read_b128 %2, %8\n\tds_read_b128 %3, %9\n\t"
          "ds_read_b128 %4, %10\n\tds_read_b128 %5, %11\n\t"
          "s_waitcnt lgkmcnt(0)"
          : "=&v"(af[0]), "=&v"(af[1]), "=&v"(af[2]), "=&v"(af[3]), "=&v"(bg[0]), "=&v"(bg[1])
          : "v"(sl + offa[0]), "v"(sl + offa[1]), "v"(sl + offa[2]), "v"(sl + offa[3]), "v"(sl + offb[0]), "v"(sl + offb[1])
          : "memory");
    }
#pragma unroll
    for (int mt = 0; mt < 4; ++mt)
#pragma unroll
      for (int nt = 0; nt < NT; ++nt) acc[mt][nt] = MFMA16(bg[nt], af[mt], acc[mt][nt]);
  }
#undef GEMM_STAGE
  asm volatile("s_waitcnt lgkmcnt(0)" ::: "memory");
  __builtin_amdgcn_s_barrier();
}
template <int NT>
DI void zero_acc(f4v (&acc)[4][NT]) {
#pragma unroll
  for (int i = 0; i < 4; ++i)
#pragma unroll
    for (int j = 0; j < NT; ++j) acc[i][j] = fz();
}

DI void gemm_big_prefetch(const u16* __restrict__ A, int lda, const u16* __restrict__ Bt, int ldb, int m0, int n0, u16* smem) {
  const int tid = tidx();
  char* sbase = reinterpret_cast<char*>(smem);
#pragma unroll
  for (int sl = 0; sl < 2; ++sl) {
    char* d = sbase + sl * 24576 + tid * 16;
#pragma unroll
    for (int i = 0; i < 4; ++i) {
      int R, C;
      stage_rc32(tid * 16 + i * 4096, R, C);
      __builtin_amdgcn_global_load_lds((const unsigned*)(A + (size_t)(m0 + R) * lda + C + sl * 32), (unsigned*)(d + i * 4096), 16, 0, 0);
      if (i < 2)
        __builtin_amdgcn_global_load_lds((const unsigned*)(Bt + (size_t)(n0 + R) * ldb + C + sl * 32), (unsigned*)(d + 16384 + i * 4096), 16, 0, 0);
    }
  }
}
DI void gemm_big(f4v (&acc)[8][4], const u16* __restrict__ A, int lda, const u16* __restrict__ Bt, int ldb, int K, int m0, int n0,
                 u16* smem, bool prestaged) {
  const int tid = tidx(), lane = tid & 63, w = tid >> 6, wm = w >> 1, wn = w & 1;
  const int l15 = lane & 15, quad = lane >> 4;
  constexpr int TA = 16384, TBUF = 24576;
  char* sbase = reinterpret_cast<char*>(smem);
  const unsigned lbase = (unsigned)(size_t)sbase;
  const u16* ga[4];
  const u16* gb[2];
#pragma unroll
  for (int i = 0; i < 4; ++i) {
    int R, C;
    stage_rc32(tid * 16 + i * 4096, R, C);
    ga[i] = A + (size_t)(m0 + R) * lda + C;
    if (i < 2) gb[i] = Bt + (size_t)(n0 + R) * ldb + C;
  }
  unsigned offa[8], offb[4];
#pragma unroll
  for (int t = 0; t < 8; ++t) offa[t] = lds_byte32(wm * 128 + t * 16 + l15, quad * 8);
#pragma unroll
  for (int t = 0; t < 4; ++t) offb[t] = TA + lds_byte32(wn * 64 + t * 16 + l15, quad * 8);
  const int ns = K >> 5;
#define BIG_STAGE(j, slot)                                                                                            \
  do {                                                                                                               \
    char* _d = sbase + (slot) * TBUF + tid * 16;                                                                      \
    _Pragma("unroll") for (int _i = 0; _i < 4; ++_i)                                                                 \
      __builtin_amdgcn_global_load_lds((const unsigned*)(ga[_i] + (j) * 32), (unsigned*)(_d + _i * 4096), 16, 0, 0);  \
    _Pragma("unroll") for (int _i = 0; _i < 2; ++_i)                                                                 \
      __builtin_amdgcn_global_load_lds((const unsigned*)(gb[_i] + (j) * 32), (unsigned*)(_d + TA + _i * 4096), 16, 0, 0); \
  } while (0)
  if (!prestaged) {
    asm volatile("s_waitcnt vmcnt(0)" ::: "memory");
    BIG_STAGE(0, 0);
    BIG_STAGE(1, 1);
  }
  int slot = 0;
  for (int j = 0; j < ns; ++j) {
    if (j + 1 < ns) wait_vm<6>();
    else wait_vm<0>();
    asm volatile("s_waitcnt lgkmcnt(0)" ::: "memory");
    __builtin_amdgcn_s_barrier();
    const int s2 = (slot == 0) ? 2 : slot - 1;
    if (j + 2 < ns) BIG_STAGE(j + 2, s2);
    const unsigned sl = lbase + (unsigned)(slot * TBUF);
    s8v af[8], bg[4];
    asm volatile(
        "ds_read_b128 %0, %12\n\tds_read_b128 %1, %13\n\tds_read_b128 %2, %14\n\tds_read_b128 %3, %15\n\t"
        "ds_read_b128 %4, %16\n\tds_read_b128 %5, %17\n\tds_read_b128 %6, %18\n\tds_read_b128 %7, %19\n\t"
        "ds_read_b128 %8, %20\n\tds_read_b128 %9, %21\n\tds_read_b128 %10, %22\n\tds_read_b128 %11, %23\n\t"
        "s_waitcnt lgkmcnt(0)"
        : "=&v"(bg[0]), "=&v"(bg[1]), "=&v"(bg[2]), "=&v"(bg[3]), "=&v"(af[0]), "=&v"(af[1]), "=&v"(af[2]), "=&v"(af[3]),
          "=&v"(af[4]), "=&v"(af[5]), "=&v"(af[6]), "=&v"(af[7])
        : "v"(sl + offb[0]), "v"(sl + offb[1]), "v"(sl + offb[2]), "v"(sl + offb[3]), "v"(sl + offa[0]), "v"(sl + offa[1]),
          "v"(sl + offa[2]), "v"(sl + offa[3]), "v"(sl + offa[4]), "v"(sl + offa[5]), "v"(sl + offa[6]), "v"(sl + offa[7])
        : "memory");
#pragma unroll
    for (int mt = 0; mt < 8; ++mt)
#pragma unroll
      for (int nt = 0; nt < 4; ++nt) acc[mt][nt] = MFMA16(bg[nt], af[mt], acc[mt][nt]);
    slot = (slot == 2) ? 0 : slot + 1;
  }
#undef BIG_STAGE
  asm volatile("s_waitcnt lgkmcnt(0)" ::: "memory");
  __builtin_amdgcn_s_barrier();
}

DI void gemm_k64(f4v (&acc)[4][2], const u16* __restrict__ A, int lda, const u16* __restrict__ Bt, int ldb, int K, int m0, int n0,
                 u16* smem) {
  const int tid = tidx(), lane = tid & 63, w = tid >> 6, wm = w >> 1, wn = w & 1;
  const int l15 = lane & 15, quad = lane >> 4;
  constexpr int TA = 16384, TBUF = 24576;
  char* sbase = reinterpret_cast<char*>(smem);
  const unsigned lbase = (unsigned)(size_t)sbase;
  const u16* ga[4];
  const u16* gb[2];
#pragma unroll
  for (int i = 0; i < 4; ++i) {
    int R, C;
    stage_rc32(tid * 16 + (i & 1) * 4096, R, C);
    ga[i] = A + (size_t)(m0 + R) * lda + C + 32 * (i >> 1);
  }
  {
    int R, C;
    stage_rc32(tid * 16, R, C);
    gb[0] = Bt + (size_t)(n0 + R) * ldb + C;
    gb[1] = gb[0] + 32;
  }
  unsigned offa[8], offb[4];
#pragma unroll
  for (int t = 0; t < 8; ++t) offa[t] = (t >> 2) * 8192 + lds_byte32(wm * 64 + (t & 3) * 16 + l15, quad * 8);
#pragma unroll
  for (int t = 0; t < 4; ++t) offb[t] = TA + (t >> 1) * 4096 + lds_byte32(wn * 32 + (t & 1) * 16 + l15, quad * 8);
  const int ns = K >> 6;
#define K64_STAGE(j, slot)                                                                                            \
  do {                                                                                                               \
    char* _d = sbase + (slot) * TBUF + tid * 16;                                                                      \
    _Pragma("unroll") for (int _i = 0; _i < 4; ++_i)                                                                 \
      __builtin_amdgcn_global_load_lds((const unsigned*)(ga[_i] + (j) * 64), (unsigned*)(_d + _i * 4096), 16, 0, 0);  \
    _Pragma("unroll") for (int _i = 0; _i < 2; ++_i)                                                                 \
      __builtin_amdgcn_global_load_lds((const unsigned*)(gb[_i] + (j) * 64), (unsigned*)(_d + TA + _i * 4096), 16, 0, 0); \
  } while (0)
  asm volatile("s_waitcnt vmcnt(0)" ::: "memory");
  K64_STAGE(0, 0);
  if (ns > 1) K64_STAGE(1, 1);
  int slot = 0;
  for (int j = 0; j < ns; ++j) {
    if (j + 1 < ns) wait_vm<6>();
    else wait_vm<0>();
    asm volatile("s_waitcnt lgkmcnt(0)" ::: "memory");
    __builtin_amdgcn_s_barrier();
    const int s2 = (slot == 0) ? 2 : slot - 1;
    if (j + 2 < ns) K64_STAGE(j + 2, s2);
    const unsigned sl = lbase + (unsigned)(slot * TBUF);
    s8v af[8], bg[4];
    asm volatile(
        "ds_read_b128 %0, %12\n\tds_read_b128 %1, %13\n\tds_read_b128 %2, %14\n\tds_read_b128 %3, %15\n\t"
        "ds_read_b128 %4, %16\n\tds_read_b128 %5, %17\n\tds_read_b128 %6, %18\n\tds_read_b128 %7, %19\n\t"
        "ds_read_b128 %8, %20\n\tds_read_b128 %9, %21\n\tds_read_b128 %10, %22\n\tds_read_b128 %11, %23\n\t"
        "s_waitcnt lgkmcnt(0)"
        : "=&v"(bg[0]), "=&v"(bg[1]), "=&v"(bg[2]), "=&v"(bg[3]), "=&v"(af[0]), "=&v"(af[1]), "=&v"(af[2]), "=&v"(af[3]),
          "=&v"(af[4]), "=&v"(af[5]), "=&v"(af[6]), "=&v"(af[7])
        : "v"(sl + offb[0]), "v"(sl + offb[1]), "v"(sl + offb[2]), "v"(sl + offb[3]), "v"(sl + offa[0]), "v"(sl + offa[1]),
          "v"(sl + offa[2]), "v"(sl + offa[3]), "v"(sl + offa[4]), "v"(sl + offa[5]), "v"(sl + offa[6]), "v"(sl + offa[7])
        : "memory");
#pragma unroll
    for (int h = 0; h < 2; ++h)
#pragma unroll
      for (int mt = 0; mt < 4; ++mt)
#pragma unroll
        for (int nt = 0; nt < 2; ++nt) acc[mt][nt] = MFMA16(bg[h * 2 + nt], af[h * 4 + mt], acc[mt][nt]);
    slot = (slot == 2) ? 0 : slot + 1;
  }
#undef K64_STAGE
  asm volatile("s_waitcnt lgkmcnt(0)" ::: "memory");
  __builtin_amdgcn_s_barrier();
}

DI void convT_tile(const float* __restrict__ w, int K, int N, u16* __restrict__ wt, int tile, float* sm) {
  const int tid = tidx();
  const int tiles_k = K >> 6;
  const int tk = tile % tiles_k, tn = tile / tiles_k;
  const int k0 = tk * 64, n0 = tn * 64;
  {
    const int c = tid & 63, r0 = tid >> 6;
    const bool ok = (n0 + c) < N;
    float v[16];
#pragma unroll
    for (int i = 0; i < 16; ++i) v[i] = ok ? w[(size_t)(k0 + r0 + 4 * i) * N + n0 + c] : 0.f;
    __builtin_amdgcn_sched_barrier(0);
#pragma unroll
    for (int i = 0; i < 16; ++i) sm[(r0 + 4 * i) * 65 + c] = v[i];
  }
  __syncthreads();
  {
    const int n = tid >> 2, ks = (tid & 3) * 16;
    float t0[8], t1[8];
#pragma unroll
    for (int j = 0; j < 8; ++j) { t0[j] = sm[(ks + j) * 65 + n]; t1[j] = sm[(ks + 8 + j) * 65 + n]; }
    const s8v v0 = pack8f(t0), v1 = pack8f(t1);
    u16* dst = wt + (size_t)(n0 + n) * K + k0 + ks;
    *reinterpret_cast<s8v*>(dst) = v0;
    *reinterpret_cast<s8v*>(dst + 8) = v1;
  }
  __syncthreads();
}

template <int NR>
DI void gemv_cols(const float* __restrict__ vec, int K, const float* __restrict__ W, int N, const float* __restrict__ bias,
                  float* __restrict__ out, int col0, float* sm) {
  const int tid = tidx(), kg = tid >> 6, cl = tid & 63;
  const int kper = K >> 2;
  float acc[NR];
#pragma unroll
  for (int r = 0; r < NR; ++r) acc[r] = 0.f;
  for (int k0 = kg * kper; k0 < (kg + 1) * kper; k0 += 16) {
    float wv[16];
#pragma unroll
    for (int j = 0; j < 16; ++j) wv[j] = W[(size_t)(k0 + j) * N + col0 + cl];
    __builtin_amdgcn_sched_barrier(0);
#pragma unroll
    for (int j = 0; j < 16; ++j)
#pragma unroll
      for (int r = 0; r < NR; ++r) acc[r] += vec[r * K + k0 + j] * wv[j];
    __builtin_amdgcn_sched_barrier(0);
  }
#pragma unroll
  for (int r = 0; r < NR; ++r) sm[(kg * NR + r) * 64 + cl] = acc[r];
  __syncthreads();
  for (int idx = tid; idx < NR * 64; idx += 256) {
    const int r = idx >> 6, c2 = idx & 63;
    float s = bias ? bias[col0 + c2] : 0.f;
#pragma unroll
    for (int g = 0; g < 4; ++g) s += sm[(g * NR + r) * 64 + c2];
    out[(size_t)r * N + col0 + c2] = s;
  }
  __syncthreads();
}

DI void phaseA(const Params& p, unsigned char* smem_raw) {
  float* smf = reinterpret_cast<float*>(smem_raw);
  unsigned char* ws = p.ws;
  constexpr int T0 = 16 * 170, T1 = T0 + 32 * 16, T2 = T1 + 16 * 16, T3 = T2 + 16 * 16, T4 = T3 + 32 * 4, T5 = T4 + 32 * 4,
                T6 = T5 + 4, T7 = T6 + 4, T8 = T7 + 48, T9 = T8 + 8;
  for (int it = blockIdx.x; it < T9; it += gridDim.x) {
    if (it < T0) convT_tile(p.w_in, 1024, NIN, (u16*)(ws + O_WIN), it, smf);
    else if (it < T1) convT_tile(p.w_ssm_out, 2048, 1024, (u16*)(ws + O_WSSM), it - T0, smf);
    else if (it < T2) convT_tile(p.w_nsa_out, 1024, 1024, (u16*)(ws + O_WNSA), it - T1, smf);
    else if (it < T3) convT_tile(p.w_out, 1024, 1024, (u16*)(ws + O_WOUT), it - T2, smf);
    else if (it < T4) convT_tile(p.cmp_w1_k, 2048, 256, (u16*)(ws + O_W1K), it - T3, smf);
    else if (it < T5) convT_tile(p.cmp_w1_v, 2048, 256, (u16*)(ws + O_W1V), it - T4, smf);
    else if (it < T6) convT_tile(p.cmp_w2_k, 256, 64, (u16*)(ws + O_W2K), it - T5, smf);
    else if (it < T7) convT_tile(p.cmp_w2_v, 256, 64, (u16*)(ws + O_W2V), it - T6, smf);
    else if (it < T8) gemv_cols<8>(p.c, 1024, p.w_ada, 3072, p.b_ada, (float*)(ws + O_ADA), (it - T7) * 64, smf);
    else {
      const int j = it - T8, kind = j >> 2, cb = j & 3;
      gemv_cols<1>(kind ? p.cmp_pos_v : p.cmp_pos_k, 2048, kind ? p.cmp_w1_v : p.cmp_w1_k, 256, nullptr,
                   (float*)(ws + O_POSB) + kind * 256, cb * 64, smf);
    }
  }
}

DI void phaseB(const Params& p, int pass) {
  const int tid = tidx(), lane = tid & 63, w = tid >> 6;
  const float* ada = (const float*)(p.ws + O_ADA);
  u16* h = (u16*)(p.ws + O_H);
  for (int it = blockIdx.x; it < MP / 4; it += gridDim.x) {
    const int r = it * 4 + w;
    const int tg = pass * MP + r;
    const int b = tg >> 11;
    const float* xr = p.x + (size_t)tg * DM;
    f4v v[4];
    float ss = 0.f;
#pragma unroll
    for (int i = 0; i < 4; ++i) {
      v[i] = ldf4(xr + i * 256 + lane * 4);
      ss += v[i][0] * v[i][0] + v[i][1] * v[i][1] + v[i][2] * v[i][2] + v[i][3] * v[i][3];
    }
#pragma unroll
    for (int o = 1; o < 64; o <<= 1) ss += __shfl_xor(ss, o);
    const float rstd = rsqrtf(ss * (1.f / DM) + EPS);
    f4v gg[4], shh[4], scc[4];
#pragma unroll
    for (int i = 0; i < 4; ++i) {
      const int c0 = i * 256 + lane * 4;
      gg[i] = ldf4(p.g_pre + c0);
      shh[i] = ldf4(ada + b * 3072 + c0);
      scc[i] = ldf4(ada + b * 3072 + 1024 + c0);
    }
    __builtin_amdgcn_sched_barrier(0);
#pragma unroll
    for (int i = 0; i < 4; ++i) {
      const int c0 = i * 256 + lane * 4;
      const f4v g = gg[i], sh = shh[i], sc = scc[i];
      float o0 = v[i][0] * rstd * g[0] * (1.f + sc[0]) + sh[0];
      float o1 = v[i][1] * rstd * g[1] * (1.f + sc[1]) + sh[1];
      float o2 = v[i][2] * rstd * g[2] * (1.f + sc[2]) + sh[2];
      float o3 = v[i][3] * rstd * g[3] * (1.f + sc[3]) + sh[3];
      st4bf(h + (size_t)r * DM + c0, o0, o1, o2, o3);
    }
  }
}

template <int MODE>
DI void phaseC(const Params& p, u16* smem) {
  const int lane = tidx() & 63, w = tidx() >> 6, wm = w >> 1, wn = w & 1, l15 = lane & 15, quad = lane >> 4;
  const u16* A = (const u16*)(p.ws + O_H);
  const u16* Bt = (const u16*)(p.ws + O_WIN);
  u16* P = (u16*)(p.ws + O_P);
  constexpr int NTN = LDP / 128;
  const int xcd = blockIdx.x & 7, lb = blockIdx.x >> 3, nlb = gridDim.x >> 3;
  bool pre = false;
  for (int t = lb;; t += nlb) {
    const int mi = (xcd & 3) * 4 + (t & 3);
    const int ni = 2 * (t >> 2) + (xcd >> 2);
    if (ni >= NTN) break;
    f4v acc[8][4];
#pragma unroll
    for (int i = 0; i < 8; ++i)
#pragma unroll
      for (int j = 0; j < 4; ++j) acc[i][j] = fz();
    gemm_big(acc, A, 1024, Bt, 1024, 1024, mi * 256, ni * 128, smem, pre);
    {
      const int t2 = t + nlb;
      const int ni2 = 2 * (t2 >> 2) + (xcd >> 2);
      pre = ni2 < NTN;
      if (pre) gemm_big_prefetch(A, 1024, Bt, 1024, ((xcd & 3) * 4 + (t2 & 3)) * 256, ni2 * 128, smem);
    }
    if (MODE != 0) { if (acc[0][0][0] + acc[7][3][3] != 12345.678f) continue; }
#pragma unroll
    for (int mt = 0; mt < 8; ++mt) {
      u16* prow = P + (size_t)(mi * 256 + wm * 128 + mt * 16 + l15) * LDP + ni * 128 + wn * 64;
      st8bf_pair(prow, acc[mt][0], acc[mt][1], quad);
      st8bf_pair(prow + 32, acc[mt][2], acc[mt][3], quad);
    }
  }
}

DI void conv_item(const Params& p, int it) {
  const int tid = tidx();
  const int cb = it % 24, tb = (it / 24) & 31, b = it / (24 * 32);
  const int ch0 = cb * 128 + 2 * (tid & 63);
  const int t0 = tb * 64 + 16 * (tid >> 6);
  const u16* P = (const u16*)(p.ws + O_P);
  u16* xc = (u16*)(p.ws + O_XC);
  u16* xcT = (u16*)(p.ws + O_XCT);
  unsigned raw[19];
#pragma unroll
  for (int i = 0; i < 19; ++i) {
    const int t = t0 - 3 + i;
    raw[i] = (t >= 0) ? *reinterpret_cast<const unsigned*>(P + (size_t)(b * SEQ + t) * LDP + C_XBC + ch0) : 0u;
  }
  const int hd = ch0 >> 6;
  u16 dtr[16];
  const bool isx = ch0 < 2048, isxb = ch0 < 2560;
  if (isx) {
#pragma unroll
    for (int i = 0; i < 16; ++i) dtr[i] = P[(size_t)(b * SEQ + t0 + i) * LDP + C_DT + hd];
  }
  float wv[4][2];
#pragma unroll
  for (int k = 0; k < 4; ++k) { wv[k][0] = p.conv_w[k * 3072 + ch0]; wv[k][1] = p.conv_w[k * 3072 + ch0 + 1]; }
  const float b0 = p.conv_b[ch0], b1 = p.conv_b[ch0 + 1];
  float y0[16], y1[16];
#pragma unroll
  for (int i = 0; i < 16; ++i) {
    float a0 = b0, a1 = b1;
#pragma unroll
    for (int k = 0; k < 4; ++k) {
      a0 += wv[k][0] * __uint_as_float(raw[i + k] << 16);
      a1 += wv[k][1] * __uint_as_float(raw[i + k] & 0xffff0000u);
    }
    y0[i] = siluf_(a0); y1[i] = siluf_(a1);
    const unsigned pk = pk2(y0[i], y1[i]);
    if (ch0 >= 2048) *reinterpret_cast<unsigned*>(xc + (size_t)(b * SEQ + t0 + i) * 3072 + ch0) = pk;
  }
  if (isxb) {
    if (isx) {
      const float db = p.dt_bias[hd];
#pragma unroll
      for (int i = 0; i < 16; ++i) {
        const float dtv = softplusf_(bf2f(dtr[i]) + db);
        y0[i] *= dtv; y1[i] *= dtv;
      }
    }
    u16* d0 = xcT + ((size_t)b * 2560 + ch0) * TS + t0;
    *reinterpret_cast<s8v*>(d0) = pack8f(y0);
    *reinterpret_cast<s8v*>(d0 + 8) = pack8f(y0 + 8);
    *reinterpret_cast<s8v*>(d0 + TS) = pack8f(y1);
    *reinterpret_cast<s8v*>(d0 + TS + 8) = pack8f(y1 + 8);
  }
}
DI void dt_item(const Params& p, int it, float* sm) {
  const int tid = tidx(), hd = tid & 31, seg = tid >> 5;
  const int c = it & 15, b = it >> 4;
  const u16* P = (const u16*)(p.ws + O_P);
  float* dtb = (float*)(p.ws + O_DT);
  float* acs = (float*)(p.ws + O_ACS);
  const float db = p.dt_bias[hd];
  const float a = -expf(p.a_log[hd]);
  const int tbase = c * 128 + seg * 16;
  float v[16], cs[16];
#pragma unroll
  for (int i = 0; i < 16; ++i) v[i] = bf2f(P[(size_t)(b * SEQ + tbase + i) * LDP + C_DT + hd]);
  float run = 0.f;
#pragma unroll
  for (int i = 0; i < 16; ++i) { v[i] = softplusf_(v[i] + db); run += v[i] * a; cs[i] = run; }
  sm[seg * 32 + hd] = run;
  __syncthreads();
  float off = 0.f;
#pragma unroll
  for (int s2 = 0; s2 < 8; ++s2) off += (s2 < seg) ? sm[s2 * 32 + hd] : 0.f;
  float* d0 = dtb + ((size_t)b * 32 + hd) * SEQ + tbase;
  float* d1 = acs + ((size_t)b * 32 + hd) * SEQ + tbase;
#pragma unroll
  for (int i = 0; i < 4; ++i) {
    f4v x0 = {v[4 * i], v[4 * i + 1], v[4 * i + 2], v[4 * i + 3]};
    f4v x1 = {cs[4 * i] + off, cs[4 * i + 1] + off, cs[4 * i + 2] + off, cs[4 * i + 3] + off};
    *reinterpret_cast<f4v*>(d0 + 4 * i) = x0;
    *reinterpret_cast<f4v*>(d1 + 4 * i) = x1;
  }
  __syncthreads();
}
DI void vtr_item(const Params& p, int it) {
  const int tid = tidx();
  const int tb = it & 31, g = (it >> 5) & 3, b = (it >> 7) % NBG, kind = it / (128 * NBG);
  const u16* P = (const u16*)(p.ws + O_P);
  u16* dst = (u16*)(p.ws + (kind ? O_VWT : O_VST));
  const int d = tid & 63, tq = tid >> 6;
  const int t0 = tb * 64 + tq * 16;
  const int col = (kind ? C_VW : C_VS) + g * 64 + d;
  s8v v0, v1;
#pragma unroll
  for (int i = 0; i < 8; ++i) {
    v0[i] = (short)P[(size_t)(b * SEQ + t0 + i) * LDP + col];
    v1[i] = (short)P[(size_t)(b * SEQ + t0 + 8 + i) * LDP + col];
  }
  u16* o = dst + (((size_t)b * 4 + g) * 64 + d) * TS + t0;
  *reinterpret_cast<s8v*>(o) = v0;
  *reinterpret_cast<s8v*>(o + 8) = v1;
}
DI void cmp_item(const Params& p, int it, u16* sm) {
  const int tid = tidx(), lane = tid & 63, w = tid >> 6, l15 = lane & 15, quad = lane >> 4;
  const int jt = it & 7, g = (it >> 3) & 3, b = (it >> 5) % NBG, kind = it / (32 * NBG);
  const u16* P = (const u16*)(p.ws + O_P);
  const u16* W1 = (const u16*)(p.ws + (kind ? O_W1V : O_W1K));
  const u16* W2 = (const u16*)(p.ws + (kind ? O_W2V : O_W2K));
  const float* posb = (const float*)(p.ws + O_POSB) + kind * 256;
  const int col0 = (kind ? C_VC : C_KC) + g * 64;
  const int j = jt * 16 + l15;
  const bool rv = j < 127;
  const u16* arow = P + (size_t)(b * SEQ + (rv ? j : 0) * 16) * LDP + col0 + quad * 8;
  f4v hid[16];
#pragma unroll
  for (int nt = 0; nt < 16; ++nt) hid[nt] = fz();
  s8v zero8 = {0, 0, 0, 0, 0, 0, 0, 0};
#define CMP_LOAD(AF, BW, K2R)                                                                        \
  do {                                                                                               \
    const int _kk = 16 * w + (((K2R) + it) & 15);                        \
    const int _l = _kk >> 1, _d0 = (_kk & 1) * 32;                                                    \
    AF = rv ? ld8(arow + (size_t)_l * LDP + _d0) : zero8;                                             \
    const u16* _wb = W1 + (size_t)l15 * 2048 + _kk * 32 + quad * 8;                                   \
    _Pragma("unroll") for (int nt = 0; nt < 16; ++nt) BW[nt] = ld8(_wb + (size_t)nt * 16 * 2048);    \
  } while (0)
#define CMP_MMA(AF, BW)                                                                              \
  do {                                                                                               \
    _Pragma("unroll") for (int nt = 0; nt < 16; ++nt) hid[nt] = MFMA16(AF, BW[nt], hid[nt]);         \
  } while (0)
  {
    s8v a0, a1, b0[16], b1[16];
    CMP_LOAD(a0, b0, 0);
#pragma unroll 1
    for (int k2r = 0; k2r < 16; k2r += 2) {
      CMP_LOAD(a1, b1, k2r + 1);
      __builtin_amdgcn_sched_barrier(0);
      CMP_MMA(a0, b0);
      __builtin_amdgcn_sched_barrier(0);
      CMP_LOAD(a0, b0, k2r + 2);
      __builtin_amdgcn_sched_barrier(0);
      CMP_MMA(a1, b1);
      __builtin_amdgcn_sched_barrier(0);
    }
  }
#undef CMP_LOAD
#undef CMP_MMA
  float* red = reinterpret_cast<float*>(sm);
#pragma unroll
  for (int nt = 0; nt < 16; ++nt)
#pragma unroll
    for (int i = 0; i < 4; ++i) red[(w * 16 + quad * 4 + i) * 260 + nt * 16 + l15] = hid[nt][i];
  __syncthreads();
  u16 hb[16];
  {
    const float pb = posb[tid];
#pragma unroll
    for (int r = 0; r < 16; ++r) {
      const float v = red[r * 260 + tid] + red[(16 + r) * 260 + tid] + red[(32 + r) * 260 + tid] + red[(48 + r) * 260 + tid] + pb;
      hb[r] = f2bf(siluf_(v));
    }
  }
  __syncthreads();
  constexpr int HS = 264;
#pragma unroll
  for (int r = 0; r < 16; ++r) sm[r * HS + tid] = hb[r];
  __syncthreads();
  f4v res = fz();
#pragma unroll
  for (int ks = 0; ks < 8; ++ks) {
    const s8v a = ld8(sm + l15 * HS + ks * 32 + quad * 8);
    const s8v bw = ld8(W2 + (size_t)(w * 16 + l15) * 256 + ks * 32 + quad * 8);
    res = MFMA16(a, bw, res);
  }
  const int d = w * 16 + l15;
  const int jb = jt * 16 + quad * 4;
  if (kind == 0) {
    u16* kc = (u16*)(p.ws + O_KCMP) + ((size_t)(b * 4 + g) * 128) * 64;
#pragma unroll
    for (int i = 0; i < 4; ++i) kc[(size_t)(jb + i) * 64 + d] = (jb + i < 127) ? f2bf(res[i]) : (u16)0;
  } else {
    u16* vc = (u16*)(p.ws + O_VCT) + ((size_t)(b * 4 + g) * 64 + d) * 128 + jb;
    st4bf(vc, res[0], res[1], res[2], (jb + 3 < 127) ? res[3] : 0.f);
  }
  __syncthreads();
}

DI int q_next(unsigned* ctr) {
  __shared__ int q_slot;
  if (tidx() == 0) q_slot = (int)atomicAdd(ctr, 1u);
  __syncthreads();
  const int it = q_slot;
  __syncthreads();
  return it;
}
DI unsigned* q_counter(const Params& p, int pass, int phase, int rep) {
  return (unsigned*)(p.ws + O_BAR) + 3520 + 8 * (((pass * 4 + phase) * 2) + rep);
}

DI void phaseD(const Params& p, u16* smem, int sub, int pass, int rep) {
  constexpr int N_CMP = 2 * NBG * 32, N_CONV = NBG * 128 * 6, N_VTR = 2 * NBG * 128, N_DT = NBG * 16;
  constexpr int E1 = N_CONV, E2 = E1 + N_VTR, E3 = E2 + N_DT;
  const int ncb = ((int)gridDim.x >= 2 * N_CMP) ? N_CMP : 0;
  constexpr int TAIL = 320;
  int lo, hi, start, step;
  if (ncb == 0) {
    for (int it = blockIdx.x; it < N_CMP; it += gridDim.x)
      if (sub == 0 || sub == 1) cmp_item(p, it, smem);
    lo = 0; hi = E3; start = blockIdx.x; step = gridDim.x;
  } else if ((int)blockIdx.x < ncb) {
    if (sub == 0 || sub == 1) cmp_item(p, blockIdx.x, smem);
    lo = E3 - TAIL; hi = E3; start = lo + blockIdx.x; step = ncb;
  } else {
    lo = 0; hi = E3 - TAIL; start = (int)blockIdx.x - ncb; step = (int)gridDim.x - ncb;
  }
  for (int it = start; it < hi; it += step) {
    if (it < E1) { if (sub == 0 || sub == 2) conv_item(p, it); }
    else if (it < E2) { if (sub == 0 || sub == 3) vtr_item(p, it - E1); }
    else { if (sub == 0 || sub == 3) dt_item(p, it - E2, (float*)smem); }
  }
}

DI void ssd_item(const Params& p, int it, u16* sm) {
  const int tid = tidx(), lane = tid & 63, w = tid >> 6, l15 = lane & 15, quad = lane >> 4;
  const int qr = (it >> 3) & 3, cgx = ((it >> 5) << 3) | (it & 7);
  const int g = cgx & 3, c = (cgx >> 2) & 15, b = cgx >> 6;
  const int t0 = c * 128;
  const u16* xc = (const u16*)(p.ws + O_XC);
  const u16* xcT = (const u16*)(p.ws + O_XCT);
  const float* acsb = (const float*)(p.ws + O_ACS);
  const float* dtb = (const float*)(p.ws + O_DT);
  u16* yd = (u16*)(p.ws + O_YD);
  u16* stb = (u16*)(p.ws + O_ST);
  const u16* Bbase = xc + (size_t)(b * SEQ + t0) * 3072 + 2048 + g * 128;
  const u16* Cbase = xc + (size_t)(b * SEQ + t0) * 3072 + 2560 + g * 128;
  const u16* BT = xcT + ((size_t)b * 2560 + 2048 + g * 128) * TS + t0;
  const int h0 = g * 8 + qr * 2;
  constexpr int LS = 136;
  u16* Bs = sm;
  u16* Xs = sm + 128 * LS;
  float* As = reinterpret_cast<float*>(sm + 256 * LS);
  {
    s8v rb[8], rx[8];
#pragma unroll
    for (int r = 0; r < 8; ++r) {
      const int idx = tid + 256 * r, row = idx >> 4, seg = idx & 15;
      rb[r] = ld8(Bbase + (size_t)row * 3072 + seg * 8);
      rx[r] = ld8(xcT + ((size_t)b * 2560 + h0 * 64 + row) * TS + t0 + seg * 8);
    }
#pragma unroll
    for (int r = 0; r < 8; ++r) {
      const int idx = tid + 256 * r, row = idx >> 4, seg = idx & 15;
      *reinterpret_cast<s8v*>(Bs + row * LS + seg * 8) = rb[r];
      *reinterpret_cast<s8v*>(Xs + row * LS + seg * 8) = rx[r];
    }
    As[tid] = acsb[((size_t)b * 32 + h0 + (tid >> 7)) * SEQ + t0 + (tid & 127)];
  }
  __syncthreads();

#pragma unroll 1
  for (int li = 0; li < 2; ++li) {
    const int lt = li ? 7 - w : w;
    const int l = 16 * lt + l15;
    s8v cf[4];
#pragma unroll
    for (int ks = 0; ks < 4; ++ks) cf[ks] = ld8(Cbase + (size_t)l * 3072 + ks * 32 + quad * 8);
    f4v y[2][4];
#pragma unroll
    for (int hh = 0; hh < 2; ++hh)
#pragma unroll
      for (int pt = 0; pt < 4; ++pt) y[hh][pt] = fz();
    float acl[2];
#pragma unroll
    for (int hh = 0; hh < 2; ++hh) acl[hh] = As[hh * 128 + l];
    const int spn = lt >> 1;
    for (int sp = 0; sp <= spn; ++sp) {
      f4v cb[2];
#pragma unroll
      for (int si = 0; si < 2; ++si) {
        cb[si] = fz();
#pragma unroll
        for (int ks = 0; ks < 4; ++ks)
          cb[si] = MFMA16(ld8(Bs + (32 * sp + 16 * si + l15) * LS + ks * 32 + quad * 8), cf[ks], cb[si]);
      }
#pragma unroll
      for (int hh = 0; hh < 2; ++hh) {
        const float* ah = As + hh * 128;
        const f4v as0 = ldf4(ah + 32 * sp + quad * 4);
        const f4v as1 = ldf4(ah + 32 * sp + 16 + quad * 4);
        f4v m0, m1;
#pragma unroll
        for (int i = 0; i < 4; ++i) {
          const int s0 = 32 * sp + quad * 4 + i, s1 = s0 + 16;
          m0[i] = (s0 <= l) ? cb[0][i] * __expf(acl[hh] - as0[i]) : 0.f;
          m1[i] = (s1 <= l) ? cb[1][i] * __expf(acl[hh] - as1[i]) : 0.f;
        }
        const s8v pb = pack8(m0, m1);
#pragma unroll
        for (int pt = 0; pt < 4; ++pt) {
          const u16* xr = Xs + (hh * 64 + 16 * pt + l15) * LS + 32 * sp + quad * 4;
          y[hh][pt] = MFMA16(cat44(ld4(xr), ld4(xr + 16)), pb, y[hh][pt]);
        }
      }
    }
#pragma unroll
    for (int hh = 0; hh < 2; ++hh) {
      const float dinv = p.d_skip[h0 + hh] / dtb[((size_t)b * 32 + h0 + hh) * SEQ + t0 + l];
#pragma unroll
      for (int pt = 0; pt < 4; ++pt) {
#pragma unroll
        for (int i = 0; i < 4; ++i) y[hh][pt][i] += dinv * bf2f(Xs[(hh * 64 + 16 * pt + 4 * quad + i) * LS + l]);
      }
      u16* yrow = yd + (size_t)(b * SEQ + t0 + l) * 2048 + (h0 + hh) * 64;
      st8bf_pair(yrow, y[hh][0], y[hh][1], quad);
      st8bf_pair(yrow + 32, y[hh][2], y[hh][3], quad);
    }
  }
#pragma unroll 1
  for (int hh = 0; hh < 2; ++hh) {
    const int hd = h0 + hh;
    const float* ah = As + hh * 128;
    const float alast = ah[127];
    f4v st[2][4];
#pragma unroll
    for (int ni = 0; ni < 2; ++ni)
#pragma unroll
      for (int pt = 0; pt < 4; ++pt) st[ni][pt] = fz();
    s8v bt[4][2];
#pragma unroll
    for (int ks = 0; ks < 4; ++ks)
#pragma unroll
      for (int ni = 0; ni < 2; ++ni) bt[ks][ni] = ld8(BT + (size_t)(16 * (2 * w + ni) + l15) * TS + ks * 32 + quad * 8);
    __builtin_amdgcn_sched_barrier(0);
#pragma unroll
    for (int ks = 0; ks < 4; ++ks) {
      const f4v a0 = ldf4(ah + ks * 32 + quad * 8), a1 = ldf4(ah + ks * 32 + quad * 8 + 4);
      float wl[8];
#pragma unroll
      for (int j = 0; j < 4; ++j) { wl[j] = __expf(alast - a0[j]); wl[4 + j] = __expf(alast - a1[j]); }
#pragma unroll
      for (int pt = 0; pt < 4; ++pt) {
        const s8v raw = ld8(Xs + (hh * 64 + 16 * pt + l15) * LS + ks * 32 + quad * 8);
        float xf[8];
#pragma unroll
        for (int j = 0; j < 8; ++j) xf[j] = bfs(raw[j]) * wl[j];
        const s8v xw = pack8f(xf);
        st[0][pt] = MFMA16(bt[ks][0], xw, st[0][pt]);
        st[1][pt] = MFMA16(bt[ks][1], xw, st[1][pt]);
      }
    }
    u16* so = stb + (((size_t)(b * 16 + c) * 32 + hd) * 64) * 128;
#pragma unroll
    for (int pt = 0; pt < 4; ++pt) st8bf_pair(so + (size_t)(16 * pt + l15) * 128 + 32 * w, st[0][pt], st[1][pt], quad);
  }
  __syncthreads();
}

DI void cmpattn_item(const Params& p, int it, unsigned char* smraw) {
  const int tid = tidx(), lane = tid & 63, w = tid >> 6, l15 = lane & 15, quad = lane >> 4;
  const int tq2 = it & 63, g = (it >> 6) & 3, b = it >> 8;
  const int H = g * 4 + w;
  const float slope = exp2f(-0.5f * (float)(H + 1));
  const u16* P = (const u16*)(p.ws + O_P);
  const u16* kcg = (const u16*)(p.ws + O_KCMP) + (size_t)(b * 4 + g) * 128 * 64;
  const u16* vcg = (const u16*)(p.ws + O_VCT) + (size_t)(b * 4 + g) * 64 * 128;
  constexpr int KS = 72, VS = 136;
  u16* kcs = reinterpret_cast<u16*>(smraw);
  u16* vcs = kcs + 128 * KS;
  float* impA = reinterpret_cast<float*>(smraw + 36864);
  float* impB = impA + 2048;
  float* scl = impB + 2112;
  {
    s8v r0[4], r1[4];
#pragma unroll
    for (int r = 0; r < 4; ++r) {
      const int idx = tid + 256 * r;
      r0[r] = ld8(kcg + (size_t)(idx >> 3) * 64 + (idx & 7) * 8);
      r1[r] = ld8(vcg + (size_t)(idx >> 4) * 128 + (idx & 15) * 8);
    }
#pragma unroll
    for (int r = 0; r < 4; ++r) {
      const int idx = tid + 256 * r;
      *reinterpret_cast<s8v*>(kcs + (idx >> 3) * KS + (idx & 7) * 8) = r0[r];
      *reinterpret_cast<s8v*>(vcs + (idx >> 4) * VS + (idx & 15) * 8) = r1[r];
    }
  }
  __syncthreads();
#pragma unroll 1
  for (int sub = 0; sub < 2; ++sub) {
    const int q0 = tq2 * 32 + sub * 16;
    const int njt = (q0 >= 16) ? (((q0 - 16) >> 8) + 1) : 0;
    const int t = q0 + l15;
    const size_t trow = (size_t)(b * SEQ + t);
    s8v qf[2];
    qf[0] = ld8(P + trow * LDP + C_Q + H * 64 + quad * 8);
    qf[1] = ld8(P + trow * LDP + C_Q + H * 64 + 32 + quad * 8);
    f4v s[8];
#pragma unroll
    for (int jt = 0; jt < 8; ++jt) {
      s[jt] = fz();
      if (jt < njt) {
#pragma unroll
        for (int ks = 0; ks < 2; ++ks) s[jt] = MFMA16(ld8(kcs + (16 * jt + l15) * KS + ks * 32 + quad * 8), qf[ks], s[jt]);
      }
    }
    float mx = NEGB;
#pragma unroll
    for (int jt = 0; jt < 8; ++jt)
#pragma unroll
      for (int i = 0; i < 4; ++i) {
        const int j = 16 * jt + 4 * quad + i;
        const int dist = t - (16 * j + 31);
        const float sc = (dist >= 0) ? s[jt][i] * 0.125f - slope * (float)dist : NEGB;
        s[jt][i] = sc;
        mx = fmaxf(mx, sc);
      }
    mx = qmax(mx);
    float lsum = 0.f;
#pragma unroll
    for (int jt = 0; jt < 8; ++jt)
#pragma unroll
      for (int i = 0; i < 4; ++i) {
        const float e = (s[jt][i] > -1e29f) ? __expf(s[jt][i] - mx) : 0.f;
        s[jt][i] = e;
        lsum += e;
      }
    lsum = qsum(lsum);
    const float inv = lsum > 0.f ? 1.f / lsum : 0.f;
#pragma unroll
    for (int jt = 0; jt < 8; ++jt) {
      s[jt] = s[jt] * inv;
      const int k = 4 * jt + quad;
      impA[(w * 16 + l15) * 32 + k] = s[jt][0] + s[jt][1] + s[jt][2] + 0.5f * s[jt][3];
      impB[(w * 16 + l15) * 33 + k + 1] = 0.5f * s[jt][3];
    }
    f4v oc[4];
#pragma unroll
    for (int dt = 0; dt < 4; ++dt) oc[dt] = fz();
#pragma unroll
    for (int kp = 0; kp < 4; ++kp) {
      if (2 * kp < njt) {
        const s8v pb = pack8(s[2 * kp], s[2 * kp + 1]);
#pragma unroll
        for (int dt = 0; dt < 4; ++dt) {
          const u16* vr = vcs + (16 * dt + l15) * VS + 32 * kp + quad * 4;
          oc[dt] = MFMA16(cat44(ld4(vr), ld4(vr + 16)), pb, oc[dt]);
        }
      }
    }
    {
      const float g0 = sigmoidf_(bf2f(P[trow * LDP + C_G + H * 3 + 0]));
      u16* oo = (u16*)(p.ws + O_OCMP) + trow * 1024 + H * 64 + quad * 4;
#pragma unroll
      for (int dt = 0; dt < 4; ++dt) st4bf(oo + 16 * dt, oc[dt][0] * g0, oc[dt][1] * g0, oc[dt][2] * g0, oc[dt][3] * g0);
    }
    __syncthreads();
#pragma unroll
    for (int r = 0; r < 2; ++r) {
      const int idx = tid + 256 * r, q = idx >> 5, k = idx & 31;
      float im = 0.f;
#pragma unroll
      for (int hh = 0; hh < 4; ++hh) {
        im += impA[(hh * 16 + q) * 32 + k];
        if (k > 0) im += impB[(hh * 16 + q) * 33 + k];
      }
      const int blk = (q0 + q) >> 6;
      const bool forced = (k == 0) | (k == blk) | (k == blk - 1);
      scl[q * 32 + k] = forced ? im + 1000.f : ((k <= blk) ? im : -1.f);
    }
    __syncthreads();
    unsigned* sel = (unsigned*)(p.ws + O_SEL) + (size_t)(b * 4 + g) * SEQ + q0;
#pragma unroll
    for (int r = 0; r < 2; ++r) {
      const int idx = tid + 256 * r, q = idx >> 5, k = idx & 31;
      const float me = scl[q * 32 + k];
      int cnt = 0;
#pragma unroll
      for (int k2 = 0; k2 < 32; ++k2) {
        const float o = scl[q * 32 + k2];
        cnt += (o > me || (o == me && k2 < k)) ? 1 : 0;
      }
      const unsigned long long bal = __ballot(cnt < 16);
      if (k == 0) sel[q] = (unsigned)(bal >> (32 * (lane >> 5)));
    }
    __syncthreads();
  }
}

DI void phaseE(const Params& p, float* smf, int sub, int pass, int rep) {
  constexpr int N_SSD = NBG * 256;
  for (int it = blockIdx.x; it < N_SSD; it += gridDim.x) ssd_item(p, it, (u16*)smf);
}

DI void scan_item(const Params& p, int it) {
  const int gid = it * 256 + tidx();
  const int e = gid & 1023, hd = (gid >> 10) & 31, b = gid >> 15;
  u16* stb = (u16*)(p.ws + O_ST);
  const float* acs = (const float*)(p.ws + O_ACS) + ((size_t)b * 32 + hd) * SEQ;
  float carry[8];
#pragma unroll
  for (int j = 0; j < 8; ++j) carry[j] = 0.f;
  s8v sv[16];
  float dec[16];
#pragma unroll
  for (int c = 0; c < 16; ++c) {
    sv[c] = ld8(stb + (((size_t)(b * 16 + c) * 32 + hd) * 8192) + e * 8);
    dec[c] = acs[c * 128 + 127];
  }
#pragma unroll
  for (int c = 0; c < 16; ++c) {
    u16* ptr = stb + (((size_t)(b * 16 + c) * 32 + hd) * 8192) + e * 8;
    const float dc = __expf(dec[c]);
    const s8v pv = pack8f(carry);
#pragma unroll
    for (int j = 0; j < 8; ++j) carry[j] = carry[j] * dc + bfs(sv[c][j]);
    *reinterpret_cast<s8v*>(ptr) = pv;
  }
}

template <bool WIN, bool MASKED>
DI void attn_tile(const u16* Kt, const u16* Vt, const s8v (&qf)[2], const f4v (&cb)[4], int t, int kb, int q0, bool selb,
                  float slope2, float& m, float& l, f4v (&o)[4]) {
  const int lane = tidx() & 63, l15 = lane & 15, quad = lane >> 4;
  constexpr int LS = 72;
  const float bkb = slope2 * (float)(64 * kb - q0);
  f4v s[4];
#pragma unroll
  for (int kt = 0; kt < 4; ++kt) {
    s[kt] = cb[kt] + bkb;
    const u16* kr = Kt + (16 * kt + l15) * LS + quad * 8;
    s[kt] = MFMA16(ld8(kr), qf[0], s[kt]);
    s[kt] = MFMA16(ld8(kr + 32), qf[1], s[kt]);
  }
  if (MASKED) {
    const int dd0 = t - (64 * kb + 4 * quad);
#pragma unroll
    for (int kt = 0; kt < 4; ++kt)
#pragma unroll
      for (int i = 0; i < 4; ++i) {
        const int dd = dd0 - (16 * kt + i);
        const bool ok = WIN ? ((unsigned)dd < 512u) : (selb && dd >= 0);
        s[kt][i] = ok ? s[kt][i] : NEGB;
      }
  }
  float mx = fmaxf(fmaxf(fmaxf(s[0][0], s[0][1]), fmaxf(s[0][2], s[0][3])), fmaxf(fmaxf(s[1][0], s[1][1]), fmaxf(s[1][2], s[1][3])));
  mx = fmaxf(mx, fmaxf(fmaxf(fmaxf(s[2][0], s[2][1]), fmaxf(s[2][2], s[2][3])), fmaxf(fmaxf(s[3][0], s[3][1]), fmaxf(s[3][2], s[3][3]))));
  mx = qmax(mx);
  if (__ballot(mx > m) != 0ull) {
    const float mn = fmaxf(m, mx);
    const float alpha = __builtin_amdgcn_exp2f(m - mn);
    m = mn;
    l *= alpha;
#pragma unroll
    for (int dt = 0; dt < 4; ++dt) o[dt] = o[dt] * alpha;
  }
  float ps = 0.f;
#pragma unroll
  for (int kt = 0; kt < 4; ++kt)
#pragma unroll
    for (int i = 0; i < 4; ++i) {
      float e = __builtin_amdgcn_exp2f(s[kt][i] - m);
      if (MASKED) e = (s[kt][i] > -1e29f) ? e : 0.f;
      s[kt][i] = e;
      ps += e;
    }
  l += ps;
#pragma unroll
  for (int kp = 0; kp < 2; ++kp) {
    const s8v pb = pack8(s[2 * kp], s[2 * kp + 1]);
#pragma unroll
    for (int dt = 0; dt < 4; ++dt) {
      const u16* vr = Vt + (16 * dt + l15) * LS + 32 * kp + quad * 4;
      o[dt] = MFMA16(cat44(ld4(vr), ld4(vr + 16)), pb, o[dt]);
    }
  }
}

template <bool WIN, int AV>
DI void attn_pass(const u16* __restrict__ Kbase  , const u16* __restrict__ VT  ,
                  const s8v (&qf)[2], const f4v (&cb)[4], int t, int q0, unsigned mymask, float slope2, unsigned tiles, f4v (&o)[4],
                  float& lout, u16* sm) {
  const int tid = tidx();
  constexpr int LS = 72, TB = 64 * LS;
  const int lrow = tid >> 3, lseg = tid & 7;
  const int blk = q0 >> 6;
  float m = NEGB, l = 0.f;
#pragma unroll
  for (int dt = 0; dt < 4; ++dt) o[dt] = fz();
  const u16* kp0 = Kbase + (size_t)lrow * LDP + lseg * 8;
  const u16* vp0 = VT + (size_t)lrow * TS + lseg * 8;
#define AT_LOAD(RK, RV, KB)                                                            \
  do {                                                                                 \
    RK[0] = ld8(kp0 + (size_t)(64 * (KB)) * LDP);                                       \
    RK[1] = ld8(kp0 + (size_t)(64 * (KB) + 32) * LDP);                                  \
    RV[0] = ld8(vp0 + 64 * (KB));                                                       \
    RV[1] = ld8(vp0 + (size_t)32 * TS + 64 * (KB));                                    \
  } while (0)
#define AT_STORE(RK, RV, BUF)                                                          \
  do {                                                                                 \
    u16* _d = sm + (BUF) * 2 * TB + lrow * LS + lseg * 8;                               \
    *reinterpret_cast<s8v*>(_d) = RK[0];                                                \
    *reinterpret_cast<s8v*>(_d + 32 * LS) = RK[1];                                      \
    *reinterpret_cast<s8v*>(_d + TB) = RV[0];                                           \
    *reinterpret_cast<s8v*>(_d + TB + 32 * LS) = RV[1];                                 \
  } while (0)
#define AT_POPL() do { if (tl) { kbl = 31 - __builtin_clz(tl); tl &= ~(1u << kbl); } } while (0)
#define AT_STEP(RK, RV)                                                                                              \
  {                                                                                                                  \
    const int kb = 31 - __builtin_clz(tc);                                                                            \
    tc &= ~(1u << kb);                                                                                                \
    const u16* Kt = sm + cur * 2 * TB;                                                                                \
    const bool selb = WIN ? true : (((mymask >> kb) & 1u) != 0u);                                                     \
    const bool need = WIN ? ((kb == blk) || (64 * kb <= q0 - 497)) : ((kb == blk) || (__ballot(selb) != ~0ull));      \
    if (AV != 2) {                                                                                                    \
    if (need) attn_tile<WIN, true>(Kt, Kt + TB, qf, cb, t, kb, q0, selb, slope2, m, l, o);                            \
    else attn_tile<WIN, false>(Kt, Kt + TB, qf, cb, t, kb, q0, selb, slope2, m, l, o);                                \
    }                                                                                                                 \
    if (AV != 1) {                                                                                                    \
    if (tc) AT_STORE(RK, RV, cur ^ 1);                                                                                \
    AT_POPL();                                                                                                        \
    AT_LOAD(RK, RV, kbl);                                                                                             \
    }                                                                                                                 \
    __syncthreads();                                                                                                  \
    if (!tc) break;                                                                                                   \
    cur ^= 1;                                                                                                         \
  }
  unsigned tc = tiles, tl = tiles;
  s8v ak[2], av[2], bk[2], bv[2];
  int kbl = 0;
  AT_POPL();
  AT_LOAD(ak, av, kbl);
  AT_STORE(ak, av, 0);
  AT_POPL();
  AT_LOAD(ak, av, kbl);
  AT_POPL();
  AT_LOAD(bk, bv, kbl);
  __syncthreads();
  int cur = 0;
  while (true) {
    AT_STEP(ak, av)
    AT_STEP(bk, bv)
  }
#undef AT_LOAD
#undef AT_STORE
#undef AT_POPL
#undef AT_STEP
  lout = qsum(l);
}

DI void cmp_part(const Params& p, int b, int g, int q0, const s8v (&qf)[2], unsigned char* smraw, f4v (&oc)[4], unsigned& mymask) {
  const int tid = tidx(), lane = tid & 63, w = tid >> 6, l15 = lane & 15, quad = lane >> 4;
  const int H = g * 4 + w;
  const float slope = exp2f(-0.5f * (float)(H + 1));
  const u16* P = (const u16*)(p.ws + O_P);
  const u16* kcg = (const u16*)(p.ws + O_KCMP) + (size_t)(b * 4 + g) * 128 * 64;
  const u16* vcg = (const u16*)(p.ws + O_VCT) + (size_t)(b * 4 + g) * 64 * 128;
  constexpr int KS = 72, VS = 136;
  u16* kcs = reinterpret_cast<u16*>(smraw);
  u16* vcs = kcs + 128 * KS;
  float* impA = reinterpret_cast<float*>(smraw + 36864);
  float* impB = impA + 2048;
  float* scl = impB + 2112;
  unsigned* selm = reinterpret_cast<unsigned*>(scl + 512);
  const int njt = (q0 >= 16) ? (((q0 - 16) >> 8) + 1) : 0;
  {
    s8v r0[4], r1[4];
#pragma unroll
    for (int r = 0; r < 4; ++r) {
      const int idx = tid + 256 * r;
      r0[r] = ld8(kcg + (size_t)(idx >> 3) * 64 + (idx & 7) * 8);
      r1[r] = ld8(vcg + (size_t)(idx >> 4) * 128 + (idx & 15) * 8);
    }
#pragma unroll
    for (int r = 0; r < 4; ++r) {
      const int idx = tid + 256 * r;
      *reinterpret_cast<s8v*>(kcs + (idx >> 3) * KS + (idx & 7) * 8) = r0[r];
      *reinterpret_cast<s8v*>(vcs + (idx >> 4) * VS + (idx & 15) * 8) = r1[r];
    }
  }
  __syncthreads();
  const int t = q0 + l15;
  const size_t trow = (size_t)(b * SEQ + t);
  f4v s[8];
#pragma unroll
  for (int jt = 0; jt < 8; ++jt) {
    s[jt] = fz();
    if (jt < njt) {
#pragma unroll
      for (int ks = 0; ks < 2; ++ks) s[jt] = MFMA16(ld8(kcs + (16 * jt + l15) * KS + ks * 32 + quad * 8), qf[ks], s[jt]);
    }
  }
  float mx = NEGB;
#pragma unroll
  for (int jt = 0; jt < 8; ++jt)
#pragma unroll
    for (int i = 0; i < 4; ++i) {
      const int j = 16 * jt + 4 * quad + i;
      const int dist = t - (16 * j + 31);
      const float sc = (dist >= 0) ? s[jt][i] * 0.125f - slope * (float)dist : NEGB;
      s[jt][i] = sc;
      mx = fmaxf(mx, sc);
    }
  mx = qmax(mx);
  float lsum = 0.f;
#pragma unroll
  for (int jt = 0; jt < 8; ++jt)
#pragma unroll
    for (int i = 0; i < 4; ++i) {
      const float e = (s[jt][i] > -1e29f) ? __expf(s[jt][i] - mx) : 0.f;
      s[jt][i] = e;
      lsum += e;
    }
  lsum = qsum(lsum);
  const float inv = lsum > 0.f ? 1.f / lsum : 0.f;
#pragma unroll
  for (int jt = 0; jt < 8; ++jt) {
    s[jt] = s[jt] * inv;
    const int k = 4 * jt + quad;
    impA[(w * 16 + l15) * 32 + k] = s[jt][0] + s[jt][1] + s[jt][2] + 0.5f * s[jt][3];
    impB[(w * 16 + l15) * 33 + k + 1] = 0.5f * s[jt][3];
  }
#pragma unroll
  for (int dt = 0; dt < 4; ++dt) oc[dt] = fz();
#pragma unroll
  for (int kp = 0; kp < 4; ++kp) {
    if (2 * kp < njt) {
      const s8v pb = pack8(s[2 * kp], s[2 * kp + 1]);
#pragma unroll
      for (int dt = 0; dt < 4; ++dt) {
        const u16* vr = vcs + (16 * dt + l15) * VS + 32 * kp + quad * 4;
        oc[dt] = MFMA16(cat44(ld4(vr), ld4(vr + 16)), pb, oc[dt]);
      }
    }
  }
  {
    const float g0 = sigmoidf_(bf2f(P[trow * LDP + C_G + H * 3 + 0]));
#pragma unroll
    for (int dt = 0; dt < 4; ++dt) oc[dt] = oc[dt] * g0;
  }
  __syncthreads();
#pragma unroll
  for (int r = 0; r < 2; ++r) {
    const int idx = tid + 256 * r, q = idx >> 5, k = idx & 31;
    float im = 0.f;
#pragma unroll
    for (int hh = 0; hh < 4; ++hh) {
      im += impA[(hh * 16 + q) * 32 + k];
      if (k > 0) im += impB[(hh * 16 + q) * 33 + k];
    }
    const int blk = (q0 + q) >> 6;
    const bool forced = (k == 0) | (k == blk) | (k == blk - 1);
    scl[q * 32 + k] = forced ? im + 1000.f : ((k <= blk) ? im : -1.f);
  }
  __syncthreads();
#pragma unroll
  for (int r = 0; r < 2; ++r) {
    const int idx = tid + 256 * r, q = idx >> 5, k = idx & 31;
    const float me = scl[q * 32 + k];
    int cnt = 0;
#pragma unroll
    for (int k2 = 0; k2 < 32; ++k2) {
      const float o = scl[q * 32 + k2];
      cnt += (o > me || (o == me && k2 < k)) ? 1 : 0;
    }
    const unsigned long long bal = __ballot(cnt < 16);
    if (k == 0) selm[q] = (unsigned)(bal >> (32 * (lane >> 5)));
  }
  __syncthreads();
  mymask = selm[l15];
  __syncthreads();
}

template <int AV>
DI void attn_item(const Params& p, int it, u16* sm) {
  const int tid = tidx(), lane = tid & 63, w = tid >> 6, l15 = lane & 15, quad = lane >> 4;
  const int tq = it & 127, g = (it >> 7) & 3, b = it >> 9;
  const int q0 = tq * 16;
  const int H = g * 4 + w;
  const float slope2 = exp2f(-0.5f * (float)(H + 1)) * 1.4426950408889634f;
  constexpr float SCALE2 = 0.125f * 1.4426950408889634f;
  const u16* P = (const u16*)(p.ws + O_P);
  const int t = q0 + l15;
  const size_t trow = (size_t)(b * SEQ + t);
  s8v qf[2], qraw[2];
#pragma unroll
  for (int ks = 0; ks < 2; ++ks) {
    const s8v raw = ld8(P + trow * LDP + C_Q + H * 64 + ks * 32 + quad * 8);
    qraw[ks] = raw;
    float qs[8];
#pragma unroll
    for (int j = 0; j < 8; ++j) qs[j] = bfs(raw[j]) * SCALE2;
    qf[ks] = pack8f(qs);
  }
  f4v ocm[4];
  unsigned mymask;
  cmp_part(p, b, g, q0, qraw, reinterpret_cast<unsigned char*>(sm), ocm, mymask);
  f4v cb[4];
#pragma unroll
  for (int kt = 0; kt < 4; ++kt)
#pragma unroll
    for (int i = 0; i < 4; ++i) cb[kt][i] = slope2 * (float)(16 * kt + 4 * quad + i);
  const int blk = q0 >> 6;
  const unsigned upto = (blk >= 31) ? 0xffffffffu : ((2u << blk) - 1u);
  unsigned um = mymask;
#pragma unroll
  for (int o = 1; o < 64; o <<= 1) um |= (unsigned)__shfl_xor((int)um, o);
  um = (unsigned)__builtin_amdgcn_readfirstlane((int)(um & upto));
  f4v os[4], ow[4];
  float ls, lw;
  attn_pass<false, AV>(P + (size_t)(b * SEQ) * LDP + C_KS + g * 64, (const u16*)(p.ws + O_VST) + (size_t)(b * 4 + g) * 64 * TS, qf, cb, t,
                   q0, mymask, slope2, um, os, ls, sm);
  const int wlo = (q0 - 511 > 0 ? q0 - 511 : 0) >> 6;
  const unsigned wm_ = (unsigned)__builtin_amdgcn_readfirstlane((int)(upto & ~((1u << wlo) - 1u)));
  attn_pass<true, AV>(P + (size_t)(b * SEQ) * LDP + C_KW + g * 64, (const u16*)(p.ws + O_VWT) + (size_t)(b * 4 + g) * 64 * TS, qf, cb, t,
                  q0, 0u, slope2, wm_, ow, lw, sm);
  if (AV != 0) { if (ls + lw + os[0][0] + ow[3][3] != 12345.678f) return; }
  const float g1 = sigmoidf_(bf2f(P[trow * LDP + C_G + H * 3 + 1])) / ls;
  const float g2 = sigmoidf_(bf2f(P[trow * LDP + C_G + H * 3 + 2])) / lw;
  const u16* za = P + trow * LDP + C_ZA + H * 64;
  u16* oo = (u16*)(p.ws + O_O) + trow * 1024 + H * 64;
  f4v rr[4];
  s4v zq[4];
  ld8bf_pair(za, quad, zq[0], zq[1]);
  ld8bf_pair(za + 32, quad, zq[2], zq[3]);
#pragma unroll
  for (int dt = 0; dt < 4; ++dt) {
#pragma unroll
    for (int i = 0; i < 4; ++i) rr[dt][i] = (ocm[dt][i] + g1 * os[dt][i] + g2 * ow[dt][i]) * siluf_(bfs(zq[dt][i]));
  }
  st8bf_pair(oo, rr[0], rr[1], quad);
  st8bf_pair(oo + 32, rr[2], rr[3], quad);
}

DI void phaseF(const Params& p, bool noscan, u16* sm, int pass, int rep) {
  constexpr int N_SC = NBG * 32 * 1024 / 256;
  const int xq = blockIdx.x & 7, lbq = blockIdx.x >> 3, nl = (int)gridDim.x >> 3;
  unsigned* ctr = q_counter(p, pass, 2, rep) + xq;
  const int nend = noscan ? 128 : 128 + N_SC / 8;
  bool first = true;
  while (true) {
    const int j = first ? lbq : q_next(ctr) + nl;
    first = false;
    if (j >= nend) break;
    if (j < 128) attn_item<0>(p, (xq >> 2) * 512 + (xq & 3) * 128 + (127 - j), sm);
    else scan_item(p, (j - 128) * 8 + xq);
  }
}

DI void phaseG(const Params& p, float* smf) {
  const int tid = tidx(), lane = tid & 63, w = tid >> 6, l15 = lane & 15, quad = lane >> 4;
  const u16* xc = (const u16*)(p.ws + O_XC);
  const u16* P = (const u16*)(p.ws + O_P);
  const u16* yd = (const u16*)(p.ws + O_YD);
  const u16* stb = (const u16*)(p.ws + O_ST);
  const float* acsb = (const float*)(p.ws + O_ACS);
  u16* yn = (u16*)(p.ws + O_YN);
  for (int it = blockIdx.x; it < NBG * 256; it += gridDim.x) {
    const int lq = (it >> 3) & 3, cgx = ((it >> 5) << 3) | (it & 7);
    const int g = cgx & 3, c = (cgx >> 2) & 15, b = cgx >> 6;
    const int t0 = b * SEQ + c * 128 + 32 * lq + l15;
    s8v cf[2][4];
#pragma unroll
    for (int li = 0; li < 2; ++li)
#pragma unroll
      for (int ks = 0; ks < 4; ++ks) cf[li][ks] = ld8(xc + (size_t)(t0 + 16 * li) * 3072 + 2560 + g * 128 + ks * 32 + quad * 8);
    f4v y[2][4][2];
    f4v* park = reinterpret_cast<f4v*>(smf + 1024);
    float ss[2] = {0.f, 0.f};
#pragma unroll
    for (int hh = 0; hh < 2; ++hh) {
      const int hd = g * 8 + 2 * w + hh;
      const u16* pv = stb + (((size_t)(b * 16 + c) * 32 + hd) * 64) * 128;
      s8v pf[4][4];
      s4v d4[4], z4[4];
#pragma unroll
      for (int pt = 0; pt < 4; ++pt) {
#pragma unroll
        for (int ks = 0; ks < 4; ++ks) pf[pt][ks] = ld8(pv + (size_t)(16 * pt + l15) * 128 + ks * 32 + quad * 8);
      }
#pragma unroll
      for (int pp = 0; pp < 2; ++pp) {
        ld8bf_pair(yd + (size_t)t0 * 2048 + hd * 64 + 32 * pp, quad, d4[2 * pp], d4[2 * pp + 1]);
        ld8bf_pair(P + (size_t)t0 * LDP + C_Z + hd * 64 + 32 * pp, quad, z4[2 * pp], z4[2 * pp + 1]);
      }
      float ea[2];
#pragma unroll
      for (int li = 0; li < 2; ++li) ea[li] = __expf(acsb[((size_t)b * 32 + hd) * SEQ + (t0 + 16 * li - b * SEQ)]);
      __builtin_amdgcn_sched_barrier(0);
#pragma unroll
      for (int pt = 0; pt < 4; ++pt) {
        y[hh][pt][0] = fz(); y[hh][pt][1] = fz();
#pragma unroll
        for (int ks = 0; ks < 4; ++ks) {
          y[hh][pt][0] = MFMA16(pf[pt][ks], cf[0][ks], y[hh][pt][0]);
          y[hh][pt][1] = MFMA16(pf[pt][ks], cf[1][ks], y[hh][pt][1]);
        }
      }
      __builtin_amdgcn_sched_barrier(0);
      s4v d5[4], z5[4];
#pragma unroll
      for (int pp = 0; pp < 2; ++pp) {
        ld8bf_pair(yd + (size_t)(t0 + 16) * 2048 + hd * 64 + 32 * pp, quad, d5[2 * pp], d5[2 * pp + 1]);
        ld8bf_pair(P + (size_t)(t0 + 16) * LDP + C_Z + hd * 64 + 32 * pp, quad, z5[2 * pp], z5[2 * pp + 1]);
      }
      __builtin_amdgcn_sched_barrier(0);
#pragma unroll
      for (int pt = 0; pt < 4; ++pt)
#pragma unroll
        for (int i = 0; i < 4; ++i) {
          const float v = (bfs(d4[pt][i]) + y[hh][pt][0][i] * ea[0]) * siluf_(bfs(z4[pt][i]));
          y[hh][pt][0][i] = v;
          ss[0] += v * v;
        }
      __builtin_amdgcn_sched_barrier(0);
#pragma unroll
      for (int pt = 0; pt < 4; ++pt)
#pragma unroll
        for (int i = 0; i < 4; ++i) {
          const float v = (bfs(d5[pt][i]) + y[hh][pt][1][i] * ea[1]) * siluf_(bfs(z5[pt][i]));
          y[hh][pt][1][i] = v;
          ss[1] += v * v;
        }
      if (hh == 0) {
#pragma unroll
        for (int pt = 0; pt < 4; ++pt) { park[(2 * pt) * 256 + tid] = y[0][pt][0]; park[(2 * pt + 1) * 256 + tid] = y[0][pt][1]; }
      }
    }
    ss[0] = qsum(ss[0]); ss[1] = qsum(ss[1]);
    if (quad == 0) { smf[w * 32 + l15] = ss[0]; smf[w * 32 + 16 + l15] = ss[1]; }
    f4v gnv[2][4];
#pragma unroll
    for (int hh = 0; hh < 2; ++hh)
#pragma unroll
      for (int pt = 0; pt < 4; ++pt) gnv[hh][pt] = ldf4(p.g_ssm_norm + (g * 8 + 2 * w + hh) * 64 + 16 * pt + quad * 4);
    __syncthreads();
    float rs[2];
#pragma unroll
    for (int li = 0; li < 2; ++li) {
      const float tot = smf[16 * li + l15] + smf[32 + 16 * li + l15] + smf[64 + 16 * li + l15] + smf[96 + 16 * li + l15];
      rs[li] = rsqrtf(tot * (1.f / 512.f) + EPS);
    }
#pragma unroll
    for (int hh = 0; hh < 2; ++hh) {
      const int hd = g * 8 + 2 * w + hh;
#pragma unroll
      for (int li = 0; li < 2; ++li) {
        f4v nv[4];
#pragma unroll
        for (int pt = 0; pt < 4; ++pt) {
          const f4v v = (hh == 0) ? park[(2 * pt + li) * 256 + tid] : y[1][pt][li];
          nv[pt] = v * gnv[hh][pt] * rs[li];
        }
        u16* nrow = yn + (size_t)(t0 + 16 * li) * 2048 + hd * 64;
        st8bf_pair(nrow, nv[0], nv[1], quad);
        st8bf_pair(nrow + 32, nv[2], nv[3], quad);
      }
    }
    __syncthreads();
  }
}

DI void phaseH(const Params& p, u16* smem) {
  const int lane = tidx() & 63, w = tidx() >> 6, wm = w >> 1, wn = w & 1, l15 = lane & 15, quad = lane >> 4;
  const u16* P = (const u16*)(p.ws + O_P);
  u16* mg = (u16*)(p.ws + O_H);
  float* tmp = (float*)(p.ws + O_YD);
  constexpr int MT = MP / 128;
  for (int it = blockIdx.x; it < MT * 16; it += gridDim.x) {
    const int mi = it % MT, ni = it / MT;
    f4v acc[4][2];
    u2v keep[4][2];
    zero_acc<2>(acc);
    gemm_k64(acc, (const u16*)(p.ws + O_YN), 2048, (const u16*)(p.ws + O_WSSM), 2048, 2048, mi * 128, ni * 64, smem);
    s4v gq[4][2];
#pragma unroll
    for (int mt = 0; mt < 4; ++mt)
      ld8bf_pair(P + (size_t)(mi * 128 + wm * 64 + mt * 16 + l15) * LDP + C_MG + ni * 64 + wn * 32, quad, gq[mt][0], gq[mt][1]);
    __builtin_amdgcn_sched_barrier(0);
#pragma unroll
    for (int mt = 0; mt < 4; ++mt)
#pragma unroll
      for (int nt = 0; nt < 2; ++nt) {
        const int m = mi * 128 + wm * 64 + mt * 16 + l15, n = ni * 64 + wn * 32 + nt * 16 + quad * 4;
        const s4v g0 = gq[mt][nt];
        f4v r;
#pragma unroll
        for (int i = 0; i < 4; ++i) r[i] = sigmoidf_(bfs(g0[i])) * acc[mt][nt][i];
        u2v kp = {pk2(r[0], r[1]), pk2(r[2], r[3])};
        keep[mt][nt] = kp;
      }
    zero_acc<2>(acc);
    gemm_k64(acc, (const u16*)(p.ws + O_O), 1024, (const u16*)(p.ws + O_WNSA), 1024, 1024, mi * 128, ni * 64, smem);
    f4v tq[4][2];
#pragma unroll
    for (int mt = 0; mt < 4; ++mt)
      ld8bf_pair(P + (size_t)(mi * 128 + wm * 64 + mt * 16 + l15) * LDP + C_MG + 1024 + ni * 64 + wn * 32, quad, gq[mt][0], gq[mt][1]);
#pragma unroll
    for (int mt = 0; mt < 4; ++mt)
#pragma unroll
      for (int nt = 0; nt < 2; ++nt) {
        const u2v kp = keep[mt][nt];
        f4v tv = {__uint_as_float(kp[0] << 16), __uint_as_float(kp[0] & 0xffff0000u), __uint_as_float(kp[1] << 16),
                  __uint_as_float(kp[1] & 0xffff0000u)};
        tq[mt][nt] = tv;
      }
    __builtin_amdgcn_sched_barrier(0);
#pragma unroll
    for (int mt = 0; mt < 4; ++mt) {
      f4v rr[2];
#pragma unroll
      for (int nt = 0; nt < 2; ++nt) {
        const s4v g1 = gq[mt][nt];
        const f4v t0 = tq[mt][nt];
#pragma unroll
        for (int i = 0; i < 4; ++i) rr[nt][i] = t0[i] + sigmoidf_(bfs(g1[i])) * acc[mt][nt][i];
      }
      st8bf_pair(mg + (size_t)(mi * 128 + wm * 64 + mt * 16 + l15) * 1024 + ni * 64 + wn * 32, rr[0], rr[1], quad);
    }
  }
}

DI void phaseI(const Params& p, u16* smem) {
  const int lane = tidx() & 63, w = tidx() >> 6, wm = w >> 1, wn = w & 1, l15 = lane & 15, quad = lane >> 4;
  u16* outb = (u16*)(p.ws + O_OUTF);
  float* rsq = (float*)(p.ws + O_RSQ);
  constexpr int MT = MP / 128;
  for (int it = blockIdx.x; it < MT * 16; it += gridDim.x) {
    const int mi = it % MT, ni = it / MT;
    f4v acc[4][2];
    zero_acc<2>(acc);
    gemm_k64(acc, (const u16*)(p.ws + O_H), 1024, (const u16*)(p.ws + O_WOUT), 1024, 1024, mi * 128, ni * 64, smem);
#pragma unroll
    for (int mt = 0; mt < 4; ++mt) {
      const int m = mi * 128 + wm * 64 + mt * 16 + l15;
      float ss = 0.f;
#pragma unroll
      for (int nt = 0; nt < 2; ++nt) {
        const f4v v = acc[mt][nt];
        ss += v[0] * v[0] + v[1] * v[1] + v[2] * v[2] + v[3] * v[3];
      }
      st8bf_pair(outb + (size_t)m * 1024 + ni * 64 + wn * 32, acc[mt][0], acc[mt][1], quad);
      ss = qsum(ss);
      if (quad == 0) rsq[(size_t)m * 32 + ni * 2 + wn] = ss;
    }
  }
}

DI void phaseJ(const Params& p, int pass) {
  const int tid = tidx(), lane = tid & 63, w = tid >> 6;
  const u16* outb = (const u16*)(p.ws + O_OUTF);
  const float* rsq = (const float*)(p.ws + O_RSQ);
  const float* ada = (const float*)(p.ws + O_ADA);
  for (int it = blockIdx.x; it < MP / 4; it += gridDim.x) {
    const int r = it * 4 + w;
    const int tg = pass * MP + r, b = tg >> 11;
    float part = (lane < 32) ? rsq[(size_t)r * 32 + lane] : 0.f;
    s4v ob[4];
    f4v xv[4], gp[4], gt[4];
#pragma unroll
    for (int i = 0; i < 4; ++i) {
      const int c0 = i * 256 + lane * 4;
      ob[i] = ld4(outb + (size_t)r * 1024 + c0);
      xv[i] = ldf4(p.x + (size_t)tg * 1024 + c0);
      gp[i] = ldf4(p.g_post + c0);
      gt[i] = ldf4(ada + b * 3072 + 2048 + c0);
    }
    __builtin_amdgcn_sched_barrier(0);
#pragma unroll
    for (int o = 1; o < 64; o <<= 1) part += __shfl_xor(part, o);
    const float rstd = rsqrtf(part * (1.f / 1024.f) + EPS);
#pragma unroll
    for (int i = 0; i < 4; ++i) {
      const int c0 = i * 256 + lane * 4;
      f4v rr;
#pragma unroll
      for (int k = 0; k < 4; ++k) rr[k] = xv[i][k] + gt[i][k] * (bfs(ob[i][k]) * rstd * gp[i][k]);
      *reinterpret_cast<f4v*>(p.out + (size_t)tg * 1024 + c0) = rr;
    }
  }
}

#define XB_TMO      128
#define XB_XCNT(j)  (256  + 64 * (j))
#define XB_XSUB(j)  (1280 + 64 * (j))
#define XB_XGEN(j)  (2304 + 64 * (j))
#define XB_TOP      3328
#define XB_TOPGEN   3392
#define XCD_BAR_WORDS 3456
#define XB_SPIN_CAP (1u << 18)
#define LAS __attribute__((address_space(3)))
DI unsigned xb_ld(unsigned* p)              { return __hip_atomic_load(p, __ATOMIC_RELAXED, __HIP_MEMORY_SCOPE_AGENT); }
DI unsigned xb_add(unsigned* p, unsigned v) { return __hip_atomic_fetch_add(p, v, __ATOMIC_RELAXED, __HIP_MEMORY_SCOPE_AGENT); }
DI unsigned xb_xcc_id() { return (unsigned)__builtin_amdgcn_s_getreg((3 << 11) | 20) & 0xFu; }
#define XB_SPIN(cond, bar) do { unsigned _sp = 0; while (cond) { __builtin_amdgcn_s_sleep(1); \
    if ((++_sp & 255u) == 0u) { if (xb_ld(&(bar)[XB_TMO])) break; if (_sp > XB_SPIN_CAP) { atomicAdd(&(bar)[XB_TMO], 1u); break; } } } } while (0)
struct XcdBarrier { unsigned* bar; unsigned x; volatile LAS unsigned* st; };
DI XcdBarrier xcd_barrier_post(unsigned* bar, volatile LAS unsigned* st) {
  XcdBarrier b; b.bar = bar; b.x = xb_xcc_id(); b.st = st;
  if (threadIdx.x == 0) (void)xb_add(&bar[XB_XCNT(b.x)], 1u);
  return b;
}
DI void xcd_barrier_complete(unsigned* bar, unsigned x, unsigned& nloc, unsigned& nx) {
  const unsigned G = gridDim.x * gridDim.y * gridDim.z;
  unsigned sum, cnt, mine, sp = 0u;
  for (;;) {
    sum = 0u; cnt = 0u; mine = 0u;
#pragma unroll
    for (unsigned j = 0; j < 16; ++j) { const unsigned c = xb_ld(&bar[XB_XCNT(j)]); sum += c; cnt += (c > 0u) ? 1u : 0u; mine = (j == x) ? c : mine; }
    if (sum == G) break;
    __builtin_amdgcn_s_sleep(1);
    if ((++sp & 255u) == 0u) { if (xb_ld(&bar[XB_TMO])) break; if (sp > XB_SPIN_CAP) { atomicAdd(&bar[XB_TMO], 1u); break; } }
  }
  nloc = mine > 0u ? mine : 1u; nx = cnt > 0u ? cnt : 1u;
}
DI void xcd_barrier(const XcdBarrier& b) {
  asm volatile("s_waitcnt vmcnt(0)" ::: "memory");
  __syncthreads();
  if (threadIdx.x == 0) {
    unsigned* bar = b.bar;
    __builtin_amdgcn_s_waitcnt(0);
    unsigned nloc = b.st[0], nx = b.st[1];
    if (nloc == 0u) { xcd_barrier_complete(bar, b.x, nloc, nx); b.st[0] = nloc; b.st[1] = nx; }
    const unsigned old = xb_add(&bar[XB_XSUB(b.x)], 1u);
    const unsigned gen = old / nloc;
    if (old + 1u == (gen + 1u) * nloc) {
      __builtin_amdgcn_fence(__ATOMIC_RELEASE, "agent");
      asm volatile("s_waitcnt vmcnt(0)" ::: "memory");
      const unsigned og = xb_add(&bar[XB_TOP], 1u);
      const unsigned tg = og / nx;
      if (og + 1u == (tg + 1u) * nx) xb_add(&bar[XB_TOPGEN], 1u);
      else XB_SPIN(xb_ld(&bar[XB_TOPGEN]) == tg, bar);
      __builtin_amdgcn_fence(__ATOMIC_ACQUIRE, "agent");
      xb_add(&bar[XB_XGEN(b.x)], 1u);
      asm volatile("s_waitcnt vmcnt(0)" ::: "memory");
    } else {
      XB_SPIN(xb_ld(&bar[XB_XGEN(b.x)]) == gen, bar);
      __builtin_amdgcn_fence(__ATOMIC_ACQUIRE, "agent");
      asm volatile("s_waitcnt vmcnt(0)" ::: "memory");
    }
  }
  __syncthreads();
}

constexpr int PH_PER_PASS = 8;
constexpr int N_PHASES = 2 + NPASS * PH_PER_PASS;

constexpr int REP_MASK = 0;
constexpr int REP_SUB = 0;
constexpr int REP_A = 0;
constexpr int CPROBE = 0;
__global__ void __launch_bounds__(256, 2) mega_kernel(Params p, int ph_lo, int ph_hi) {
  __shared__ __attribute__((aligned(16))) unsigned char smem[73728];
  __shared__ uint4 xb_words;
  cg::grid_group grid = cg::this_grid();
  if (threadIdx.x == 0) xb_words = make_uint4(0u, 0u, 0u, 0u);
  __syncthreads();
  const XcdBarrier xb = xcd_barrier_post((unsigned*)(p.ws + O_BAR), (volatile LAS unsigned*)&xb_words);
  for (int ph = ph_lo; ph < ph_hi; ++ph) {
    if (ph == 0) {
      phaseA(p, smem);
      if (REP_A) { xcd_barrier(xb); phaseA(p, smem); }
    } else if (ph == 1) {
      phaseB(p, 0);
    } else {
      const int pass = (ph - 2) / PH_PER_PASS, k = (ph - 2) % PH_PER_PASS;
      Params q = p;
      const int nrep = ((REP_MASK >> k) & 1) ? 2 : 1;
      for (int rep = 0; rep < nrep; ++rep) {
        if (rep) xcd_barrier(xb);
        if (rep && REP_SUB == 9) continue;
        switch (k) {
          case 0: if (REP_MASK != 0 && rep) phaseC<CPROBE>(q, (u16*)smem); else phaseC<0>(q, (u16*)smem); break;
          case 1: phaseD(q, (u16*)smem, rep ? REP_SUB : 0, pass, rep); break;
          case 2: phaseE(q, (float*)smem, rep ? REP_SUB : 0, pass, rep); break;
          case 3: phaseF(q, rep > 0, (u16*)smem, pass, rep); break;
          case 4: phaseG(q, (float*)smem); break;
          case 5: phaseH(q, (u16*)smem); break;
          case 6: phaseI(q, (u16*)smem); break;
          default:
            phaseJ(q, pass);
            if (pass + 1 < NPASS) phaseB(q, pass + 1);
            break;
        }
      }
    }
    if (ph + 1 < ph_hi) {
      if (ph_hi < 0) grid.sync();
      xcd_barrier(xb);
    }
  }
}

extern "C" void kernel_launch(void* const* d_in, const int* in_sizes, int n_in, void* d_out, int out_size, void* d_ws,
                              size_t ws_size, hipStream_t stream) {
  static int grid_blocks = 0;
  if (!grid_blocks) {
    int dev = 0, cus = 0, per_cu = 0;
    hipGetDevice(&dev);
    hipDeviceGetAttribute(&cus, hipDeviceAttributeMultiprocessorCount, dev);
    hipOccupancyMaxActiveBlocksPerMultiprocessor(&per_cu, mega_kernel, 256, 0);
    if (per_cu < 1) per_cu = 1;
    if (per_cu > 2) per_cu = 2;
    grid_blocks = cus * per_cu;
  }
  if (ws_size < O_END) { fprintf(stderr, "workspace too small: %zu < %zu\n", ws_size, (size_t)O_END); return; }
  Params p{};
  const float** pp = reinterpret_cast<const float**>(&p);
  for (int i = 0; i < 22; ++i) pp[i] = (const float*)d_in[i];
  p.out = (float*)d_out;
  p.ws = (unsigned char*)d_ws;
  hipMemsetAsync((unsigned char*)d_ws + O_BAR, 0, 16384, stream);
  int lo = 0, hi = N_PHASES;
  void* args[] = {&p, &lo, &hi};
  hipError_t e = hipLaunchCooperativeKernel((void*)mega_kernel, dim3(grid_blocks), dim3(256), args, 0, stream);
  if (e != hipSuccess) fprintf(stderr, "cooperative launch failed: %s (grid %d)\n", hipGetErrorString(e), grid_blocks);
}
```

```cpp
#include <hip/hip_runtime.h>
#include <hip/hip_cooperative_groups.h>
#include <cstdio>
namespace cg = cooperative_groups;

typedef unsigned short u16;
typedef short s8v __attribute__((ext_vector_type(8)));
typedef short s4v __attribute__((ext_vector_type(4)));
typedef float f4v __attribute__((ext_vector_type(4)));
#define DI __device__ __forceinline__
#define MFMA16(a, b, c) __builtin_amdgcn_mfma_f32_16x16x32_bf16((a), (b), (c), 0, 0, 0)

constexpr int SEQ = 2048, DM = 1024, NB = 8;
constexpr int TS = SEQ + 64;
constexpr int NBG = 2;
constexpr int MP = NBG * SEQ;
constexpr int NPASS = NB / NBG;
constexpr int NIN = 10832, LDP = 10880;
constexpr int C_Z = 0, C_XBC = 2048, C_DT = 5120, C_Q = 5152, C_KC = 6176, C_VC = 6432, C_KS = 6688, C_VS = 6944,
              C_KW = 7200, C_VW = 7456, C_G = 7712, C_ZA = 7760, C_MG = 8784;
constexpr float EPS = 1e-6f;
constexpr float NEGB = -1e30f;
constexpr int APROBE = 0;

constexpr size_t al256(size_t x) { return (x + 255) & ~size_t(255); }
constexpr size_t O_WIN = 0;
constexpr size_t O_WSSM = O_WIN + al256((size_t)LDP * 1024 * 2);
constexpr size_t O_WNSA = O_WSSM + al256((size_t)1024 * 2048 * 2);
constexpr size_t O_WOUT = O_WNSA + al256((size_t)1024 * 1024 * 2);
constexpr size_t O_W1K = O_WOUT + al256((size_t)1024 * 1024 * 2);
constexpr size_t O_W1V = O_W1K + al256((size_t)256 * 2048 * 2);
constexpr size_t O_W2K = O_W1V + al256((size_t)256 * 2048 * 2);
constexpr size_t O_W2V = O_W2K + al256((size_t)64 * 256 * 2);
constexpr size_t O_POSB = O_W2V + al256((size_t)64 * 256 * 2);
constexpr size_t O_ADA = O_POSB + al256(2 * 256 * 4);
constexpr size_t O_H = O_ADA + al256((size_t)8 * 3072 * 4);
constexpr size_t O_P = O_H + al256((size_t)MP * 1024 * 2);
constexpr size_t O_XC = O_P + al256((size_t)MP * LDP * 2);
constexpr size_t O_XCT = O_XC + al256((size_t)MP * 3072 * 2);
constexpr size_t O_DT = O_XCT + al256((size_t)NBG * 2560 * TS * 2);
constexpr size_t O_ACS = O_DT + al256((size_t)NBG * 32 * 2048 * 4);
constexpr size_t O_ST = O_ACS + al256((size_t)NBG * 32 * 2048 * 4);
constexpr size_t O_YD = O_ST + al256((size_t)NBG * 16 * 32 * 64 * 128 * 2);
constexpr size_t O_YN = O_YD + al256((size_t)MP * 2048 * 2);
constexpr size_t O_KCMP = O_YN + al256((size_t)MP * 2048 * 2);
constexpr size_t O_VCT = O_KCMP + al256((size_t)NBG * 4 * 128 * 64 * 2);
constexpr size_t O_VST = O_VCT + al256((size_t)NBG * 4 * 128 * 64 * 2);
constexpr size_t O_VWT = O_VST + al256((size_t)NBG * 4 * 64 * TS * 2);
constexpr size_t O_SEL = O_VWT + al256((size_t)NBG * 4 * 64 * TS * 2);
constexpr size_t O_OCMP = O_SEL + al256((size_t)NBG * 4 * 2048 * 4);
constexpr size_t O_O = O_OCMP + al256((size_t)MP * 1024 * 2);
constexpr size_t O_BAR = O_O + al256((size_t)MP * 1024 * 2);
constexpr size_t O_END = O_BAR + 16384;
static_assert(O_END <= (size_t)256 * 1024 * 1024, "workspace map must fit the guaranteed 256 MiB");
constexpr size_t O_OUTF = O_P;
constexpr size_t O_RSQ = O_P + al256((size_t)MP * 1024 * 4);

struct Params {
  const float *x, *c, *w_ada, *b_ada, *g_pre, *g_post, *w_in, *conv_w, *conv_b, *dt_bias, *a_log, *d_skip, *g_ssm_norm,
      *w_ssm_out, *cmp_pos_k, *cmp_w1_k, *cmp_w2_k, *cmp_pos_v, *cmp_w1_v, *cmp_w2_v, *w_nsa_out, *w_out;
  float* out;
  unsigned char* ws;
};

DI u16 f2bf(float f) { unsigned u = __float_as_uint(f); u += 0x7fffu + ((u >> 16) & 1u); return (u16)(u >> 16); }
DI float bf2f(u16 h) { return __uint_as_float(((unsigned)h) << 16); }
DI float bfs(short h) { return __uint_as_float(((unsigned)(u16)h) << 16); }
DI s8v ld8(const u16* p) { return *reinterpret_cast<const s8v*>(p); }
DI s4v ld4(const u16* p) { return *reinterpret_cast<const s4v*>(p); }
DI f4v ldf4(const float* p) { return *reinterpret_cast<const f4v*>(p); }
typedef __bf16 bf2v __attribute__((ext_vector_type(2)));
typedef float f2v __attribute__((ext_vector_type(2)));
typedef unsigned u2v __attribute__((ext_vector_type(2)));
typedef unsigned u4v __attribute__((ext_vector_type(4)));
DI unsigned pk2(float a, float b) {
  f2v v = {a, b};
  return __builtin_bit_cast(unsigned, __builtin_convertvector(v, bf2v));
}
DI void st4bf(u16* p, float a, float b, float c, float d) {
  u2v v = {pk2(a, b), pk2(c, d)};
  *reinterpret_cast<u2v*>(p) = v;
}
DI void st8bf_pair(u16* p, f4v a, f4v b, int quad) {
  unsigned ax = pk2(a[0], a[1]), ay = pk2(a[2], a[3]), bx = pk2(b[0], b[1]), by = pk2(b[2], b[3]);
  const auto r0 = __builtin_amdgcn_permlane16_swap(ax, bx, false, false);
  const auto r1 = __builtin_amdgcn_permlane16_swap(ay, by, false, false);
  u4v v = {r0[0], r1[0], r0[1], r1[1]};
  *reinterpret_cast<u4v*>(p + (quad & 1) * 16 + (quad >> 1) * 8) = v;
}
DI void ld8bf_pair(const u16* p, int quad, s4v& a, s4v& b) {
  const u4v x = *reinterpret_cast<const u4v*>(p + (quad & 1) * 16 + (quad >> 1) * 8);
  const auto r0 = __builtin_amdgcn_permlane16_swap(x[0], x[2], false, false);
  const auto r1 = __builtin_amdgcn_permlane16_swap(x[1], x[3], false, false);
  u2v ua = {r0[0], r1[0]}, ub = {r0[1], r1[1]};
  a = __builtin_bit_cast(s4v, ua);
  b = __builtin_bit_cast(s4v, ub);
}
DI s8v pack8(f4v a, f4v b) {
  u4v v = {pk2(a[0], a[1]), pk2(a[2], a[3]), pk2(b[0], b[1]), pk2(b[2], b[3])};
  return __builtin_bit_cast(s8v, v);
}
DI s8v pack8f(const float* x) {
  u4v v = {pk2(x[0], x[1]), pk2(x[2], x[3]), pk2(x[4], x[5]), pk2(x[6], x[7])};
  return __builtin_bit_cast(s8v, v);
}
DI s8v cat44(s4v a, s4v b) { s8v v; v[0]=a[0]; v[1]=a[1]; v[2]=a[2]; v[3]=a[3]; v[4]=b[0]; v[5]=b[1]; v[6]=b[2]; v[7]=b[3]; return v; }
DI float sigmoidf_(float x) { return __builtin_amdgcn_rcpf(1.f + __expf(-x)); }
DI float siluf_(float x) { return x * __builtin_amdgcn_rcpf(1.f + __expf(-x)); }
DI float softplusf_(float x) {
  const float y = __expf(x);
  const float small = y * (1.f - y * (0.5f - y * (0.33333334f - 0.25f * y)));
  const float big = __logf(1.f + y);
  return x > 20.f ? x : (y < 0.03f ? small : big);
}
DI float qmax(float v) { v = fmaxf(v, __shfl_xor(v, 16)); v = fmaxf(v, __shfl_xor(v, 32)); return v; }
DI float qsum(float v) { v += __shfl_xor(v, 16); v += __shfl_xor(v, 32); return v; }
DI int tidx() { int t = __builtin_amdgcn_workitem_id_x(); asm volatile("" : "+v"(t)); return t; }
DI f4v fz() { f4v z = {0.f, 0.f, 0.f, 0.f}; return z; }

DI int lds_byte32(int r, int c) {
  const int ob = (r & 15) * 64 + c * 2;
  return (r >> 4) * 1024 + (ob ^ (((ob >> 9) & 1) << 5));
}
DI void stage_rc32(int b, int& R, int& C) {
  const int st = b >> 10, sb = b & 1023, swz = sb ^ (((sb >> 9) & 1) << 5);
  R = st * 16 + (swz >> 6);
  C = (swz & 63) >> 1;
}
template <int N> DI void wait_vm() {
  if constexpr (N == 0) asm volatile("s_waitcnt vmcnt(0)" ::: "memory");
  else if constexpr (N == 3) asm volatile("s_waitcnt vmcnt(3)" ::: "memory");
  else if constexpr (N == 4) asm volatile("s_waitcnt vmcnt(4)" ::: "memory");
  else if constexpr (N == 6) asm volatile("s_waitcnt vmcnt(6)" ::: "memory");
  else asm volatile("s_waitcnt vmcnt(8)" ::: "memory");
}
template <int NT, int MODE = 0>
DI void gemm_mainloop(f4v (&acc)[4][NT], const u16* __restrict__ A, int lda, const u16* __restrict__ Bt, int ldb, int K,
                      int m0, int n0, u16* smem) {
  const int tid = tidx(), lane = tid & 63, w = tid >> 6, wm = w >> 1, wn = w & 1;
  const int l15 = lane & 15, quad = lane >> 4;
  constexpr int TA = 8192, TBB = NT * 2048, TBUF = TA + TBB;
  constexpr int NBP = NT / 2;
  constexpr int L = 2 + NBP;
  char* sbase = reinterpret_cast<char*>(smem);
  const unsigned lbase = (unsigned)(size_t)sbase;
  int Rr[2], Cc[2];
#pragma unroll
  for (int i = 0; i < 2; ++i) stage_rc32(tid * 16 + i * 4096, Rr[i], Cc[i]);
  const u16* ga0 = A + (size_t)(m0 + Rr[0]) * lda + Cc[0];
  const u16* ga1 = A + (size_t)(m0 + Rr[1]) * lda + Cc[1];
  const u16* gb0 = Bt + (size_t)(n0 + Rr[0]) * ldb + Cc[0];
  const u16* gb1 = Bt + (size_t)(n0 + Rr[NBP - 1]) * ldb + Cc[NBP - 1];
  unsigned offa[4], offb[NT];
#pragma unroll
  for (int t = 0; t < 4; ++t) offa[t] = lds_byte32(wm * 64 + t * 16 + l15, quad * 8);
#pragma unroll
  for (int t = 0; t < NT; ++t) offb[t] = TA + lds_byte32(wn * 16 * NT + t * 16 + l15, quad * 8);
  const int ns = K >> 5;
#define GEMM_STAGE(j)                                                                                                 \
  do {                                                                                                               \
    char* _d = sbase + ((j) & 3) * TBUF + tid * 16;                                                                   \
    __builtin_amdgcn_global_load_lds((const unsigned*)(ga0 + (j) * 32), (unsigned*)(_d), 16, 0, 0);                   \
    __builtin_amdgcn_global_load_lds((const unsigned*)(ga1 + (j) * 32), (unsigned*)(_d + 4096), 16, 0, 0);            \
    __builtin_amdgcn_global_load_lds((const unsigned*)(gb0 + (j) * 32), (unsigned*)(_d + TA), 16, 0, 0);              \
    if (NBP == 2) __builtin_amdgcn_global_load_lds((const unsigned*)(gb1 + (j) * 32), (unsigned*)(_d + TA + 4096), 16, 0, 0); \
  } while (0)
  asm volatile("s_waitcnt vmcnt(0)" ::: "memory");
  if (MODE != 1) { GEMM_STAGE(0); GEMM_STAGE(1); GEMM_STAGE(2); }
  for (int j = 0; j < ns; ++j) {
    if (j + 2 < ns) wait_vm<2 * L>();
    else if (j + 1 < ns) wait_vm<L>();
    else wait_vm<0>();
    asm volatile("s_waitcnt lgkmcnt(0)" ::: "memory");
    __builtin_amdgcn_s_barrier();
    if (MODE != 1 && j + 3 < ns) GEMM_STAGE(j + 3);
    if (MODE == 2) continue;
    const unsigned sl = lbase + (unsigned)((j & 3) * TBUF);
    s8v af[4], bg[NT];
    if constexpr (NT == 4) {
      asm volatile(
          "ds_read_b128 %0, %8\n\tds_read_b128 %1, %9\n\tds_read_b128 %2, %10\n\tds_read_b128 %3, %11\n\t"
          "ds_read_b128 %4, %12\n\tds_read_b128 %5, %13\n\tds_read_b128 %6, %14\n\tds_read_b128 %7, %15\n\t"
          "s_waitcnt lgkmcnt(0)"
          : "=&v"(af[0]), "=&v"(af[1]), "=&v"(af[2]), "=&v"(af[3]), "=&v"(bg[0]), "=&v"(bg[1]), "=&v"(bg[2]), "=&v"(bg[3])
          : "v"(sl + offa[0]), "v"(sl + offa[1]), "v"(sl + offa[2]), "v"(sl + offa[3]), "v"(sl + offb[0]), "v"(sl + offb[1]),
            "v"(sl + offb[2]), "v"(sl + offb[3])
          : "memory");
    } else {
      asm volatile(
          "ds_read_b128 %0, %6\n\tds_read_b128 %1, %7\n\tds_read_b128 %2, %8\n\tds_read_b128 %3, %9\n\t"
          "ds_read_b128 %4, %10\n\tds_read_b128 %5, %11\n\t"
          "s_waitcnt lgkmcnt(0)"
          : "=&v"(af[0]), "=&v"(af[1]), "=&v"(af[2]), "=&v"(af[3]), "=&v"(bg[0]), "=&v"(bg[1])
          : "v"(sl + offa[0]), "v"(sl + offa[1]), "v"(sl + offa[2]), "v"(sl + offa[3]), "v"(sl + offb[0]), "v"(sl + offb[1])
          : "memory");
    }
#pragma unroll
    for (int mt = 0; mt < 4; ++mt)
#pragma unroll
      for (int nt = 0; nt < NT; ++nt) acc[mt][nt] = MFMA16(bg[nt], af[mt], acc[mt][nt]);
  }
#undef GEMM_STAGE
  asm volatile("s_waitcnt lgkmcnt(0)" ::: "memory");
  __builtin_amdgcn_s_barrier();
}
template <int NT>
DI void zero_acc(f4v (&acc)[4][NT]) {
#pragma unroll
  for (int i = 0; i < 4; ++i)
#pragma unroll
    for (int j = 0; j < NT; ++j) acc[i][j] = fz();
}

DI void gemm_big_prefetch(const u16* __restrict__ A, int lda, const u16* __restrict__ Bt, int ldb, int m0, int n0, u16* smem) {
  const int tid = tidx();
  char* sbase = reinterpret_cast<char*>(smem);
#pragma unroll
  for (int sl = 0; sl < 2; ++sl) {
    char* d = sbase + sl * 24576 + tid * 16;
#pragma unroll
    for (int i = 0; i < 4; ++i) {
      int R, C;
      stage_rc32(tid * 16 + i * 4096, R, C);
      __builtin_amdgcn_global_load_lds((const unsigned*)(A + (size_t)(m0 + R) * lda + C + sl * 32), (unsigned*)(d + i * 4096), 16, 0, 0);
      if (i < 2)
        __builtin_amdgcn_global_load_lds((const unsigned*)(Bt + (size_t)(n0 + R) * ldb + C + sl * 32), (unsigned*)(d + 16384 + i * 4096), 16, 0, 0);
    }
  }
}
DI void gemm_big(f4v (&acc)[8][4], const u16* __restrict__ A, int lda, const u16* __restrict__ Bt, int ldb, int K, int m0, int n0,
                 u16* smem, bool prestaged) {
  const int tid = tidx(), lane = tid & 63, w = tid >> 6, wm = w >> 1, wn = w & 1;
  const int l15 = lane & 15, quad = lane >> 4;
  constexpr int TA = 16384, TBUF = 24576;
  char* sbase = reinterpret_cast<char*>(smem);
  const unsigned lbase = (unsigned)(size_t)sbase;
  const u16* ga[4];
  const u16* gb[2];
#pragma unroll
  for (int i = 0; i < 4; ++i) {
    int R, C;
    stage_rc32(tid * 16 + i * 4096, R, C);
    ga[i] = A + (size_t)(m0 + R) * lda + C;
    if (i < 2) gb[i] = Bt + (size_t)(n0 + R) * ldb + C;
  }
  unsigned offa[8], offb[4];
#pragma unroll
  for (int t = 0; t < 8; ++t) offa[t] = lds_byte32(wm * 128 + t * 16 + l15, quad * 8);
#pragma unroll
  for (int t = 0; t < 4; ++t) offb[t] = TA + lds_byte32(wn * 64 + t * 16 + l15, quad * 8);
  const int ns = K >> 5;
#define BIG_STAGE(j, slot)                                                                                            \
  do {                                                                                                               \
    char* _d = sbase + (slot) * TBUF + tid * 16;                                                                      \
    _Pragma("unroll") for (int _i = 0; _i < 4; ++_i)                                                                 \
      __builtin_amdgcn_global_load_lds((const unsigned*)(ga[_i] + (j) * 32), (unsigned*)(_d + _i * 4096), 16, 0, 0);  \
    _Pragma("unroll") for (int _i = 0; _i < 2; ++_i)                                                                 \
      __builtin_amdgcn_global_load_lds((const unsigned*)(gb[_i] + (j) * 32), (unsigned*)(_d + TA + _i * 4096), 16, 0, 0); \
  } while (0)
  if (!prestaged) {
    asm volatile("s_waitcnt vmcnt(0)" ::: "memory");
    BIG_STAGE(0, 0);
    BIG_STAGE(1, 1);
  }
  int slot = 0;
  for (int j = 0; j < ns; ++j) {
    if (j + 1 < ns) wait_vm<6>();
    else wait_vm<0>();
    asm volatile("s_waitcnt lgkmcnt(0)" ::: "memory");
    __builtin_amdgcn_s_barrier();
    const int s2 = (slot == 0) ? 2 : slot - 1;
    if (j + 2 < ns) BIG_STAGE(j + 2, s2);
    const unsigned sl = lbase + (unsigned)(slot * TBUF);
    s8v af[8], bg[4];
    asm volatile(
        "ds_read_b128 %0, %12\n\tds_read_b128 %1, %13\n\tds_read_b128 %2, %14\n\tds_read_b128 %3, %15\n\t"
        "ds_read_b128 %4, %16\n\tds_read_b128 %5, %17\n\tds_read_b128 %6, %18\n\tds_read_b128 %7, %19\n\t"
        "ds_read_b128 %8, %20\n\tds_read_b128 %9, %21\n\tds_read_b128 %10, %22\n\tds_read_b128 %11, %23\n\t"
        "s_waitcnt lgkmcnt(0)"
        : "=&v"(bg[0]), "=&v"(bg[1]), "=&v"(bg[2]), "=&v"(bg[3]), "=&v"(af[0]), "=&v"(af[1]), "=&v"(af[2]), "=&v"(af[3]),
          "=&v"(af[4]), "=&v"(af[5]), "=&v"(af[6]), "=&v"(af[7])
        : "v"(sl + offb[0]), "v"(sl + offb[1]), "v"(sl + offb[2]), "v"(sl + offb[3]), "v"(sl + offa[0]), "v"(sl + offa[1]),
          "v"(sl + offa[2]), "v"(sl + offa[3]), "v"(sl + offa[4]), "v"(sl + offa[5]), "v"(sl + offa[6]), "v"(sl + offa[7])
        : "memory");
#pragma unroll
    for (int mt = 0; mt < 8; ++mt)
#pragma unroll
      for (int nt = 0; nt < 4; ++nt) acc[mt][nt] = MFMA16(bg[nt], af[mt], acc[mt][nt]);
    slot = (slot == 2) ? 0 : slot + 1;
  }
#undef BIG_STAGE
  asm volatile("s_waitcnt lgkmcnt(0)" ::: "memory");
  __builtin_amdgcn_s_barrier();
}

DI void gemm_k64(f4v (&acc)[4][2], const u16* __restrict__ A, int lda, const u16* __restrict__ Bt, int ldb, int K, int m0, int n0,
                 u16* smem) {
  const int tid = tidx(), lane = tid & 63, w = tid >> 6, wm = w >> 1, wn = w & 1;
  const int l15 = lane & 15, quad = lane >> 4;
  constexpr int TA = 16384, TBUF = 24576;
  char* sbase = reinterpret_cast<char*>(smem);
  const unsigned lbase = (unsigned)(size_t)sbase;
  const u16* ga[4];
  const u16* gb[2];
#pragma unroll
  for (int i = 0; i < 4; ++i) {
    int R, C;
    stage_rc32(tid * 16 + (i & 1) * 4096, R, C);
    ga[i] = A + (size_t)(m0 + R) * lda + C + 32 * (i >> 1);
  }
  {
    int R, C;
    stage_rc32(tid * 16, R, C);
    gb[0] = Bt + (size_t)(n0 + R) * ldb + C;
    gb[1] = gb[0] + 32;
  }
  unsigned offa[8], offb[4];
#pragma unroll
  for (int t = 0; t < 8; ++t) offa[t] = (t >> 2) * 8192 + lds_byte32(wm * 64 + (t & 3) * 16 + l15, quad * 8);
#pragma unroll
  for (int t = 0; t < 4; ++t) offb[t] = TA + (t >> 1) * 4096 + lds_byte32(wn * 32 + (t & 1) * 16 + l15, quad * 8);
  const int ns = K >> 6;
#define K64_STAGE(j, slot)                                                                                            \
  do {                                                                                                               \
    char* _d = sbase + (slot) * TBUF + tid * 16;                                                                      \
    _Pragma("unroll") for (int _i = 0; _i < 4; ++_i)                                                                 \
      __builtin_amdgcn_global_load_lds((const unsigned*)(ga[_i] + (j) * 64), (unsigned*)(_d + _i * 4096), 16, 0, 0);  \
    _Pragma("unroll") for (int _i = 0; _i < 2; ++_i)                                                                 \
      __builtin_amdgcn_global_load_lds((const unsigned*)(gb[_i] + (j) * 64), (unsigned*)(_d + TA + _i * 4096), 16, 0, 0); \
  } while (0)
  asm volatile("s_waitcnt vmcnt(0)" ::: "memory");
  K64_STAGE(0, 0);
  if (ns > 1) K64_STAGE(1, 1);
  int slot = 0;
  for (int j = 0; j < ns; ++j) {
    if (j + 1 < ns) wait_vm<6>();
    else wait_vm<0>();
    asm volatile("s_waitcnt lgkmcnt(0)" ::: "memory");
    __builtin_amdgcn_s_barrier();
    const int s2 = (slot == 0) ? 2 : slot - 1;
    if (j + 2 < ns) K64_STAGE(j + 2, s2);
    const unsigned sl = lbase + (unsigned)(slot * TBUF);
    s8v af[8], bg[4];
    asm volatile(
        "ds_read_b128 %0, %12\n\tds_read_b128 %1, %13\n\tds_read_b128 %2, %14\n\tds_read_b128 %3, %15\n\t"
        "ds_read_b128 %4, %16\n\tds_read_b128 %5, %17\n\tds_read_b128 %6, %18\n\tds_read_b128 %7, %19\n\t"
        "ds_read_b128 %8, %20\n\tds_read_b128 %9, %21\n\tds_read_b128 %10, %22\n\tds_read_b128 %11, %23\n\t"
        "s_waitcnt lgkmcnt(0)"
        : "=&v"(bg[0]), "=&v"(bg[1]), "=&v"(bg[2]), "=&v"(bg[3]), "=&v"(af[0]), "=&v"(af[1]), "=&v"(af[2]), "=&v"(af[3]),
          "=&v"(af[4]), "=&v"(af[5]), "=&v"(af[6]), "=&v"(af[7])
        : "v"(sl + offb[0]), "v"(sl + offb[1]), "v"(sl + offb[2]), "v"(sl + offb[3]), "v"(sl + offa[0]), "v"(sl + offa[1]),
          "v"(sl + offa[2]), "v"(sl + offa[3]), "v"(sl + offa[4]), "v"(sl + offa[5]), "v"(sl + offa[6]), "v"(sl + offa[7])
        : "memory");
#pragma unroll
    for (int h = 0; h < 2; ++h)
#pragma unroll
      for (int mt = 0; mt < 4; ++mt)
#pragma unroll
        for (int nt = 0; nt < 2; ++nt) acc[mt][nt] = MFMA16(bg[h * 2 + nt], af[h * 4 + mt], acc[mt][nt]);
    slot = (slot == 2) ? 0 : slot + 1;
  }
#undef K64_STAGE
  asm volatile("s_waitcnt lgkmcnt(0)" ::: "memory");
  __builtin_amdgcn_s_barrier();
}

DI void convT_tile(const float* __restrict__ w, int K, int N, u16* __restrict__ wt, int tile, float* sm) {
  const int tid = tidx();
  const int tiles_k = K >> 6;
  const int tk = tile % tiles_k, tn = tile / tiles_k;
  const int k0 = tk * 64, n0 = tn * 64;
  {
    const int c = tid & 63, r0 = tid >> 6;
    const bool ok = (n0 + c) < N;
    float v[16];
#pragma unroll
    for (int i = 0; i < 16; ++i) v[i] = ok ? w[(size_t)(k0 + r0 + 4 * i) * N + n0 + c] : 0.f;
    __builtin_amdgcn_sched_barrier(0);
#pragma unroll
    for (int i = 0; i < 16; ++i) sm[(r0 + 4 * i) * 65 + c] = v[i];
  }
  __syncthreads();
  {
    const int n = tid >> 2, ks = (tid & 3) * 16;
    float t0[8], t1[8];
#pragma unroll
    for (int j = 0; j < 8; ++j) { t0[j] = sm[(ks + j) * 65 + n]; t1[j] = sm[(ks + 8 + j) * 65 + n]; }
    const s8v v0 = pack8f(t0), v1 = pack8f(t1);
    u16* dst = wt + (size_t)(n0 + n) * K + k0 + ks;
    *reinterpret_cast<s8v*>(dst) = v0;
    *reinterpret_cast<s8v*>(dst + 8) = v1;
  }
  __syncthreads();
}

template <int NR>
DI void gemv_cols(const float* __restrict__ vec, int K, const float* __restrict__ W, int N, const float* __restrict__ bias,
                  float* __restrict__ out, int col0, float* sm) {
  const int tid = tidx(), kg = tid >> 6, cl = tid & 63;
  const int kper = K >> 2;
  float acc[NR];
#pragma unroll
  for (int r = 0; r < NR; ++r) acc[r] = 0.f;
  for (int k0 = kg * kper; k0 < (kg + 1) * kper; k0 += 16) {
    float wv[16];
#pragma unroll
    for (int j = 0; j < 16; ++j) wv[j] = W[(size_t)(k0 + j) * N + col0 + cl];
    __builtin_amdgcn_sched_barrier(0);
#pragma unroll
    for (int j = 0; j < 16; ++j)
#pragma unroll
      for (int r = 0; r < NR; ++r) acc[r] += vec[r * K + k0 + j] * wv[j];
    __builtin_amdgcn_sched_barrier(0);
  }
#pragma unroll
  for (int r = 0; r < NR; ++r) sm[(kg * NR + r) * 64 + cl] = acc[r];
  __syncthreads();
  for (int idx = tid; idx < NR * 64; idx += 256) {
    const int r = idx >> 6, c2 = idx & 63;
    float s = bias ? bias[col0 + c2] : 0.f;
#pragma unroll
    for (int g = 0; g < 4; ++g) s += sm[(g * NR + r) * 64 + c2];
    out[(size_t)r * N + col0 + c2] = s;
  }
  __syncthreads();
}

DI void phaseA(const Params& p, unsigned char* smem_raw) {
  float* smf = reinterpret_cast<float*>(smem_raw);
  unsigned char* ws = p.ws;
  constexpr int T0 = 16 * 170, T1 = T0 + 32 * 16, T2 = T1 + 16 * 16, T3 = T2 + 16 * 16, T4 = T3 + 32 * 4, T5 = T4 + 32 * 4,
                T6 = T5 + 4, T7 = T6 + 4, T8 = T7 + 48, T9 = T8 + 8;
  for (int it = blockIdx.x; it < T9; it += gridDim.x) {
    if (it < T0) convT_tile(p.w_in, 1024, NIN, (u16*)(ws + O_WIN), it, smf);
    else if (it < T1) convT_tile(p.w_ssm_out, 2048, 1024, (u16*)(ws + O_WSSM), it - T0, smf);
    else if (it < T2) convT_tile(p.w_nsa_out, 1024, 1024, (u16*)(ws + O_WNSA), it - T1, smf);
    else if (it < T3) convT_tile(p.w_out, 1024, 1024, (u16*)(ws + O_WOUT), it - T2, smf);
    else if (it < T4) convT_tile(p.cmp_w1_k, 2048, 256, (u16*)(ws + O_W1K), it - T3, smf);
    else if (it < T5) convT_tile(p.cmp_w1_v, 2048, 256, (u16*)(ws + O_W1V), it - T4, smf);
    else if (it < T6) convT_tile(p.cmp_w2_k, 256, 64, (u16*)(ws + O_W2K), it - T5, smf);
    else if (it < T7) convT_tile(p.cmp_w2_v, 256, 64, (u16*)(ws + O_W2V), it - T6, smf);
    else if (it < T8) gemv_cols<8>(p.c, 1024, p.w_ada, 3072, p.b_ada, (float*)(ws + O_ADA), (it - T7) * 64, smf);
    else {
      const int j = it - T8, kind = j >> 2, cb = j & 3;
      gemv_cols<1>(kind ? p.cmp_pos_v : p.cmp_pos_k, 2048, kind ? p.cmp_w1_v : p.cmp_w1_k, 256, nullptr,
                   (float*)(ws + O_POSB) + kind * 256, cb * 64, smf);
    }
  }
}

DI void phaseB(const Params& p, int pass) {
  const int tid = tidx(), lane = tid & 63, w = tid >> 6;
  const float* ada = (const float*)(p.ws + O_ADA);
  u16* h = (u16*)(p.ws + O_H);
  for (int it = blockIdx.x; it < MP / 4; it += gridDim.x) {
    const int r = it * 4 + w;
    const int tg = pass * MP + r;
    const int b = tg >> 11;
    const float* xr = p.x + (size_t)tg * DM;
    f4v v[4];
    float ss = 0.f;
#pragma unroll
    for (int i = 0; i < 4; ++i) {
      v[i] = ldf4(xr + i * 256 + lane * 4);
      ss += v[i][0] * v[i][0] + v[i][1] * v[i][1] + v[i][2] * v[i][2] + v[i][3] * v[i][3];
    }
#pragma unroll
    for (int o = 1; o < 64; o <<= 1) ss += __shfl_xor(ss, o);
    const float rstd = rsqrtf(ss * (1.f / DM) + EPS);
    f4v gg[4], shh[4], scc[4];
#pragma unroll
    for (int i = 0; i < 4; ++i) {
      const int c0 = i * 256 + lane * 4;
      gg[i] = ldf4(p.g_pre + c0);
      shh[i] = ldf4(ada + b * 3072 + c0);
      scc[i] = ldf4(ada + b * 3072 + 1024 + c0);
    }
    __builtin_amdgcn_sched_barrier(0);
#pragma unroll
    for (int i = 0; i < 4; ++i) {
      const int c0 = i * 256 + lane * 4;
      const f4v g = gg[i], sh = shh[i], sc = scc[i];
      float o0 = v[i][0] * rstd * g[0] * (1.f + sc[0]) + sh[0];
      float o1 = v[i][1] * rstd * g[1] * (1.f + sc[1]) + sh[1];
      float o2 = v[i][2] * rstd * g[2] * (1.f + sc[2]) + sh[2];
      float o3 = v[i][3] * rstd * g[3] * (1.f + sc[3]) + sh[3];
      st4bf(h + (size_t)r * DM + c0, o0, o1, o2, o3);
    }
  }
}

template <int MODE>
DI void phaseC(const Params& p, u16* smem) {
  const int lane = tidx() & 63, w = tidx() >> 6, wm = w >> 1, wn = w & 1, l15 = lane & 15, quad = lane >> 4;
  const u16* A = (const u16*)(p.ws + O_H);
  const u16* Bt = (const u16*)(p.ws + O_WIN);
  u16* P = (u16*)(p.ws + O_P);
  constexpr int NTN = LDP / 128;
  const int xcd = blockIdx.x & 7, lb = blockIdx.x >> 3, nlb = gridDim.x >> 3;
  bool pre = false;
  for (int t = lb;; t += nlb) {
    const int mi = (xcd & 3) * 4 + (t & 3);
    const int ni = 2 * (t >> 2) + (xcd >> 2);
    if (ni >= NTN) break;
    f4v acc[8][4];
#pragma unroll
    for (int i = 0; i < 8; ++i)
#pragma unroll
      for (int j = 0; j < 4; ++j) acc[i][j] = fz();
    gemm_big(acc, A, 1024, Bt, 1024, 1024, mi * 256, ni * 128, smem, pre);
    {
      const int t2 = t + nlb;
      const int ni2 = 2 * (t2 >> 2) + (xcd >> 2);
      pre = ni2 < NTN;
      if (pre) gemm_big_prefetch(A, 1024, Bt, 1024, ((xcd & 3) * 4 + (t2 & 3)) * 256, ni2 * 128, smem);
    }
    if (MODE != 0) { if (acc[0][0][0] + acc[7][3][3] != 12345.678f) continue; }
#pragma unroll
    for (int mt = 0; mt < 8; ++mt) {
      u16* prow = P + (size_t)(mi * 256 + wm * 128 + mt * 16 + l15) * LDP + ni * 128 + wn * 64;
      st8bf_pair(prow, acc[mt][0], acc[mt][1], quad);
      st8bf_pair(prow + 32, acc[mt][2], acc[mt][3], quad);
    }
  }
}

DI void conv_item(const Params& p, int it) {
  const int tid = tidx();
  const int cb = it % 24, tb = (it / 24) & 31, b = it / (24 * 32);
  const int ch0 = cb * 128 + 2 * (tid & 63);
  const int t0 = tb * 64 + 16 * (tid >> 6);
  const u16* P = (const u16*)(p.ws + O_P);
  u16* xc = (u16*)(p.ws + O_XC);
  u16* xcT = (u16*)(p.ws + O_XCT);
  unsigned raw[19];
#pragma unroll
  for (int i = 0; i < 19; ++i) {
    const int t = t0 - 3 + i;
    raw[i] = (t >= 0) ? *reinterpret_cast<const unsigned*>(P + (size_t)(b * SEQ + t) * LDP + C_XBC + ch0) : 0u;
  }
  const int hd = ch0 >> 6;
  u16 dtr[16];
  const bool isx = ch0 < 2048, isxb = ch0 < 2560;
  if (isx) {
#pragma unroll
    for (int i = 0; i < 16; ++i) dtr[i] = P[(size_t)(b * SEQ + t0 + i) * LDP + C_DT + hd];
  }
  float wv[4][2];
#pragma unroll
  for (int k = 0; k < 4; ++k) { wv[k][0] = p.conv_w[k * 3072 + ch0]; wv[k][1] = p.conv_w[k * 3072 + ch0 + 1]; }
  const float b0 = p.conv_b[ch0], b1 = p.conv_b[ch0 + 1];
  float y0[16], y1[16];
#pragma unroll
  for (int i = 0; i < 16; ++i) {
    float a0 = b0, a1 = b1;
#pragma unroll
    for (int k = 0; k < 4; ++k) {
      a0 += wv[k][0] * __uint_as_float(raw[i + k] << 16);
      a1 += wv[k][1] * __uint_as_float(raw[i + k] & 0xffff0000u);
    }
    y0[i] = siluf_(a0); y1[i] = siluf_(a1);
    const unsigned pk = pk2(y0[i], y1[i]);
    if (ch0 >= 2048) *reinterpret_cast<unsigned*>(xc + (size_t)(b * SEQ + t0 + i) * 3072 + ch0) = pk;
  }
  if (isxb) {
    if (isx) {
      const float db = p.dt_bias[hd];
#pragma unroll
      for (int i = 0; i < 16; ++i) {
        const float dtv = softplusf_(bf2f(dtr[i]) + db);
        y0[i] *= dtv; y1[i] *= dtv;
      }
    }
    u16* d0 = xcT + ((size_t)b * 2560 + ch0) * TS + t0;
    *reinterpret_cast<s8v*>(d0) = pack8f(y0);
    *reinterpret_cast<s8v*>(d0 + 8) = pack8f(y0 + 8);
    *reinterpret_cast<s8v*>(d0 + TS) = pack8f(y1);
    *reinterpret_cast<s8v*>(d0 + TS + 8) = pack8f(y1 + 8);
  }
}
DI void dt_item(const Params& p, int it, float* sm) {
  const int tid = tidx(), hd = tid & 31, seg = tid >> 5;
  const int c = it & 15, b = it >> 4;
  const u16* P = (const u16*)(p.ws + O_P);
  float* dtb = (float*)(p.ws + O_DT);
  float* acs = (float*)(p.ws + O_ACS);
  const float db = p.dt_bias[hd];
  const float a = -expf(p.a_log[hd]);
  const int tbase = c * 128 + seg * 16;
  float v[16], cs[16];
#pragma unroll
  for (int i = 0; i < 16; ++i) v[i] = bf2f(P[(size_t)(b * SEQ + tbase + i) * LDP + C_DT + hd]);
  float run = 0.f;
#pragma unroll
  for (int i = 0; i < 16; ++i) { v[i] = softplusf_(v[i] + db); run += v[i] * a; cs[i] = run; }
  sm[seg * 32 + hd] = run;
  __syncthreads();
  float off = 0.f;
#pragma unroll
  for (int s2 = 0; s2 < 8; ++s2) off += (s2 < seg) ? sm[s2 * 32 + hd] : 0.f;
  float* d0 = dtb + ((size_t)b * 32 + hd) * SEQ + tbase;
  float* d1 = acs + ((size_t)b * 32 + hd) * SEQ + tbase;
#pragma unroll
  for (int i = 0; i < 4; ++i) {
    f4v x0 = {v[4 * i], v[4 * i + 1], v[4 * i + 2], v[4 * i + 3]};
    f4v x1 = {cs[4 * i] + off, cs[4 * i + 1] + off, cs[4 * i + 2] + off, cs[4 * i + 3] + off};
    *reinterpret_cast<f4v*>(d0 + 4 * i) = x0;
    *reinterpret_cast<f4v*>(d1 + 4 * i) = x1;
  }
  __syncthreads();
}
DI void vtr_item(const Params& p, int it) {
  const int tid = tidx();
  const int tb = it & 31, g = (it >> 5) & 3, b = (it >> 7) % NBG, kind = it / (128 * NBG);
  const u16* P = (const u16*)(p.ws + O_P);
  u16* dst = (u16*)(p.ws + (kind ? O_VWT : O_VST));
  const int d = tid & 63, tq = tid >> 6;
  const int t0 = tb * 64 + tq * 16;
  const int col = (kind ? C_VW : C_VS) + g * 64 + d;
  s8v v0, v1;
#pragma unroll
  for (int i = 0; i < 8; ++i) {
    v0[i] = (short)P[(size_t)(b * SEQ + t0 + i) * LDP + col];
    v1[i] = (short)P[(size_t)(b * SEQ + t0 + 8 + i) * LDP + col];
  }
  u16* o = dst + (((size_t)b * 4 + g) * 64 + d) * TS + t0;
  *reinterpret_cast<s8v*>(o) = v0;
  *reinterpret_cast<s8v*>(o + 8) = v1;
}
DI void cmp_item(const Params& p, int it, u16* sm) {
  const int tid = tidx(), lane = tid & 63, w = tid >> 6, l15 = lane & 15, quad = lane >> 4;
  const int jt = it & 7, g = (it >> 3) & 3, b = (it >> 5) % NBG, kind = it / (32 * NBG);
  const u16* P = (const u16*)(p.ws + O_P);
  const u16* W1 = (const u16*)(p.ws + (kind ? O_W1V : O_W1K));
  const u16* W2 = (const u16*)(p.ws + (kind ? O_W2V : O_W2K));
  const float* posb = (const float*)(p.ws + O_POSB) + kind * 256;
  const int col0 = (kind ? C_VC : C_KC) + g * 64;
  const int j = jt * 16 + l15;
  const bool rv = j < 127;
  const u16* arow = P + (size_t)(b * SEQ + (rv ? j : 0) * 16) * LDP + col0 + quad * 8;
  f4v hid[16];
#pragma unroll
  for (int nt = 0; nt < 16; ++nt) hid[nt] = fz();
  s8v zero8 = {0, 0, 0, 0, 0, 0, 0, 0};
#define CMP_LOAD(AF, BW, K2R)                                                                        \
  do {                                                                                               \
    const int _kk = 16 * w + (((K2R) + it) & 15);                        \
    const int _l = _kk >> 1, _d0 = (_kk & 1) * 32;                                                    \
    AF = rv ? ld8(arow + (size_t)_l * LDP + _d0) : zero8;                                             \
    const u16* _wb = W1 + (size_t)l15 * 2048 + _kk * 32 + quad * 8;                                   \
    _Pragma("unroll") for (int nt = 0; nt < 16; ++nt) BW[nt] = ld8(_wb + (size_t)nt * 16 * 2048);    \
  } while (0)
#define CMP_MMA(AF, BW)                                                                              \
  do {                                                                                               \
    _Pragma("unroll") for (int nt = 0; nt < 16; ++nt) hid[nt] = MFMA16(AF, BW[nt], hid[nt]);         \
  } while (0)
  {
    s8v a0, a1, b0[16], b1[16];
    CMP_LOAD(a0, b0, 0);
#pragma unroll 1
    for (int k2r = 0; k2r < 16; k2r += 2) {
      CMP_LOAD(a1, b1, k2r + 1);
      __builtin_amdgcn_sched_barrier(0);
      CMP_MMA(a0, b0);
      __builtin_amdgcn_sched_barrier(0);
      CMP_LOAD(a0, b0, k2r + 2);
      __builtin_amdgcn_sched_barrier(0);
      CMP_MMA(a1, b1);
      __builtin_amdgcn_sched_barrier(0);
    }
  }
#undef CMP_LOAD
#undef CMP_MMA
  float* red = reinterpret_cast<float*>(sm);
#pragma unroll
  for (int nt = 0; nt < 16; ++nt)
#pragma unroll
    for (int i = 0; i < 4; ++i) red[(w * 16 + quad * 4 + i) * 260 + nt * 16 + l15] = hid[nt][i];
  __syncthreads();
  u16 hb[16];
  {
    const float pb = posb[tid];
#pragma unroll
    for (int r = 0; r < 16; ++r) {
      const float v = red[r * 260 + tid] + red[(16 + r) * 260 + tid] + red[(32 + r) * 260 + tid] + red[(48 + r) * 260 + tid] + pb;
      hb[r] = f2bf(siluf_(v));
    }
  }
  __syncthreads();
  constexpr int HS = 264;
#pragma unroll
  for (int r = 0; r < 16; ++r) sm[r * HS + tid] = hb[r];
  __syncthreads();
  f4v res = fz();
#pragma unroll
  for (int ks = 0; ks < 8; ++ks) {
    const s8v a = ld8(sm + l15 * HS + ks * 32 + quad * 8);
    const s8v bw = ld8(W2 + (size_t)(w * 16 + l15) * 256 + ks * 32 + quad * 8);
    res = MFMA16(a, bw, res);
  }
  const int d = w * 16 + l15;
  const int jb = jt * 16 + quad * 4;
  if (kind == 0) {
    u16* kc = (u16*)(p.ws + O_KCMP) + ((size_t)(b * 4 + g) * 128) * 64;
#pragma unroll
    for (int i = 0; i < 4; ++i) kc[(size_t)(jb + i) * 64 + d] = (jb + i < 127) ? f2bf(res[i]) : (u16)0;
  } else {
    u16* vc = (u16*)(p.ws + O_VCT) + ((size_t)(b * 4 + g) * 64 + d) * 128 + jb;
    st4bf(vc, res[0], res[1], res[2], (jb + 3 < 127) ? res[3] : 0.f);
  }
  __syncthreads();
}

DI int q_next(unsigned* ctr) {
  __shared__ int q_slot;
  if (tidx() == 0) q_slot = (int)atomicAdd(ctr, 1u);
  __syncthreads();
  const int it = q_slot;
  __syncthreads();
  return it;
}
DI unsigned* q_counter(const Params& p, int pass, int phase, int rep) {
  return (unsigned*)(p.ws + O_BAR) + 3520 + 8 * (((pass * 4 + phase) * 2) + rep);
}

DI void phaseD(const Params& p, u16* smem, int sub, int pass, int rep) {
  constexpr int N_CMP = 2 * NBG * 32, N_CONV = NBG * 128 * 6, N_VTR = 2 * NBG * 128, N_DT = NBG * 16;
  constexpr int E1 = N_CONV, E2 = E1 + N_VTR, E3 = E2 + N_DT;
  const int ncb = ((int)gridDim.x >= 2 * N_CMP) ? N_CMP : 0;
  constexpr int TAIL = 320;
  int lo, hi, start, step;
  if (ncb == 0) {
    for (int it = blockIdx.x; it < N_CMP; it += gridDim.x)
      if (sub == 0 || sub == 1) cmp_item(p, it, smem);
    lo = 0; hi = E3; start = blockIdx.x; step = gridDim.x;
  } else if ((int)blockIdx.x < ncb) {
    if (sub == 0 || sub == 1) cmp_item(p, blockIdx.x, smem);
    lo = E3 - TAIL; hi = E3; start = lo + blockIdx.x; step = ncb;
  } else {
    lo = 0; hi = E3 - TAIL; start = (int)blockIdx.x - ncb; step = (int)gridDim.x - ncb;
  }
  for (int it = start; it < hi; it += step) {
    if (it < E1) { if (sub == 0 || sub == 2) conv_item(p, it); }
    else if (it < E2) { if (sub == 0 || sub == 3) vtr_item(p, it - E1); }
    else { if (sub == 0 || sub == 3) dt_item(p, it - E2, (float*)smem); }
  }
}

DI void ssd_item(const Params& p, int it, u16* sm) {
  const int tid = tidx(), lane = tid & 63, w = tid >> 6, l15 = lane & 15, quad = lane >> 4;
  const int qr = (it >> 3) & 3, cgx = ((it >> 5) << 3) | (it & 7);
  const int g = cgx & 3, c = (cgx >> 2) & 15, b = cgx >> 6;
  const int t0 = c * 128;
  const u16* xc = (const u16*)(p.ws + O_XC);
  const u16* xcT = (const u16*)(p.ws + O_XCT);
  const float* acsb = (const float*)(p.ws + O_ACS);
  const float* dtb = (const float*)(p.ws + O_DT);
  u16* yd = (u16*)(p.ws + O_YD);
  u16* stb = (u16*)(p.ws + O_ST);
  const u16* Bbase = xc + (size_t)(b * SEQ + t0) * 3072 + 2048 + g * 128;
  const u16* Cbase = xc + (size_t)(b * SEQ + t0) * 3072 + 2560 + g * 128;
  const u16* BT = xcT + ((size_t)b * 2560 + 2048 + g * 128) * TS + t0;
  const int h0 = g * 8 + qr * 2;
  constexpr int LS = 136;
  u16* Bs = sm;
  u16* Xs = sm + 128 * LS;
  float* As = reinterpret_cast<float*>(sm + 256 * LS);
  {
    s8v rb[8], rx[8];
#pragma unroll
    for (int r = 0; r < 8; ++r) {
      const int idx = tid + 256 * r, row = idx >> 4, seg = idx & 15;
      rb[r] = ld8(Bbase + (size_t)row * 3072 + seg * 8);
      rx[r] = ld8(xcT + ((size_t)b * 2560 + h0 * 64 + row) * TS + t0 + seg * 8);
    }
#pragma unroll
    for (int r = 0; r < 8; ++r) {
      const int idx = tid + 256 * r, row = idx >> 4, seg = idx & 15;
      *reinterpret_cast<s8v*>(Bs + row * LS + seg * 8) = rb[r];
      *reinterpret_cast<s8v*>(Xs + row * LS + seg * 8) = rx[r];
    }
    As[tid] = acsb[((size_t)b * 32 + h0 + (tid >> 7)) * SEQ + t0 + (tid & 127)];
  }
  __syncthreads();

#pragma unroll 1
  for (int li = 0; li < 2; ++li) {
    const int lt = li ? 7 - w : w;
    const int l = 16 * lt + l15;
    s8v cf[4];
#pragma unroll
    for (int ks = 0; ks < 4; ++ks) cf[ks] = ld8(Cbase + (size_t)l * 3072 + ks * 32 + quad * 8);
    f4v y[2][4];
#pragma unroll
    for (int hh = 0; hh < 2; ++hh)
#pragma unroll
      for (int pt = 0; pt < 4; ++pt) y[hh][pt] = fz();
    float acl[2];
#pragma unroll
    for (int hh = 0; hh < 2; ++hh) acl[hh] = As[hh * 128 + l];
    const int spn = lt >> 1;
    for (int sp = 0; sp <= spn; ++sp) {
      f4v cb[2];
#pragma unroll
      for (int si = 0; si < 2; ++si) {
        cb[si] = fz();
#pragma unroll
        for (int ks = 0; ks < 4; ++ks)
          cb[si] = MFMA16(ld8(Bs + (32 * sp + 16 * si + l15) * LS + ks * 32 + quad * 8), cf[ks], cb[si]);
      }
#pragma unroll
      for (int hh = 0; hh < 2; ++hh) {
        const float* ah = As + hh * 128;
        const f4v as0 = ldf4(ah + 32 * sp + quad * 4);
        const f4v as1 = ldf4(ah + 32 * sp + 16 + quad * 4);
        f4v m0, m1;
#pragma unroll
        for (int i = 0; i < 4; ++i) {
          const int s0 = 32 * sp + quad * 4 + i, s1 = s0 + 16;
          m0[i] = (s0 <= l) ? cb[0][i] * __expf(acl[hh] - as0[i]) : 0.f;
          m1[i] = (s1 <= l) ? cb[1][i] * __expf(acl[hh] - as1[i]) : 0.f;
        }
        const s8v pb = pack8(m0, m1);
#pragma unroll
        for (int pt = 0; pt < 4; ++pt) {
          const u16* xr = Xs + (hh * 64 + 16 * pt + l15) * LS + 32 * sp + quad * 4;
          y[hh][pt] = MFMA16(cat44(ld4(xr), ld4(xr + 16)), pb, y[hh][pt]);
        }
      }
    }
#pragma unroll
    for (int hh = 0; hh < 2; ++hh) {
      const float dinv = p.d_skip[h0 + hh] / dtb[((size_t)b * 32 + h0 + hh) * SEQ + t0 + l];
#pragma unroll
      for (int pt = 0; pt < 4; ++pt) {
#pragma unroll
        for (int i = 0; i < 4; ++i) y[hh][pt][i] += dinv * bf2f(Xs[(hh * 64 + 16 * pt + 4 * quad + i) * LS + l]);
      }
      u16* yrow = yd + (size_t)(b * SEQ + t0 + l) * 2048 + (h0 + hh) * 64;
      st8bf_pair(yrow, y[hh][0], y[hh][1], quad);
      st8bf_pair(yrow + 32, y[hh][2], y[hh][3], quad);
    }
  }
#pragma unroll 1
  for (int hh = 0; hh < 2; ++hh) {
    const int hd = h0 + hh;
    const float* ah = As + hh * 128;
    const float alast = ah[127];
    f4v st[2][4];
#pragma unroll
    for (int ni = 0; ni < 2; ++ni)
#pragma unroll
      for (int pt = 0; pt < 4; ++pt) st[ni][pt] = fz();
    s8v bt[4][2];
#pragma unroll
    for (int ks = 0; ks < 4; ++ks)
#pragma unroll
      for (int ni = 0; ni < 2; ++ni) bt[ks][ni] = ld8(BT + (size_t)(16 * (2 * w + ni) + l15) * TS + ks * 32 + quad * 8);
    __builtin_amdgcn_sched_barrier(0);
#pragma unroll
    for (int ks = 0; ks < 4; ++ks) {
      const f4v a0 = ldf4(ah + ks * 32 + quad * 8), a1 = ldf4(ah + ks * 32 + quad * 8 + 4);
      float wl[8];
#pragma unroll
      for (int j = 0; j < 4; ++j) { wl[j] = __expf(alast - a0[j]); wl[4 + j] = __expf(alast - a1[j]); }
#pragma unroll
      for (int pt = 0; pt < 4; ++pt) {
        const s8v raw = ld8(Xs + (hh * 64 + 16 * pt + l15) * LS + ks * 32 + quad * 8);
        float xf[8];
#pragma unroll
        for (int j = 0; j < 8; ++j) xf[j] = bfs(raw[j]) * wl[j];
        const s8v xw = pack8f(xf);
        st[0][pt] = MFMA16(bt[ks][0], xw, st[0][pt]);
        st[1][pt] = MFMA16(bt[ks][1], xw, st[1][pt]);
      }
    }
    u16* so = stb + (((size_t)(b * 16 + c) * 32 + hd) * 64) * 128;
#pragma unroll
    for (int pt = 0; pt < 4; ++pt) st8bf_pair(so + (size_t)(16 * pt + l15) * 128 + 32 * w, st[0][pt], st[1][pt], quad);
  }
  __syncthreads();
}

DI void cmpattn_item(const Params& p, int it, unsigned char* smraw) {
  const int tid = tidx(), lane = tid & 63, w = tid >> 6, l15 = lane & 15, quad = lane >> 4;
  const int tq2 = it & 63, g = (it >> 6) & 3, b = it >> 8;
  const int H = g * 4 + w;
  const float slope = exp2f(-0.5f * (float)(H + 1));
  const u16* P = (const u16*)(p.ws + O_P);
  const u16* kcg = (const u16*)(p.ws + O_KCMP) + (size_t)(b * 4 + g) * 128 * 64;
  const u16* vcg = (const u16*)(p.ws + O_VCT) + (size_t)(b * 4 + g) * 64 * 128;
  constexpr int KS = 72, VS = 136;
  u16* kcs = reinterpret_cast<u16*>(smraw);
  u16* vcs = kcs + 128 * KS;
  float* impA = reinterpret_cast<float*>(smraw + 36864);
  float* impB = impA + 2048;
  float* scl = impB + 2112;
  {
    s8v r0[4], r1[4];
#pragma unroll
    for (int r = 0; r < 4; ++r) {
      const int idx = tid + 256 * r;
      r0[r] = ld8(kcg + (size_t)(idx >> 3) * 64 + (idx & 7) * 8);
      r1[r] = ld8(vcg + (size_t)(idx >> 4) * 128 + (idx & 15) * 8);
    }
#pragma unroll
    for (int r = 0; r < 4; ++r) {
      const int idx = tid + 256 * r;
      *reinterpret_cast<s8v*>(kcs + (idx >> 3) * KS + (idx & 7) * 8) = r0[r];
      *reinterpret_cast<s8v*>(vcs + (idx >> 4) * VS + (idx & 15) * 8) = r1[r];
    }
  }
  __syncthreads();
#pragma unroll 1
  for (int sub = 0; sub < 2; ++sub) {
    const int q0 = tq2 * 32 + sub * 16;
    const int njt = (q0 >= 16) ? (((q0 - 16) >> 8) + 1) : 0;
    const int t = q0 + l15;
    const size_t trow = (size_t)(b * SEQ + t);
    s8v qf[2];
    qf[0] = ld8(P + trow * LDP + C_Q + H * 64 + quad * 8);
    qf[1] = ld8(P + trow * LDP + C_Q + H * 64 + 32 + quad * 8);
    f4v s[8];
#pragma unroll
    for (int jt = 0; jt < 8; ++jt) {
      s[jt] = fz();
      if (jt < njt) {
#pragma unroll
        for (int ks = 0; ks < 2; ++ks) s[jt] = MFMA16(ld8(kcs + (16 * jt + l15) * KS + ks * 32 + quad * 8), qf[ks], s[jt]);
      }
    }
    float mx = NEGB;
#pragma unroll
    for (int jt = 0; jt < 8; ++jt)
#pragma unroll
      for (int i = 0; i < 4; ++i) {
        const int j = 16 * jt + 4 * quad + i;
        const int dist = t - (16 * j + 31);
        const float sc = (dist >= 0) ? s[jt][i] * 0.125f - slope * (float)dist : NEGB;
        s[jt][i] = sc;
        mx = fmaxf(mx, sc);
      }
    mx = qmax(mx);
    float lsum = 0.f;
#pragma unroll
    for (int jt = 0; jt < 8; ++jt)
#pragma unroll
      for (int i = 0; i < 4; ++i) {
        const float e = (s[jt][i] > -1e29f) ? __expf(s[jt][i] - mx) : 0.f;
        s[jt][i] = e;
        lsum += e;
      }
    lsum = qsum(lsum);
    const float inv = lsum > 0.f ? 1.f / lsum : 0.f;
#pragma unroll
    for (int jt = 0; jt < 8; ++jt) {
      s[jt] = s[jt] * inv;
      const int k = 4 * jt + quad;
      impA[(w * 16 + l15) * 32 + k] = s[jt][0] + s[jt][1] + s[jt][2] + 0.5f * s[jt][3];
      impB[(w * 16 + l15) * 33 + k + 1] = 0.5f * s[jt][3];
    }
    f4v oc[4];
#pragma unroll
    for (int dt = 0; dt < 4; ++dt) oc[dt] = fz();
#pragma unroll
    for (int kp = 0; kp < 4; ++kp) {
      if (2 * kp < njt) {
        const s8v pb = pack8(s[2 * kp], s[2 * kp + 1]);
#pragma unroll
        for (int dt = 0; dt < 4; ++dt) {
          const u16* vr = vcs + (16 * dt + l15) * VS + 32 * kp + quad * 4;
          oc[dt] = MFMA16(cat44(ld4(vr), ld4(vr + 16)), pb, oc[dt]);
        }
      }
    }
    {
      const float g0 = sigmoidf_(bf2f(P[trow * LDP + C_G + H * 3 + 0]));
      u16* oo = (u16*)(p.ws + O_OCMP) + trow * 1024 + H * 64 + quad * 4;
#pragma unroll
      for (int dt = 0; dt < 4; ++dt) st4bf(oo + 16 * dt, oc[dt][0] * g0, oc[dt][1] * g0, oc[dt][2] * g0, oc[dt][3] * g0);
    }
    __syncthreads();
#pragma unroll
    for (int r = 0; r < 2; ++r) {
      const int idx = tid + 256 * r, q = idx >> 5, k = idx & 31;
      float im = 0.f;
#pragma unroll
      for (int hh = 0; hh < 4; ++hh) {
        im += impA[(hh * 16 + q) * 32 + k];
        if (k > 0) im += impB[(hh * 16 + q) * 33 + k];
      }
      const int blk = (q0 + q) >> 6;
      const bool forced = (k == 0) | (k == blk) | (k == blk - 1);
      scl[q * 32 + k] = forced ? im + 1000.f : ((k <= blk) ? im : -1.f);
    }
    __syncthreads();
    unsigned* sel = (unsigned*)(p.ws + O_SEL) + (size_t)(b * 4 + g) * SEQ + q0;
#pragma unroll
    for (int r = 0; r < 2; ++r) {
      const int idx = tid + 256 * r, q = idx >> 5, k = idx & 31;
      const float me = scl[q * 32 + k];
      int cnt = 0;
#pragma unroll
      for (int k2 = 0; k2 < 32; ++k2) {
        const float o = scl[q * 32 + k2];
        cnt += (o > me || (o == me && k2 < k)) ? 1 : 0;
      }
      const unsigned long long bal = __ballot(cnt < 16);
      if (k == 0) sel[q] = (unsigned)(bal >> (32 * (lane >> 5)));
    }
    __syncthreads();
  }
}

DI void phaseE(const Params& p, float* smf, int sub, int pass, int rep) {
  constexpr int N_SSD = NBG * 256;
  for (int it = blockIdx.x; it < N_SSD; it += gridDim.x) ssd_item(p, it, (u16*)smf);
}

DI void scan_item(const Params& p, int it) {
  const int gid = it * 256 + tidx();
  const int e = gid & 1023, hd = (gid >> 10) & 31, b = gid >> 15;
  u16* stb = (u16*)(p.ws + O_ST);
  const float* acs = (const float*)(p.ws + O_ACS) + ((size_t)b * 32 + hd) * SEQ;
  float carry[8];
#pragma unroll
  for (int j = 0; j < 8; ++j) carry[j] = 0.f;
  s8v sv[16];
  float dec[16];
#pragma unroll
  for (int c = 0; c < 16; ++c) {
    sv[c] = ld8(stb + (((size_t)(b * 16 + c) * 32 + hd) * 8192) + e * 8);
    dec[c] = acs[c * 128 + 127];
  }
#pragma unroll
  for (int c = 0; c < 16; ++c) {
    u16* ptr = stb + (((size_t)(b * 16 + c) * 32 + hd) * 8192) + e * 8;
    const float dc = __expf(dec[c]);
    const s8v pv = pack8f(carry);
#pragma unroll
    for (int j = 0; j < 8; ++j) carry[j] = carry[j] * dc + bfs(sv[c][j]);
    *reinterpret_cast<s8v*>(ptr) = pv;
  }
}

template <bool WIN, bool MASKED>
DI void attn_tile(const u16* Kt, const u16* Vt, const s8v (&qf)[2], const f4v (&cb)[4], int t, int kb, int q0, bool selb,
                  float slope2, float& m, float& l, f4v (&o)[4]) {
  const int lane = tidx() & 63, l15 = lane & 15, quad = lane >> 4;
  constexpr int LS = 72;
  const float bkb = slope2 * (float)(64 * kb - q0);
  f4v s[4];
#pragma unroll
  for (int kt = 0; kt < 4; ++kt) {
    s[kt] = cb[kt] + bkb;
    const u16* kr = Kt + (16 * kt + l15) * LS + quad * 8;
    s[kt] = MFMA16(ld8(kr), qf[0], s[kt]);
    s[kt] = MFMA16(ld8(kr + 32), qf[1], s[kt]);
  }
  if (MASKED) {
    const int dd0 = t - (64 * kb + 4 * quad);
#pragma unroll
    for (int kt = 0; kt < 4; ++kt)
#pragma unroll
      for (int i = 0; i < 4; ++i) {
        const int dd = dd0 - (16 * kt + i);
        const bool ok = WIN ? ((unsigned)dd < 512u) : (selb && dd >= 0);
        s[kt][i] = ok ? s[kt][i] : NEGB;
      }
  }
  float mx = fmaxf(fmaxf(fmaxf(s[0][0], s[0][1]), fmaxf(s[0][2], s[0][3])), fmaxf(fmaxf(s[1][0], s[1][1]), fmaxf(s[1][2], s[1][3])));
  mx = fmaxf(mx, fmaxf(fmaxf(fmaxf(s[2][0], s[2][1]), fmaxf(s[2][2], s[2][3])), fmaxf(fmaxf(s[3][0], s[3][1]), fmaxf(s[3][2], s[3][3]))));
  mx = qmax(mx);
  if (__ballot(mx > m + 6.f) != 0ull) {
    const float mn = fmaxf(m, mx);
    const float alpha = __builtin_amdgcn_exp2f(m - mn);
    m = mn;
    l *= alpha;
#pragma unroll
    for (int dt = 0; dt < 4; ++dt) o[dt] = o[dt] * alpha;
  }
  float ps = 0.f;
#pragma unroll
  for (int kt = 0; kt < 4; ++kt)
#pragma unroll
    for (int i = 0; i < 4; ++i) {
      float e = __builtin_amdgcn_exp2f(s[kt][i] - m);
      if (MASKED) e = (s[kt][i] > -1e29f) ? e : 0.f;
      s[kt][i] = e;
      ps += e;
    }
  l += ps;
#pragma unroll
  for (int kp = 0; kp < 2; ++kp) {
    const s8v pb = pack8(s[2 * kp], s[2 * kp + 1]);
#pragma unroll
    for (int dt = 0; dt < 4; ++dt) {
      const u16* vr = Vt + (16 * dt + l15) * LS + 32 * kp + quad * 4;
      o[dt] = MFMA16(cat44(ld4(vr), ld4(vr + 16)), pb, o[dt]);
    }
  }
}

template <bool WIN, int AV>
DI void attn_pass(const u16* __restrict__ Kbase  , const u16* __restrict__ VT  ,
                  const s8v (&qf)[2], const f4v (&cb)[4], int t, int q0, unsigned mymask, float slope2, unsigned tiles, f4v (&o)[4],
                  float& lout, u16* sm) {
  const int tid = tidx();
  constexpr int LS = 72, TB = 64 * LS;
  const int lrow = tid >> 3, lseg = tid & 7;
  const int blk = q0 >> 6;
  float m = NEGB, l = 0.f;
#pragma unroll
  for (int dt = 0; dt < 4; ++dt) o[dt] = fz();
  const u16* kp0 = Kbase + (size_t)lrow * LDP + lseg * 8;
  const u16* vp0 = VT + (size_t)lrow * TS + lseg * 8;
#define AT_LOAD(RK, RV, KB)                                                            \
  do {                                                                                 \
    RK[0] = ld8(kp0 + (size_t)(64 * (KB)) * LDP);                                       \
    RK[1] = ld8(kp0 + (size_t)(64 * (KB) + 32) * LDP);                                  \
    RV[0] = ld8(vp0 + 64 * (KB));                                                       \
    RV[1] = ld8(vp0 + (size_t)32 * TS + 64 * (KB));                                    \
  } while (0)
#define AT_STORE(RK, RV, BUF)                                                          \
  do {                                                                                 \
    u16* _d = sm + (BUF) * 2 * TB + lrow * LS + lseg * 8;                               \
    *reinterpret_cast<s8v*>(_d) = RK[0];                                                \
    *reinterpret_cast<s8v*>(_d + 32 * LS) = RK[1];                                      \
    *reinterpret_cast<s8v*>(_d + TB) = RV[0];                                           \
    *reinterpret_cast<s8v*>(_d + TB + 32 * LS) = RV[1];                                 \
  } while (0)
#define AT_POPL() do { if (tl) { kbl = 31 - __builtin_clz(tl); tl &= ~(1u << kbl); } } while (0)
#define AT_STEP(RK, RV)                                                                                              \
  {                                                                                                                  \
    const int kb = 31 - __builtin_clz(tc);                                                                            \
    tc &= ~(1u << kb);                                                                                                \
    const u16* Kt = sm + cur * 2 * TB;                                                                                \
    const bool selb = WIN ? true : (((mymask >> kb) & 1u) != 0u);                                                     \
    const bool need = WIN ? ((kb == blk) || (64 * kb <= q0 - 497)) : ((kb == blk) || (__ballot(selb) != ~0ull));      \
    if (AV != 2) {                                                                                                    \
    if (need) attn_tile<WIN, true>(Kt, Kt + TB, qf, cb, t, kb, q0, selb, slope2, m, l, o);                            \
    else attn_tile<WIN, false>(Kt, Kt + TB, qf, cb, t, kb, q0, selb, slope2, m, l, o);                                \
    }                                                                                                                 \
    if (AV != 1) {                                                                                                    \
    if (tc) AT_STORE(RK, RV, cur ^ 1);                                                                                \
    AT_POPL();                                                                                                        \
    AT_LOAD(RK, RV, kbl);                                                                                             \
    }                                                                                                                 \
    __syncthreads();                                                                                                  \
    if (!tc) break;                                                                                                   \
    cur ^= 1;                                                                                                         \
  }
  unsigned tc = tiles, tl = tiles;
  s8v ak[2], av[2], bk[2], bv[2];
  int kbl = 0;
  AT_POPL();
  AT_LOAD(ak, av, kbl);
  AT_STORE(ak, av, 0);
  AT_POPL();
  AT_LOAD(ak, av, kbl);
  AT_POPL();
  AT_LOAD(bk, bv, kbl);
  __syncthreads();
  int cur = 0;
  while (true) {
    AT_STEP(ak, av)
    AT_STEP(bk, bv)
  }
#undef AT_LOAD
#undef AT_STORE
#undef AT_POPL
#undef AT_STEP
  lout = qsum(l);
}

DI void cmp_part(const Params& p, int b, int g, int q0, const s8v (&qf)[2], unsigned char* smraw, f4v (&oc)[4], unsigned& mymask) {
  const int tid = tidx(), lane = tid & 63, w = tid >> 6, l15 = lane & 15, quad = lane >> 4;
  const int H = g * 4 + w;
  const float slope = exp2f(-0.5f * (float)(H + 1));
  const u16* P = (const u16*)(p.ws + O_P);
  const u16* kcg = (const u16*)(p.ws + O_KCMP) + (size_t)(b * 4 + g) * 128 * 64;
  const u16* vcg = (const u16*)(p.ws + O_VCT) + (size_t)(b * 4 + g) * 64 * 128;
  constexpr int KS = 72, VS = 136;
  u16* kcs = reinterpret_cast<u16*>(smraw);
  u16* vcs = kcs + 128 * KS;
  float* impA = reinterpret_cast<float*>(smraw + 36864);
  float* impB = impA + 2048;
  float* scl = impB + 2112;
  unsigned* selm = reinterpret_cast<unsigned*>(scl + 512);
  const int njt = (q0 >= 16) ? (((q0 - 16) >> 8) + 1) : 0;
  {
    s8v r0[4], r1[4];
#pragma unroll
    for (int r = 0; r < 4; ++r) {
      const int idx = tid + 256 * r;
      r0[r] = ld8(kcg + (size_t)(idx >> 3) * 64 + (idx & 7) * 8);
      r1[r] = ld8(vcg + (size_t)(idx >> 4) * 128 + (idx & 15) * 8);
    }
#pragma unroll
    for (int r = 0; r < 4; ++r) {
      const int idx = tid + 256 * r;
      *reinterpret_cast<s8v*>(kcs + (idx >> 3) * KS + (idx & 7) * 8) = r0[r];
      *reinterpret_cast<s8v*>(vcs + (idx >> 4) * VS + (idx & 15) * 8) = r1[r];
    }
  }
  __syncthreads();
  const int t = q0 + l15;
  const size_t trow = (size_t)(b * SEQ + t);
  f4v s[8];
#pragma unroll
  for (int jt = 0; jt < 8; ++jt) {
    s[jt] = fz();
    if (jt < njt) {
#pragma unroll
      for (int ks = 0; ks < 2; ++ks) s[jt] = MFMA16(ld8(kcs + (16 * jt + l15) * KS + ks * 32 + quad * 8), qf[ks], s[jt]);
    }
  }
  float mx = NEGB;
#pragma unroll
  for (int jt = 0; jt < 8; ++jt)
#pragma unroll
    for (int i = 0; i < 4; ++i) {
      const int j = 16 * jt + 4 * quad + i;
      const int dist = t - (16 * j + 31);
      const float sc = (dist >= 0) ? s[jt][i] * 0.125f - slope * (float)dist : NEGB;
      s[jt][i] = sc;
      mx = fmaxf(mx, sc);
    }
  mx = qmax(mx);
  float lsum = 0.f;
#pragma unroll
  for (int jt = 0; jt < 8; ++jt)
#pragma unroll
    for (int i = 0; i < 4; ++i) {
      const float e = (s[jt][i] > -1e29f) ? __expf(s[jt][i] - mx) : 0.f;
      s[jt][i] = e;
      lsum += e;
    }
  lsum = qsum(lsum);
  const float inv = lsum > 0.f ? 1.f / lsum : 0.f;
#pragma unroll
  for (int jt = 0; jt < 8; ++jt) {
    s[jt] = s[jt] * inv;
    const int k = 4 * jt + quad;
    impA[(w * 16 + l15) * 32 + k] = s[jt][0] + s[jt][1] + s[jt][2] + 0.5f * s[jt][3];
    impB[(w * 16 + l15) * 33 + k + 1] = 0.5f * s[jt][3];
  }
#pragma unroll
  for (int dt = 0; dt < 4; ++dt) oc[dt] = fz();
#pragma unroll
  for (int kp = 0; kp < 4; ++kp) {
    if (2 * kp < njt) {
      const s8v pb = pack8(s[2 * kp], s[2 * kp + 1]);
#pragma unroll
      for (int dt = 0; dt < 4; ++dt) {
        const u16* vr = vcs + (16 * dt + l15) * VS + 32 * kp + quad * 4;
        oc[dt] = MFMA16(cat44(ld4(vr), ld4(vr + 16)), pb, oc[dt]);
      }
    }
  }
  {
    const float g0 = sigmoidf_(bf2f(P[trow * LDP + C_G + H * 3 + 0]));
#pragma unroll
    for (int dt = 0; dt < 4; ++dt) oc[dt] = oc[dt] * g0;
  }
  __syncthreads();
#pragma unroll
  for (int r = 0; r < 2; ++r) {
    const int idx = tid + 256 * r, q = idx >> 5, k = idx & 31;
    float im = 0.f;
#pragma unroll
    for (int hh = 0; hh < 4; ++hh) {
      im += impA[(hh * 16 + q) * 32 + k];
      if (k > 0) im += impB[(hh * 16 + q) * 33 + k];
    }
    const int blk = (q0 + q) >> 6;
    const bool forced = (k == 0) | (k == blk) | (k == blk - 1);
    scl[q * 32 + k] = forced ? im + 1000.f : ((k <= blk) ? im : -1.f);
  }
  __syncthreads();
#pragma unroll
  for (int r = 0; r < 2; ++r) {
    const int idx = tid + 256 * r, q = idx >> 5, k = idx & 31;
    const float me = scl[q * 32 + k];
    int cnt = 0;
#pragma unroll
    for (int k2 = 0; k2 < 32; ++k2) {
      const float o = scl[q * 32 + k2];
      cnt += (o > me || (o == me && k2 < k)) ? 1 : 0;
    }
    const unsigned long long bal = __ballot(cnt < 16);
    if (k == 0) selm[q] = (unsigned)(bal >> (32 * (lane >> 5)));
  }
  __syncthreads();
  mymask = selm[l15];
  __syncthreads();
}

template <int AV>
DI void attn_item(const Params& p, int it, u16* sm) {
  const int tid = tidx(), lane = tid & 63, w = tid >> 6, l15 = lane & 15, quad = lane >> 4;
  const int tq = it & 127, g = (it >> 7) & 3, b = it >> 9;
  const int q0 = tq * 16;
  const int H = g * 4 + w;
  const float slope2 = exp2f(-0.5f * (float)(H + 1)) * 1.4426950408889634f;
  constexpr float SCALE2 = 0.125f * 1.4426950408889634f;
  const u16* P = (const u16*)(p.ws + O_P);
  const int t = q0 + l15;
  const size_t trow = (size_t)(b * SEQ + t);
  s8v qf[2], qraw[2];
#pragma unroll
  for (int ks = 0; ks < 2; ++ks) {
    const s8v raw = ld8(P + trow * LDP + C_Q + H * 64 + ks * 32 + quad * 8);
    qraw[ks] = raw;
    float qs[8];
#pragma unroll
    for (int j = 0; j < 8; ++j) qs[j] = bfs(raw[j]) * SCALE2;
    qf[ks] = pack8f(qs);
  }
  f4v ocm[4];
  unsigned mymask;
  cmp_part(p, b, g, q0, qraw, reinterpret_cast<unsigned char*>(sm), ocm, mymask);
  f4v cb[4];
#pragma unroll
  for (int kt = 0; kt < 4; ++kt)
#pragma unroll
    for (int i = 0; i < 4; ++i) cb[kt][i] = slope2 * (float)(16 * kt + 4 * quad + i);
  const int blk = q0 >> 6;
  const unsigned upto = (blk >= 31) ? 0xffffffffu : ((2u << blk) - 1u);
  unsigned um = mymask;
#pragma unroll
  for (int o = 1; o < 64; o <<= 1) um |= (unsigned)__shfl_xor((int)um, o);
  um = (unsigned)__builtin_amdgcn_readfirstlane((int)(um & upto));
  f4v os[4], ow[4];
  float ls, lw;
  attn_pass<false, AV>(P + (size_t)(b * SEQ) * LDP + C_KS + g * 64, (const u16*)(p.ws + O_VST) + (size_t)(b * 4 + g) * 64 * TS, qf, cb, t,
                   q0, mymask, slope2, um, os, ls, sm);
  const int wlo = (q0 - 511 > 0 ? q0 - 511 : 0) >> 6;
  const unsigned wm_ = (unsigned)__builtin_amdgcn_readfirstlane((int)(upto & ~((1u << wlo) - 1u)));
  attn_pass<true, AV>(P + (size_t)(b * SEQ) * LDP + C_KW + g * 64, (const u16*)(p.ws + O_VWT) + (size_t)(b * 4 + g) * 64 * TS, qf, cb, t,
                  q0, 0u, slope2, wm_, ow, lw, sm);
  if (AV != 0) { if (ls + lw + os[0][0] + ow[3][3] != 12345.678f) return; }
  const float g1 = sigmoidf_(bf2f(P[trow * LDP + C_G + H * 3 + 1])) / ls;
  const float g2 = sigmoidf_(bf2f(P[trow * LDP + C_G + H * 3 + 2])) / lw;
  const u16* za = P + trow * LDP + C_ZA + H * 64;
  u16* oo = (u16*)(p.ws + O_O) + trow * 1024 + H * 64;
  f4v rr[4];
  s4v zq[4];
  ld8bf_pair(za, quad, zq[0], zq[1]);
  ld8bf_pair(za + 32, quad, zq[2], zq[3]);
#pragma unroll
  for (int dt = 0; dt < 4; ++dt) {
#pragma unroll
    for (int i = 0; i < 4; ++i) rr[dt][i] = (ocm[dt][i] + g1 * os[dt][i] + g2 * ow[dt][i]) * siluf_(bfs(zq[dt][i]));
  }
  st8bf_pair(oo, rr[0], rr[1], quad);
  st8bf_pair(oo + 32, rr[2], rr[3], quad);
}

DI void phaseF(const Params& p, bool noscan, u16* sm, int pass, int rep) {
  constexpr int N_SC = NBG * 32 * 1024 / 256;
  const int xq = blockIdx.x & 7, lbq = blockIdx.x >> 3, nl = (int)gridDim.x >> 3;
  unsigned* ctr = q_counter(p, pass, 2, rep) + xq;
  const int nend = noscan ? 128 : 128 + N_SC / 8;
  bool first = true;
  while (true) {
    const int j = first ? lbq : q_next(ctr) + nl;
    first = false;
    if (j >= nend) break;
    if (j < 128) attn_item<0>(p, (xq >> 2) * 512 + (xq & 3) * 128 + (127 - j), sm);
    else scan_item(p, (j - 128) * 8 + xq);
  }
}

DI void phaseG(const Params& p, float* smf) {
  const int tid = tidx(), lane = tid & 63, w = tid >> 6, l15 = lane & 15, quad = lane >> 4;
  const u16* xc = (const u16*)(p.ws + O_XC);
  const u16* P = (const u16*)(p.ws + O_P);
  const u16* yd = (const u16*)(p.ws + O_YD);
  const u16* stb = (const u16*)(p.ws + O_ST);
  const float* acsb = (const float*)(p.ws + O_ACS);
  u16* yn = (u16*)(p.ws + O_YN);
  for (int it = blockIdx.x; it < NBG * 256; it += gridDim.x) {
    const int lq = (it >> 3) & 3, cgx = ((it >> 5) << 3) | (it & 7);
    const int g = cgx & 3, c = (cgx >> 2) & 15, b = cgx >> 6;
    const int t0 = b * SEQ + c * 128 + 32 * lq + l15;
    s8v cf[2][4];
#pragma unroll
    for (int li = 0; li < 2; ++li)
#pragma unroll
      for (int ks = 0; ks < 4; ++ks) cf[li][ks] = ld8(xc + (size_t)(t0 + 16 * li) * 3072 + 2560 + g * 128 + ks * 32 + quad * 8);
    f4v y[2][4][2];
    f4v* park = reinterpret_cast<f4v*>(smf + 1024);
    float ss[2] = {0.f, 0.f};
#pragma unroll
    for (int hh = 0; hh < 2; ++hh) {
      const int hd = g * 8 + 2 * w + hh;
      const u16* pv = stb + (((size_t)(b * 16 + c) * 32 + hd) * 64) * 128;
      s8v pf[4][4];
      s4v d4[4], z4[4];
#pragma unroll
      for (int pt = 0; pt < 4; ++pt) {
#pragma unroll
        for (int ks = 0; ks < 4; ++ks) pf[pt][ks] = ld8(pv + (size_t)(16 * pt + l15) * 128 + ks * 32 + quad * 8);
      }
#pragma unroll
      for (int pp = 0; pp < 2; ++pp) {
        ld8bf_pair(yd + (size_t)t0 * 2048 + hd * 64 + 32 * pp, quad, d4[2 * pp], d4[2 * pp + 1]);
        ld8bf_pair(P + (size_t)t0 * LDP + C_Z + hd * 64 + 32 * pp, quad, z4[2 * pp], z4[2 * pp + 1]);
      }
      float ea[2];
#pragma unroll
      for (int li = 0; li < 2; ++li) ea[li] = __expf(acsb[((size_t)b * 32 + hd) * SEQ + (t0 + 16 * li - b * SEQ)]);
      __builtin_amdgcn_sched_barrier(0);
#pragma unroll
      for (int pt = 0; pt < 4; ++pt) {
        y[hh][pt][0] = fz(); y[hh][pt][1] = fz();
#pragma unroll
        for (int ks = 0; ks < 4; ++ks) {
          y[hh][pt][0] = MFMA16(pf[pt][ks], cf[0][ks], y[hh][pt][0]);
          y[hh][pt][1] = MFMA16(pf[pt][ks], cf[1][ks], y[hh][pt][1]);
        }
      }
      __builtin_amdgcn_sched_barrier(0);
      s4v d5[4], z5[4];
#pragma unroll
      for (int pp = 0; pp < 2; ++pp) {
        ld8bf_pair(yd + (size_t)(t0 + 16) * 2048 + hd * 64 + 32 * pp, quad, d5[2 * pp], d5[2 * pp + 1]);
        ld8bf_pair(P + (size_t)(t0 + 16) * LDP + C_Z + hd * 64 + 32 * pp, quad, z5[2 * pp], z5[2 * pp + 1]);
      }
      __builtin_amdgcn_sched_barrier(0);
#pragma unroll
      for (int pt = 0; pt < 4; ++pt)
#pragma unroll
        for (int i = 0; i < 4; ++i) {
          const float v = (bfs(d4[pt][i]) + y[hh][pt][0][i] * ea[0]) * siluf_(bfs(z4[pt][i]));
          y[hh][pt][0][i] = v;
          ss[0] += v * v;
        }
      __builtin_amdgcn_sched_barrier(0);
#pragma unroll
      for (int pt = 0; pt < 4; ++pt)
#pragma unroll
        for (int i = 0; i < 4; ++i) {
          const float v = (bfs(d5[pt][i]) + y[hh][pt][1][i] * ea[1]) * siluf_(bfs(z5[pt][i]));
          y[hh][pt][1][i] = v;
          ss[1] += v * v;
        }
      if (hh == 0) {
#pragma unroll
        for (int pt = 0; pt < 4; ++pt) { park[(2 * pt) * 256 + tid] = y[0][pt][0]; park[(2 * pt + 1) * 256 + tid] = y[0][pt][1]; }
      }
    }
    ss[0] = qsum(ss[0]); ss[1] = qsum(ss[1]);
    if (quad == 0) { smf[w * 32 + l15] = ss[0]; smf[w * 32 + 16 + l15] = ss[1]; }
    f4v gnv[2][4];
#pragma unroll
    for (int hh = 0; hh < 2; ++hh)
#pragma unroll
      for (int pt = 0; pt < 4; ++pt) gnv[hh][pt] = ldf4(p.g_ssm_norm + (g * 8 + 2 * w + hh) * 64 + 16 * pt + quad * 4);
    __syncthreads();
    float rs[2];
#pragma unroll
    for (int li = 0; li < 2; ++li) {
      const float tot = smf[16 * li + l15] + smf[32 + 16 * li + l15] + smf[64 + 16 * li + l15] + smf[96 + 16 * li + l15];
      rs[li] = rsqrtf(tot * (1.f / 512.f) + EPS);
    }
#pragma unroll
    for (int hh = 0; hh < 2; ++hh) {
      const int hd = g * 8 + 2 * w + hh;
#pragma unroll
      for (int li = 0; li < 2; ++li) {
        f4v nv[4];
#pragma unroll
        for (int pt = 0; pt < 4; ++pt) {
          const f4v v = (hh == 0) ? park[(2 * pt + li) * 256 + tid] : y[1][pt][li];
          nv[pt] = v * gnv[hh][pt] * rs[li];
        }
        u16* nrow = yn + (size_t)(t0 + 16 * li) * 2048 + hd * 64;
        st8bf_pair(nrow, nv[0], nv[1], quad);
        st8bf_pair(nrow + 32, nv[2], nv[3], quad);
      }
    }
    __syncthreads();
  }
}

DI void phaseH(const Params& p, u16* smem) {
  const int lane = tidx() & 63, w = tidx() >> 6, wm = w >> 1, wn = w & 1, l15 = lane & 15, quad = lane >> 4;
  const u16* P = (const u16*)(p.ws + O_P);
  u16* mg = (u16*)(p.ws + O_H);
  float* tmp = (float*)(p.ws + O_YD);
  constexpr int MT = MP / 128;
  for (int it = blockIdx.x; it < MT * 16; it += gridDim.x) {
    const int mi = it % MT, ni = it / MT;
    f4v acc[4][2];
    u2v keep[4][2];
    zero_acc<2>(acc);
    gemm_k64(acc, (const u16*)(p.ws + O_YN), 2048, (const u16*)(p.ws + O_WSSM), 2048, 2048, mi * 128, ni * 64, smem);
    s4v gq[4][2];
#pragma unroll
    for (int mt = 0; mt < 4; ++mt)
      ld8bf_pair(P + (size_t)(mi * 128 + wm * 64 + mt * 16 + l15) * LDP + C_MG + ni * 64 + wn * 32, quad, gq[mt][0], gq[mt][1]);
    __builtin_amdgcn_sched_barrier(0);
#pragma unroll
    for (int mt = 0; mt < 4; ++mt)
#pragma unroll
      for (int nt = 0; nt < 2; ++nt) {
        const int m = mi * 128 + wm * 64 + mt * 16 + l15, n = ni * 64 + wn * 32 + nt * 16 + quad * 4;
        const s4v g0 = gq[mt][nt];
        f4v r;
#pragma unroll
        for (int i = 0; i < 4; ++i) r[i] = sigmoidf_(bfs(g0[i])) * acc[mt][nt][i];
        u2v kp = {pk2(r[0], r[1]), pk2(r[2], r[3])};
        keep[mt][nt] = kp;
      }
    zero_acc<2>(acc);
    gemm_k64(acc, (const u16*)(p.ws + O_O), 1024, (const u16*)(p.ws + O_WNSA), 1024, 1024, mi * 128, ni * 64, smem);
    f4v tq[4][2];
#pragma unroll
    for (int mt = 0; mt < 4; ++mt)
      ld8bf_pair(P + (size_t)(mi * 128 + wm * 64 + mt * 16 + l15) * LDP + C_MG + 1024 + ni * 64 + wn * 32, quad, gq[mt][0], gq[mt][1]);
#pragma unroll
    for (int mt = 0; mt < 4; ++mt)
#pragma unroll
      for (int nt = 0; nt < 2; ++nt) {
        const u2v kp = keep[mt][nt];
        f4v tv = {__uint_as_float(kp[0] << 16), __uint_as_float(kp[0] & 0xffff0000u), __uint_as_float(kp[1] << 16),
                  __uint_as_float(kp[1] & 0xffff0000u)};
        tq[mt][nt] = tv;
      }
    __builtin_amdgcn_sched_barrier(0);
#pragma unroll
    for (int mt = 0; mt < 4; ++mt) {
      f4v rr[2];
#pragma unroll
      for (int nt = 0; nt < 2; ++nt) {
        const s4v g1 = gq[mt][nt];
        const f4v t0 = tq[mt][nt];
#pragma unroll
        for (int i = 0; i < 4; ++i) rr[nt][i] = t0[i] + sigmoidf_(bfs(g1[i])) * acc[mt][nt][i];
      }
      st8bf_pair(mg + (size_t)(mi * 128 + wm * 64 + mt * 16 + l15) * 1024 + ni * 64 + wn * 32, rr[0], rr[1], quad);
    }
  }
}

DI void phaseI(const Params& p, u16* smem) {
  const int lane = tidx() & 63, w = tidx() >> 6, wm = w >> 1, wn = w & 1, l15 = lane & 15, quad = lane >> 4;
  u16* outb = (u16*)(p.ws + O_OUTF);
  float* rsq = (float*)(p.ws + O_RSQ);
  constexpr int MT = MP / 128;
  for (int it = blockIdx.x; it < MT * 16; it += gridDim.x) {
    const int mi = it % MT, ni = it / MT;
    f4v acc[4][2];
    zero_acc<2>(acc);
    gemm_k64(acc, (const u16*)(p.ws + O_H), 1024, (const u16*)(p.ws + O_WOUT), 1024, 1024, mi * 128, ni * 64, smem);
#pragma unroll
    for (int mt = 0; mt < 4; ++mt) {
      const int m = mi * 128 + wm * 64 + mt * 16 + l15;
      float ss = 0.f;
#pragma unroll
      for (int nt = 0; nt < 2; ++nt) {
        const f4v v = acc[mt][nt];
        ss += v[0] * v[0] + v[1] * v[1] + v[2] * v[2] + v[3] * v[3];
      }
      st8bf_pair(outb + (size_t)m * 1024 + ni * 64 + wn * 32, acc[mt][0], acc[mt][1], quad);
      ss = qsum(ss);
      if (quad == 0) rsq[(size_t)m * 32 + ni * 2 + wn] = ss;
    }
  }
}

DI void phaseJ(const Params& p, int pass) {
  const int tid = tidx(), lane = tid & 63, w = tid >> 6;
  const u16* outb = (const u16*)(p.ws + O_OUTF);
  const float* rsq = (const float*)(p.ws + O_RSQ);
  const float* ada = (const float*)(p.ws + O_ADA);
  for (int it = blockIdx.x; it < MP / 4; it += gridDim.x) {
    const int r = it * 4 + w;
    const int tg = pass * MP + r, b = tg >> 11;
    float part = (lane < 32) ? rsq[(size_t)r * 32 + lane] : 0.f;
    s4v ob[4];
    f4v xv[4], gp[4], gt[4];
#pragma unroll
    for (int i = 0; i < 4; ++i) {
      const int c0 = i * 256 + lane * 4;
      ob[i] = ld4(outb + (size_t)r * 1024 + c0);
      xv[i] = ldf4(p.x + (size_t)tg * 1024 + c0);
      gp[i] = ldf4(p.g_post + c0);
      gt[i] = ldf4(ada + b * 3072 + 2048 + c0);
    }
    __builtin_amdgcn_sched_barrier(0);
#pragma unroll
    for (int o = 1; o < 64; o <<= 1) part += __shfl_xor(part, o);
    const float rstd = rsqrtf(part * (1.f / 1024.f) + EPS);
#pragma unroll
    for (int i = 0; i < 4; ++i) {
      const int c0 = i * 256 + lane * 4;
      f4v rr;
#pragma unroll
      for (int k = 0; k < 4; ++k) rr[k] = xv[i][k] + gt[i][k] * (bfs(ob[i][k]) * rstd * gp[i][k]);
      *reinterpret_cast<f4v*>(p.out + (size_t)tg * 1024 + c0) = rr;
    }
  }
}

#define XB_TMO      128
#define XB_XCNT(j)  (256  + 64 * (j))
#define XB_XSUB(j)  (1280 + 64 * (j))
#define XB_XGEN(j)  (2304 + 64 * (j))
#define XB_TOP      3328
#define XB_TOPGEN   3392
#define XCD_BAR_WORDS 3456
#define XB_SPIN_CAP (1u << 18)
#define LAS __attribute__((address_space(3)))
DI unsigned xb_ld(unsigned* p)              { return __hip_atomic_load(p, __ATOMIC_RELAXED, __HIP_MEMORY_SCOPE_AGENT); }
DI unsigned xb_add(unsigned* p, unsigned v) { return __hip_atomic_fetch_add(p, v, __ATOMIC_RELAXED, __HIP_MEMORY_SCOPE_AGENT); }
DI unsigned xb_xcc_id() { return (unsigned)__builtin_amdgcn_s_getreg((3 << 11) | 20) & 0xFu; }
#define XB_SPIN(cond, bar) do { unsigned _sp = 0; while (cond) { __builtin_amdgcn_s_sleep(1); \
    if ((++_sp & 255u) == 0u) { if (xb_ld(&(bar)[XB_TMO])) break; if (_sp > XB_SPIN_CAP) { atomicAdd(&(bar)[XB_TMO], 1u); break; } } } } while (0)
struct XcdBarrier { unsigned* bar; unsigned x; volatile LAS unsigned* st; };
DI XcdBarrier xcd_barrier_post(unsigned* bar, volatile LAS unsigned* st) {
  XcdBarrier b; b.bar = bar; b.x = xb_xcc_id(); b.st = st;
  if (threadIdx.x == 0) (void)xb_add(&bar[XB_XCNT(b.x)], 1u);
  return b;
}
DI void xcd_barrier_complete(unsigned* bar, unsigned x, unsigned& nloc, unsigned& nx) {
  const unsigned G = gridDim.x * gridDim.y * gridDim.z;
  unsigned sum, cnt, mine, sp = 0u;
  for (;;) {
    sum = 0u; cnt = 0u; mine = 0u;
#pragma unroll
    for (unsigned j = 0; j < 16; ++j) { const unsigned c = xb_ld(&bar[XB_XCNT(j)]); sum += c; cnt += (c > 0u) ? 1u : 0u; mine = (j == x) ? c : mine; }
    if (sum == G) break;
    __builtin_amdgcn_s_sleep(1);
    if ((++sp & 255u) == 0u) { if (xb_ld(&bar[XB_TMO])) break; if (sp > XB_SPIN_CAP) { atomicAdd(&bar[XB_TMO], 1u); break; } }
  }
  nloc = mine > 0u ? mine : 1u; nx = cnt > 0u ? cnt : 1u;
}
DI void xcd_barrier(const XcdBarrier& b) {
  asm volatile("s_waitcnt vmcnt(0)" ::: "memory");
  __syncthreads();
  if (threadIdx.x == 0) {
    unsigned* bar = b.bar;
    __builtin_amdgcn_s_waitcnt(0);
    unsigned nloc = b.st[0], nx = b.st[1];
    if (nloc == 0u) { xcd_barrier_complete(bar, b.x, nloc, nx); b.st[0] = nloc; b.st[1] = nx; }
    const unsigned old = xb_add(&bar[XB_XSUB(b.x)], 1u);
    const unsigned gen = old / nloc;
    if (old + 1u == (gen + 1u) * nloc) {
      __builtin_amdgcn_fence(__ATOMIC_RELEASE, "agent");
      asm volatile("s_waitcnt vmcnt(0)" ::: "memory");
      const unsigned og = xb_add(&bar[XB_TOP], 1u);
      const unsigned tg = og / nx;
      if (og + 1u == (tg + 1u) * nx) xb_add(&bar[XB_TOPGEN], 1u);
      else XB_SPIN(xb_ld(&bar[XB_TOPGEN]) == tg, bar);
      __builtin_amdgcn_fence(__ATOMIC_ACQUIRE, "agent");
      xb_add(&bar[XB_XGEN(b.x)], 1u);
      asm volatile("s_waitcnt vmcnt(0)" ::: "memory");
    } else {
      XB_SPIN(xb_ld(&bar[XB_XGEN(b.x)]) == gen, bar);
      __builtin_amdgcn_fence(__ATOMIC_ACQUIRE, "agent");
      asm volatile("s_waitcnt vmcnt(0)" ::: "memory");
    }
  }
  __syncthreads();
}

constexpr int PH_PER_PASS = 8;
constexpr int N_PHASES = 2 + NPASS * PH_PER_PASS;

constexpr int REP_MASK = 0;
constexpr int REP_SUB = 0;
constexpr int REP_A = 0;
constexpr int CPROBE = 0;
__global__ void __launch_bounds__(256, 2) mega_kernel(Params p, int ph_lo, int ph_hi) {
  __shared__ __attribute__((aligned(16))) unsigned char smem[73728];
  __shared__ uint4 xb_words;
  cg::grid_group grid = cg::this_grid();
  if (threadIdx.x == 0) xb_words = make_uint4(0u, 0u, 0u, 0u);
  __syncthreads();
  const XcdBarrier xb = xcd_barrier_post((unsigned*)(p.ws + O_BAR), (volatile LAS unsigned*)&xb_words);
  for (int ph = ph_lo; ph < ph_hi; ++ph) {
    if (ph == 0) {
      phaseA(p, smem);
      if (REP_A) { xcd_barrier(xb); phaseA(p, smem); }
    } else if (ph == 1) {
      phaseB(p, 0);
    } else {
      const int pass = (ph - 2) / PH_PER_PASS, k = (ph - 2) % PH_PER_PASS;
      Params q = p;
      const int nrep = ((REP_MASK >> k) & 1) ? 2 : 1;
      for (int rep = 0; rep < nrep; ++rep) {
        if (rep) xcd_barrier(xb);
        if (rep && REP_SUB == 9) continue;
        switch (k) {
          case 0: if (REP_MASK != 0 && rep) phaseC<CPROBE>(q, (u16*)smem); else phaseC<0>(q, (u16*)smem); break;
          case 1: phaseD(q, (u16*)smem, rep ? REP_SUB : 0, pass, rep); break;
          case 2: phaseE(q, (float*)smem, rep ? REP_SUB : 0, pass, rep); break;
          case 3: phaseF(q, rep > 0, (u16*)smem, pass, rep); break;
          case 4: phaseG(q, (float*)smem); break;
          case 5: phaseH(q, (u16*)smem); break;
          case 6: phaseI(q, (u16*)smem); break;
          default:
            phaseJ(q, pass);
            if (pass + 1 < NPASS) phaseB(q, pass + 1);
            break;
        }
      }
    }
    if (ph + 1 < ph_hi) {
      if (ph_hi < 0) grid.sync();
      xcd_barrier(xb);
    }
  }
}

extern "C" void kernel_launch(void* const* d_in, const int* in_sizes, int n_in, void* d_out, int out_size, void* d_ws,
                              size_t ws_size, hipStream_t stream) {
  static int grid_blocks = 0;
  if (!grid_blocks) {
    int dev = 0, cus = 0, per_cu = 0;
    hipGetDevice(&dev);
    hipDeviceGetAttribute(&cus, hipDeviceAttributeMultiprocessorCount, dev);
    hipOccupancyMaxActiveBlocksPerMultiprocessor(&per_cu, mega_kernel, 256, 0);
    if (per_cu < 1) per_cu = 1;
    if (per_cu > 2) per_cu = 2;
    grid_blocks = cus * per_cu;
  }
  if (ws_size < O_END) { fprintf(stderr, "workspace too small: %zu < %zu\n", ws_size, (size_t)O_END); return; }
  Params p{};
  const float** pp = reinterpret_cast<const float**>(&p);
  for (int i = 0; i < 22; ++i) pp[i] = (const float*)d_in[i];
  p.out = (float*)d_out;
  p.ws = (unsigned char*)d_ws;
  hipMemsetAsync((unsigned char*)d_ws + O_BAR, 0, 16384, stream);
  int lo = 0, hi = N_PHASES;
  void* args[] = {&p, &lo, &hi};
  hipError_t e = hipLaunchCooperativeKernel((void*)mega_kernel, dim3(grid_blocks), dim3(256), args, 0, stream);
  if (e != hipSuccess) fprintf(stderr, "cooperative launch failed: %s (grid %d)\n", hipGetErrorString(e), grid_blocks);
}
```

```cpp
#include <hip/hip_runtime.h>
#include <hip/hip_cooperative_groups.h>
#include <cstdio>
namespace cg = cooperative_groups;

typedef unsigned short u16;
typedef short s8v __attribute__((ext_vector_type(8)));
typedef short s4v __attribute__((ext_vector_type(4)));
typedef float f4v __attribute__((ext_vector_type(4)));
#define DI __device__ __forceinline__
#define MFMA16(a, b, c) __builtin_amdgcn_mfma_f32_16x16x32_bf16((a), (b), (c), 0, 0, 0)

constexpr int SEQ = 2048, DM = 1024, NB = 8;
constexpr int TS = SEQ + 64;
constexpr int NBG = 2;
constexpr int MP = NBG * SEQ;
constexpr int NPASS = NB / NBG;
constexpr int NIN = 10832, LDP = 10880;
constexpr int C_Z = 0, C_XBC = 2048, C_DT = 5120, C_Q = 5152, C_KC = 6176, C_VC = 6432, C_KS = 6688, C_VS = 6944,
              C_KW = 7200, C_VW = 7456, C_G = 7712, C_ZA = 7760, C_MG = 8784;
constexpr float EPS = 1e-6f;
constexpr float NEGB = -1e30f;
constexpr int APROBE = 0;

constexpr size_t al256(size_t x) { return (x + 255) & ~size_t(255); }
constexpr size_t O_WIN = 0;
constexpr size_t O_WSSM = O_WIN + al256((size_t)LDP * 1024 * 2);
constexpr size_t O_WNSA = O_WSSM + al256((size_t)1024 * 2048 * 2);
constexpr size_t O_WOUT = O_WNSA + al256((size_t)1024 * 1024 * 2);
constexpr size_t O_W1K = O_WOUT + al256((size_t)1024 * 1024 * 2);
constexpr size_t O_W1V = O_W1K + al256((size_t)256 * 2048 * 2);
constexpr size_t O_W2K = O_W1V + al256((size_t)256 * 2048 * 2);
constexpr size_t O_W2V = O_W2K + al256((size_t)64 * 256 * 2);
constexpr size_t O_POSB = O_W2V + al256((size_t)64 * 256 * 2);
constexpr size_t O_ADA = O_POSB + al256(2 * 256 * 4);
constexpr size_t O_H = O_ADA + al256((size_t)8 * 3072 * 4);
constexpr size_t O_P = O_H + al256((size_t)MP * 1024 * 2);
constexpr size_t O_XC = O_P + al256((size_t)MP * LDP * 2);
constexpr size_t O_XCT = O_XC + al256((size_t)MP * 3072 * 2);
constexpr size_t O_DT = O_XCT + al256((size_t)NBG * 2560 * TS * 2);
constexpr size_t O_ACS = O_DT + al256((size_t)NBG * 32 * 2048 * 4);
constexpr size_t O_ST = O_ACS + al256((size_t)NBG * 32 * 2048 * 4);
constexpr size_t O_YD = O_ST + al256((size_t)NBG * 16 * 32 * 64 * 128 * 2);
constexpr size_t O_YN = O_YD;
constexpr size_t O_KCMP = O_YD + al256((size_t)MP * 2048 * 2);
constexpr size_t O_VCT = O_KCMP + al256((size_t)NBG * 4 * 128 * 64 * 2);
constexpr size_t O_VST = O_VCT + al256((size_t)NBG * 4 * 128 * 64 * 2);
constexpr size_t O_VWT = O_VST + al256((size_t)NBG * 4 * 64 * TS * 2);
constexpr size_t O_SEL = O_VWT + al256((size_t)NBG * 4 * 64 * TS * 2);
constexpr size_t O_OCMP = O_SEL + al256((size_t)NBG * 4 * 2048 * 4);
constexpr size_t O_O = O_OCMP + al256((size_t)MP * 1024 * 2);
constexpr size_t O_BAR = O_O + al256((size_t)MP * 1024 * 2);
constexpr size_t O_END = O_BAR + 16384;
static_assert(O_END <= (size_t)256 * 1024 * 1024, "workspace map must fit the guaranteed 256 MiB");
constexpr size_t O_OUTF = O_P;
constexpr size_t O_RSQ = O_P + al256((size_t)MP * 1024 * 4);

struct Params {
  const float *x, *c, *w_ada, *b_ada, *g_pre, *g_post, *w_in, *conv_w, *conv_b, *dt_bias, *a_log, *d_skip, *g_ssm_norm,
      *w_ssm_out, *cmp_pos_k, *cmp_w1_k, *cmp_w2_k, *cmp_pos_v, *cmp_w1_v, *cmp_w2_v, *w_nsa_out, *w_out;
  float* out;
  unsigned char* ws;
};

DI u16 f2bf(float f) { unsigned u = __float_as_uint(f); u += 0x7fffu + ((u >> 16) & 1u); return (u16)(u >> 16); }
DI float bf2f(u16 h) { return __uint_as_float(((unsigned)h) << 16); }
DI float bfs(short h) { return __uint_as_float(((unsigned)(u16)h) << 16); }
DI s8v ld8(const u16* p) { return *reinterpret_cast<const s8v*>(p); }
DI s4v ld4(const u16* p) { return *reinterpret_cast<const s4v*>(p); }
DI f4v ldf4(const float* p) { return *reinterpret_cast<const f4v*>(p); }
typedef __bf16 bf2v __attribute__((ext_vector_type(2)));
typedef float f2v __attribute__((ext_vector_type(2)));
typedef unsigned u2v __attribute__((ext_vector_type(2)));
typedef unsigned u4v __attribute__((ext_vector_type(4)));
DI unsigned pk2(float a, float b) {
  f2v v = {a, b};
  return __builtin_bit_cast(unsigned, __builtin_convertvector(v, bf2v));
}
DI void st4bf(u16* p, float a, float b, float c, float d) {
  u2v v = {pk2(a, b), pk2(c, d)};
  *reinterpret_cast<u2v*>(p) = v;
}
DI void st8bf_pair(u16* p, f4v a, f4v b, int quad) {
  unsigned ax = pk2(a[0], a[1]), ay = pk2(a[2], a[3]), bx = pk2(b[0], b[1]), by = pk2(b[2], b[3]);
  const auto r0 = __builtin_amdgcn_permlane16_swap(ax, bx, false, false);
  const auto r1 = __builtin_amdgcn_permlane16_swap(ay, by, false, false);
  u4v v = {r0[0], r1[0], r0[1], r1[1]};
  *reinterpret_cast<u4v*>(p + (quad & 1) * 16 + (quad >> 1) * 8) = v;
}
DI void ld8bf_pair(const u16* p, int quad, s4v& a, s4v& b) {
  const u4v x = *reinterpret_cast<const u4v*>(p + (quad & 1) * 16 + (quad >> 1) * 8);
  const auto r0 = __builtin_amdgcn_permlane16_swap(x[0], x[2], false, false);
  const auto r1 = __builtin_amdgcn_permlane16_swap(x[1], x[3], false, false);
  u2v ua = {r0[0], r1[0]}, ub = {r0[1], r1[1]};
  a = __builtin_bit_cast(s4v, ua);
  b = __builtin_bit_cast(s4v, ub);
}
DI s8v pack8(f4v a, f4v b) {
  u4v v = {pk2(a[0], a[1]), pk2(a[2], a[3]), pk2(b[0], b[1]), pk2(b[2], b[3])};
  return __builtin_bit_cast(s8v, v);
}
DI s8v pack8f(const float* x) {
  u4v v = {pk2(x[0], x[1]), pk2(x[2], x[3]), pk2(x[4], x[5]), pk2(x[6], x[7])};
  return __builtin_bit_cast(s8v, v);
}
DI s8v cat44(s4v a, s4v b) { s8v v; v[0]=a[0]; v[1]=a[1]; v[2]=a[2]; v[3]=a[3]; v[4]=b[0]; v[5]=b[1]; v[6]=b[2]; v[7]=b[3]; return v; }
DI float sigmoidf_(float x) { return __builtin_amdgcn_rcpf(1.f + __expf(-x)); }
DI float siluf_(float x) { return x * __builtin_amdgcn_rcpf(1.f + __expf(-x)); }
DI float softplusf_(float x) {
  const float y = __expf(x);
  const float small = y * (1.f - y * (0.5f - y * (0.33333334f - 0.25f * y)));
  const float big = __logf(1.f + y);
  return x > 20.f ? x : (y < 0.03f ? small : big);
}
DI float qmax(float v) { v = fmaxf(v, __shfl_xor(v, 16)); v = fmaxf(v, __shfl_xor(v, 32)); return v; }
DI float qsum(float v) { v += __shfl_xor(v, 16); v += __shfl_xor(v, 32); return v; }
DI int tidx() { int t = __builtin_amdgcn_workitem_id_x(); asm volatile("" : "+v"(t)); return t; }
DI f4v fz() { f4v z = {0.f, 0.f, 0.f, 0.f}; return z; }

DI int lds_byte32(int r, int c) {
  const int ob = (r & 15) * 64 + c * 2;
  return (r >> 4) * 1024 + (ob ^ (((ob >> 9) & 1) << 5));
}
DI void stage_rc32(int b, int& R, int& C) {
  const int st = b >> 10, sb = b & 1023, swz = sb ^ (((sb >> 9) & 1) << 5);
  R = st * 16 + (swz >> 6);
  C = (swz & 63) >> 1;
}
template <int N> DI void wait_vm() {
  if constexpr (N == 0) asm volatile("s_waitcnt vmcnt(0)" ::: "memory");
  else if constexpr (N == 3) asm volatile("s_waitcnt vmcnt(3)" ::: "memory");
  else if constexpr (N == 4) asm volatile("s_waitcnt vmcnt(4)" ::: "memory");
  else if constexpr (N == 6) asm volatile("s_waitcnt vmcnt(6)" ::: "memory");
  else asm volatile("s_waitcnt vmcnt(8)" ::: "memory");
}
template <int NT, int MODE = 0>
DI void gemm_mainloop(f4v (&acc)[4][NT], const u16* __restrict__ A, int lda, const u16* __restrict__ Bt, int ldb, int K,
                      int m0, int n0, u16* smem) {
  const int tid = tidx(), lane = tid & 63, w = tid >> 6, wm = w >> 1, wn = w & 1;
  const int l15 = lane & 15, quad = lane >> 4;
  constexpr int TA = 8192, TBB = NT * 2048, TBUF = TA + TBB;
  constexpr int NBP = NT / 2;
  constexpr int L = 2 + NBP;
  char* sbase = reinterpret_cast<char*>(smem);
  const unsigned lbase = (unsigned)(size_t)sbase;
  int Rr[2], Cc[2];
#pragma unroll
  for (int i = 0; i < 2; ++i) stage_rc32(tid * 16 + i * 4096, Rr[i], Cc[i]);
  const u16* ga0 = A + (size_t)(m0 + Rr[0]) * lda + Cc[0];
  const u16* ga1 = A + (size_t)(m0 + Rr[1]) * lda + Cc[1];
  const u16* gb0 = Bt + (size_t)(n0 + Rr[0]) * ldb + Cc[0];
  const u16* gb1 = Bt + (size_t)(n0 + Rr[NBP - 1]) * ldb + Cc[NBP - 1];
  unsigned offa[4], offb[NT];
#pragma unroll
  for (int t = 0; t < 4; ++t) offa[t] = lds_byte32(wm * 64 + t * 16 + l15, quad * 8);
#pragma unroll
  for (int t = 0; t < NT; ++t) offb[t] = TA + lds_byte32(wn * 16 * NT + t * 16 + l15, quad * 8);
  const int ns = K >> 5;
#define GEMM_STAGE(j)                                                                                                 \
  do {                                                                                                               \
    char* _d = sbase + ((j) & 3) * TBUF + tid * 16;                                                                   \
    __builtin_amdgcn_global_load_lds((const unsigned*)(ga0 + (j) * 32), (unsigned*)(_d), 16, 0, 0);                   \
    __builtin_amdgcn_global_load_lds((const unsigned*)(ga1 + (j) * 32), (unsigned*)(_d + 4096), 16, 0, 0);            \
    __builtin_amdgcn_global_load_lds((const unsigned*)(gb0 + (j) * 32), (unsigned*)(_d + TA), 16, 0, 0);              \
    if (NBP == 2) __builtin_amdgcn_global_load_lds((const unsigned*)(gb1 + (j) * 32), (unsigned*)(_d + TA + 4096), 16, 0, 0); \
  } while (0)
  asm volatile("s_waitcnt vmcnt(0)" ::: "memory");
  if (MODE != 1) { GEMM_STAGE(0); GEMM_STAGE(1); GEMM_STAGE(2); }
  for (int j = 0; j < ns; ++j) {
    if (j + 2 < ns) wait_vm<2 * L>();
    else if (j + 1 < ns) wait_vm<L>();
    else wait_vm<0>();
    asm volatile("s_waitcnt lgkmcnt(0)" ::: "memory");
    __builtin_amdgcn_s_barrier();
    if (MODE != 1 && j + 3 < ns) GEMM_STAGE(j + 3);
    if (MODE == 2) continue;
    const unsigned sl = lbase + (unsigned)((j & 3) * TBUF);
    s8v af[4], bg[NT];
    if constexpr (NT == 4) {
      asm volatile(
          "ds_read_b128 %0, %8\n\tds_read_b128 %1, %9\n\tds_read_b128 %2, %10\n\tds_read_b128 %3, %11\n\t"
          "ds_read_b128 %4, %12\n\tds_read_b128 %5, %13\n\tds_read_b128 %6, %14\n\tds_read_b128 %7, %15\n\t"
          "s_waitcnt lgkmcnt(0)"
          : "=&v"(af[0]), "=&v"(af[1]), "=&v"(af[2]), "=&v"(af[3]), "=&v"(bg[0]), "=&v"(bg[1]), "=&v"(bg[2]), "=&v"(bg[3])
          : "v"(sl + offa[0]), "v"(sl + offa[1]), "v"(sl + offa[2]), "v"(sl + offa[3]), "v"(sl + offb[0]), "v"(sl + offb[1]),
            "v"(sl + offb[2]), "v"(sl + offb[3])
          : "memory");
    } else {
      asm volatile(
          "ds_read_b128 %0, %6\n\tds_read_b128 %1, %7\n\tds_read_b128 %2, %8\n\tds_read_b128 %3, %9\n\t"
          "ds_read_b128 %4, %10\n\tds_read_b128 %5, %11\n\t"
          "s_waitcnt lgkmcnt(0)"
          : "=&v"(af[0]), "=&v"(af[1]), "=&v"(af[2]), "=&v"(af[3]), "=&v"(bg[0]), "=&v"(bg[1])
          : "v"(sl + offa[0]), "v"(sl + offa[1]), "v"(sl + offa[2]), "v"(sl + offa[3]), "v"(sl + offb[0]), "v"(sl + offb[1])
          : "memory");
    }
#pragma unroll
    for (int mt = 0; mt < 4; ++mt)
#pragma unroll
      for (int nt = 0; nt < NT; ++nt) acc[mt][nt] = MFMA16(bg[nt], af[mt], acc[mt][nt]);
  }
#undef GEMM_STAGE
  asm volatile("s_waitcnt lgkmcnt(0)" ::: "memory");
  __builtin_amdgcn_s_barrier();
}
template <int NT>
DI void zero_acc(f4v (&acc)[4][NT]) {
#pragma unroll
  for (int i = 0; i < 4; ++i)
#pragma unroll
    for (int j = 0; j < NT; ++j) acc[i][j] = fz();
}

DI void gemm_big_prefetch(const u16* __restrict__ A, int lda, const u16* __restrict__ Bt, int ldb, int m0, int n0, u16* smem) {
  const int tid = tidx();
  char* sbase = reinterpret_cast<char*>(smem);
#pragma unroll
  for (int sl = 0; sl < 2; ++sl) {
    char* d = sbase + sl * 24576 + tid * 16;
#pragma unroll
    for (int i = 0; i < 4; ++i) {
      int R, C;
      stage_rc32(tid * 16 + i * 4096, R, C);
      __builtin_amdgcn_global_load_lds((const unsigned*)(A + (size_t)(m0 + R) * lda + C + sl * 32), (unsigned*)(d + i * 4096), 16, 0, 0);
      if (i < 2)
        __builtin_amdgcn_global_load_lds((const unsigned*)(Bt + (size_t)(n0 + R) * ldb + C + sl * 32), (unsigned*)(d + 16384 + i * 4096), 16, 0, 0);
    }
  }
}
DI void gemm_big(f4v (&acc)[8][4], const u16* __restrict__ A, int lda, const u16* __restrict__ Bt, int ldb, int K, int m0, int n0,
                 u16* smem, bool prestaged) {
  const int tid = tidx(), lane = tid & 63, w = tid >> 6, wm = w >> 1, wn = w & 1;
  const int l15 = lane & 15, quad = lane >> 4;
  constexpr int TA = 16384, TBUF = 24576;
  char* sbase = reinterpret_cast<char*>(smem);
  const unsigned lbase = (unsigned)(size_t)sbase;
  const u16* ga[4];
  const u16* gb[2];
#pragma unroll
  for (int i = 0; i < 4; ++i) {
    int R, C;
    stage_rc32(tid * 16 + i * 4096, R, C);
    ga[i] = A + (size_t)(m0 + R) * lda + C;
    if (i < 2) gb[i] = Bt + (size_t)(n0 + R) * ldb + C;
  }
  unsigned offa[8], offb[4];
#pragma unroll
  for (int t = 0; t < 8; ++t) offa[t] = lds_byte32(wm * 128 + t * 16 + l15, quad * 8);
#pragma unroll
  for (int t = 0; t < 4; ++t) offb[t] = TA + lds_byte32(wn * 64 + t * 16 + l15, quad * 8);
  const int ns = K >> 5;
#define BIG_STAGE(j, slot)                                                                                            \
  do {                                                                                                               \
    char* _d = sbase + (slot) * TBUF + tid * 16;                                                                      \
    _Pragma("unroll") for (int _i = 0; _i < 4; ++_i)                                                                 \
      __builtin_amdgcn_global_load_lds((const unsigned*)(ga[_i] + (j) * 32), (unsigned*)(_d + _i * 4096), 16, 0, 0);  \
    _Pragma("unroll") for (int _i = 0; _i < 2; ++_i)                                                                 \
      __builtin_amdgcn_global_load_lds((const unsigned*)(gb[_i] + (j) * 32), (unsigned*)(_d + TA + _i * 4096), 16, 0, 0); \
  } while (0)
  if (!prestaged) {
    asm volatile("s_waitcnt vmcnt(0)" ::: "memory");
    BIG_STAGE(0, 0);
    BIG_STAGE(1, 1);
  }
  int slot = 0;
  for (int j = 0; j < ns; ++j) {
    if (j + 1 < ns) wait_vm<6>();
    else wait_vm<0>();
    asm volatile("s_waitcnt lgkmcnt(0)" ::: "memory");
    __builtin_amdgcn_s_barrier();
    const int s2 = (slot == 0) ? 2 : slot - 1;
    if (j + 2 < ns) BIG_STAGE(j + 2, s2);
    const unsigned sl = lbase + (unsigned)(slot * TBUF);
    s8v af[8], bg[4];
    asm volatile(
        "ds_read_b128 %0, %12\n\tds_read_b128 %1, %13\n\tds_read_b128 %2, %14\n\tds_read_b128 %3, %15\n\t"
        "ds_read_b128 %4, %16\n\tds_read_b128 %5, %17\n\tds_read_b128 %6, %18\n\tds_read_b128 %7, %19\n\t"
        "ds_read_b128 %8, %20\n\tds_read_b128 %9, %21\n\tds_read_b128 %10, %22\n\tds_read_b128 %11, %23\n\t"
        "s_waitcnt lgkmcnt(0)"
        : "=&v"(bg[0]), "=&v"(bg[1]), "=&v"(bg[2]), "=&v"(bg[3]), "=&v"(af[0]), "=&v"(af[1]), "=&v"(af[2]), "=&v"(af[3]),
          "=&v"(af[4]), "=&v"(af[5]), "=&v"(af[6]), "=&v"(af[7])
        : "v"(sl + offb[0]), "v"(sl + offb[1]), "v"(sl + offb[2]), "v"(sl + offb[3]), "v"(sl + offa[0]), "v"(sl + offa[1]),
          "v"(sl + offa[2]), "v"(sl + offa[3]), "v"(sl + offa[4]), "v"(sl + offa[5]), "v"(sl + offa[6]), "v"(sl + offa[7])
        : "memory");
#pragma unroll
    for (int mt = 0; mt < 8; ++mt)
#pragma unroll
      for (int nt = 0; nt < 4; ++nt) acc[mt][nt] = MFMA16(bg[nt], af[mt], acc[mt][nt]);
    slot = (slot == 2) ? 0 : slot + 1;
  }
#undef BIG_STAGE
  asm volatile("s_waitcnt lgkmcnt(0)" ::: "memory");
  __builtin_amdgcn_s_barrier();
}

DI void gemm_k64(f4v (&acc)[4][2], const u16* __restrict__ A, int lda, const u16* __restrict__ Bt, int ldb, int K, int m0, int n0,
                 u16* smem) {
  const int tid = tidx(), lane = tid & 63, w = tid >> 6, wm = w >> 1, wn = w & 1;
  const int l15 = lane & 15, quad = lane >> 4;
  constexpr int TA = 16384, TBUF = 24576;
  char* sbase = reinterpret_cast<char*>(smem);
  const unsigned lbase = (unsigned)(size_t)sbase;
  const u16* ga[4];
  const u16* gb[2];
#pragma unroll
  for (int i = 0; i < 4; ++i) {
    int R, C;
    stage_rc32(tid * 16 + (i & 1) * 4096, R, C);
    ga[i] = A + (size_t)(m0 + R) * lda + C + 32 * (i >> 1);
  }
  {
    int R, C;
    stage_rc32(tid * 16, R, C);
    gb[0] = Bt + (size_t)(n0 + R) * ldb + C;
    gb[1] = gb[0] + 32;
  }
  unsigned offa[8], offb[4];
#pragma unroll
  for (int t = 0; t < 8; ++t) offa[t] = (t >> 2) * 8192 + lds_byte32(wm * 64 + (t & 3) * 16 + l15, quad * 8);
#pragma unroll
  for (int t = 0; t < 4; ++t) offb[t] = TA + (t >> 1) * 4096 + lds_byte32(wn * 32 + (t & 1) * 16 + l15, quad * 8);
  const int ns = K >> 6;
#define K64_STAGE(j, slot)                                                                                            \
  do {                                                                                                               \
    char* _d = sbase + (slot) * TBUF + tid * 16;                                                                      \
    _Pragma("unroll") for (int _i = 0; _i < 4; ++_i)                                                                 \
      __builtin_amdgcn_global_load_lds((const unsigned*)(ga[_i] + (j) * 64), (unsigned*)(_d + _i * 4096), 16, 0, 0);  \
    _Pragma("unroll") for (int _i = 0; _i < 2; ++_i)                                                                 \
      __builtin_amdgcn_global_load_lds((const unsigned*)(gb[_i] + (j) * 64), (unsigned*)(_d + TA + _i * 4096), 16, 0, 0); \
  } while (0)
  asm volatile("s_waitcnt vmcnt(0)" ::: "memory");
  K64_STAGE(0, 0);
  if (ns > 1) K64_STAGE(1, 1);
  int slot = 0;
  for (int j = 0; j < ns; ++j) {
    if (j + 1 < ns) wait_vm<6>();
    else wait_vm<0>();
    asm volatile("s_waitcnt lgkmcnt(0)" ::: "memory");
    __builtin_amdgcn_s_barrier();
    const int s2 = (slot == 0) ? 2 : slot - 1;
    if (j + 2 < ns) K64_STAGE(j + 2, s2);
    const unsigned sl = lbase + (unsigned)(slot * TBUF);
    s8v af[8], bg[4];
    asm volatile(
        "ds_read_b128 %0, %12\n\tds_read_b128 %1, %13\n\tds_read_b128 %2, %14\n\tds_read_b128 %3, %15\n\t"
        "ds_read_b128 %4, %16\n\tds_read_b128 %5, %17\n\tds_read_b128 %6, %18\n\tds_read_b128 %7, %19\n\t"
        "ds_read_b128 %8, %20\n\tds_read_b128 %9, %21\n\tds_read_b128 %10, %22\n\tds_read_b128 %11, %23\n\t"
        "s_waitcnt lgkmcnt(0)"
        : "=&v"(bg[0]), "=&v"(bg[1]), "=&v"(bg[2]), "=&v"(bg[3]), "=&v"(af[0]), "=&v"(af[1]), "=&v"(af[2]), "=&v"(af[3]),
          "=&v"(af[4]), "=&v"(af[5]), "=&v"(af[6]), "=&v"(af[7])
        : "v"(sl + offb[0]), "v"(sl + offb[1]), "v"(sl + offb[2]), "v"(sl + offb[3]), "v"(sl + offa[0]), "v"(sl + offa[1]),
          "v"(sl + offa[2]), "v"(sl + offa[3]), "v"(sl + offa[4]), "v"(sl + offa[5]), "v"(sl + offa[6]), "v"(sl + offa[7])
        : "memory");
#pragma unroll
    for (int h = 0; h < 2; ++h)
#pragma unroll
      for (int mt = 0; mt < 4; ++mt)
#pragma unroll
        for (int nt = 0; nt < 2; ++nt) acc[mt][nt] = MFMA16(bg[h * 2 + nt], af[h * 4 + mt], acc[mt][nt]);
    slot = (slot == 2) ? 0 : slot + 1;
  }
#undef K64_STAGE
  asm volatile("s_waitcnt lgkmcnt(0)" ::: "memory");
  __builtin_amdgcn_s_barrier();
}

DI void convT_tile(const float* __restrict__ w, int K, int N, u16* __restrict__ wt, int tile, float* sm) {
  const int tid = tidx();
  const int tiles_k = K >> 6;
  const int tk = tile % tiles_k, tn = tile / tiles_k;
  const int k0 = tk * 64, n0 = tn * 64;
  {
    const int c = tid & 63, r0 = tid >> 6;
    const bool ok = (n0 + c) < N;
    float v[16];
#pragma unroll
    for (int i = 0; i < 16; ++i) v[i] = ok ? w[(size_t)(k0 + r0 + 4 * i) * N + n0 + c] : 0.f;
    __builtin_amdgcn_sched_barrier(0);
#pragma unroll
    for (int i = 0; i < 16; ++i) sm[(r0 + 4 * i) * 65 + c] = v[i];
  }
  __syncthreads();
  {
    const int n = tid >> 2, ks = (tid & 3) * 16;
    float t0[8], t1[8];
#pragma unroll
    for (int j = 0; j < 8; ++j) { t0[j] = sm[(ks + j) * 65 + n]; t1[j] = sm[(ks + 8 + j) * 65 + n]; }
    const s8v v0 = pack8f(t0), v1 = pack8f(t1);
    u16* dst = wt + (size_t)(n0 + n) * K + k0 + ks;
    *reinterpret_cast<s8v*>(dst) = v0;
    *reinterpret_cast<s8v*>(dst + 8) = v1;
  }
  __syncthreads();
}

template <int NR>
DI void gemv_cols(const float* __restrict__ vec, int K, const float* __restrict__ W, int N, const float* __restrict__ bias,
                  float* __restrict__ out, int col0, float* sm) {
  const int tid = tidx(), kg = tid >> 6, cl = tid & 63;
  const int kper = K >> 2;
  float acc[NR];
#pragma unroll
  for (int r = 0; r < NR; ++r) acc[r] = 0.f;
  for (int k0 = kg * kper; k0 < (kg + 1) * kper; k0 += 16) {
    float wv[16];
#pragma unroll
    for (int j = 0; j < 16; ++j) wv[j] = W[(size_t)(k0 + j) * N + col0 + cl];
    __builtin_amdgcn_sched_barrier(0);
#pragma unroll
    for (int j = 0; j < 16; ++j)
#pragma unroll
      for (int r = 0; r < NR; ++r) acc[r] += vec[r * K + k0 + j] * wv[j];
    __builtin_amdgcn_sched_barrier(0);
  }
#pragma unroll
  for (int r = 0; r < NR; ++r) sm[(kg * NR + r) * 64 + cl] = acc[r];
  __syncthreads();
  for (int idx = tid; idx < NR * 64; idx += 256) {
    const int r = idx >> 6, c2 = idx & 63;
    float s = bias ? bias[col0 + c2] : 0.f;
#pragma unroll
    for (int g = 0; g < 4; ++g) s += sm[(g * NR + r) * 64 + c2];
    out[(size_t)r * N + col0 + c2] = s;
  }
  __syncthreads();
}

DI void phaseA(const Params& p, unsigned char* smem_raw) {
  float* smf = reinterpret_cast<float*>(smem_raw);
  unsigned char* ws = p.ws;
  constexpr int T0 = 16 * 170, T1 = T0 + 32 * 16, T2 = T1 + 16 * 16, T3 = T2 + 16 * 16, T4 = T3 + 32 * 4, T5 = T4 + 32 * 4,
                T6 = T5 + 4, T7 = T6 + 4, T8 = T7 + 48, T9 = T8 + 8;
  for (int it = blockIdx.x; it < T9; it += gridDim.x) {
    if (it < T0) convT_tile(p.w_in, 1024, NIN, (u16*)(ws + O_WIN), it, smf);
    else if (it < T1) convT_tile(p.w_ssm_out, 2048, 1024, (u16*)(ws + O_WSSM), it - T0, smf);
    else if (it < T2) convT_tile(p.w_nsa_out, 1024, 1024, (u16*)(ws + O_WNSA), it - T1, smf);
    else if (it < T3) convT_tile(p.w_out, 1024, 1024, (u16*)(ws + O_WOUT), it - T2, smf);
    else if (it < T4) convT_tile(p.cmp_w1_k, 2048, 256, (u16*)(ws + O_W1K), it - T3, smf);
    else if (it < T5) convT_tile(p.cmp_w1_v, 2048, 256, (u16*)(ws + O_W1V), it - T4, smf);
    else if (it < T6) convT_tile(p.cmp_w2_k, 256, 64, (u16*)(ws + O_W2K), it - T5, smf);
    else if (it < T7) convT_tile(p.cmp_w2_v, 256, 64, (u16*)(ws + O_W2V), it - T6, smf);
    else if (it < T8) gemv_cols<8>(p.c, 1024, p.w_ada, 3072, p.b_ada, (float*)(ws + O_ADA), (it - T7) * 64, smf);
    else {
      const int j = it - T8, kind = j >> 2, cb = j & 3;
      gemv_cols<1>(kind ? p.cmp_pos_v : p.cmp_pos_k, 2048, kind ? p.cmp_w1_v : p.cmp_w1_k, 256, nullptr,
                   (float*)(ws + O_POSB) + kind * 256, cb * 64, smf);
    }
  }
}

DI void phaseB(const Params& p, int pass) {
  const int tid = tidx(), lane = tid & 63, w = tid >> 6;
  const float* ada = (const float*)(p.ws + O_ADA);
  u16* h = (u16*)(p.ws + O_H);
  for (int it = blockIdx.x; it < MP / 4; it += gridDim.x) {
    const int r = it * 4 + w;
    const int tg = pass * MP + r;
    const int b = tg >> 11;
    const float* xr = p.x + (size_t)tg * DM;
    f4v v[4];
    float ss = 0.f;
#pragma unroll
    for (int i = 0; i < 4; ++i) {
      v[i] = ldf4(xr + i * 256 + lane * 4);
      ss += v[i][0] * v[i][0] + v[i][1] * v[i][1] + v[i][2] * v[i][2] + v[i][3] * v[i][3];
    }
#pragma unroll
    for (int o = 1; o < 64; o <<= 1) ss += __shfl_xor(ss, o);
    const float rstd = rsqrtf(ss * (1.f / DM) + EPS);
    f4v gg[4], shh[4], scc[4];
#pragma unroll
    for (int i = 0; i < 4; ++i) {
      const int c0 = i * 256 + lane * 4;
      gg[i] = ldf4(p.g_pre + c0);
      shh[i] = ldf4(ada + b * 3072 + c0);
      scc[i] = ldf4(ada + b * 3072 + 1024 + c0);
    }
    __builtin_amdgcn_sched_barrier(0);
#pragma unroll
    for (int i = 0; i < 4; ++i) {
      const int c0 = i * 256 + lane * 4;
      const f4v g = gg[i], sh = shh[i], sc = scc[i];
      float o0 = v[i][0] * rstd * g[0] * (1.f + sc[0]) + sh[0];
      float o1 = v[i][1] * rstd * g[1] * (1.f + sc[1]) + sh[1];
      float o2 = v[i][2] * rstd * g[2] * (1.f + sc[2]) + sh[2];
      float o3 = v[i][3] * rstd * g[3] * (1.f + sc[3]) + sh[3];
      st4bf(h + (size_t)r * DM + c0, o0, o1, o2, o3);
    }
  }
}

template <int MODE>
DI void phaseC(const Params& p, u16* smem) {
  const int lane = tidx() & 63, w = tidx() >> 6, wm = w >> 1, wn = w & 1, l15 = lane & 15, quad = lane >> 4;
  const u16* A = (const u16*)(p.ws + O_H);
  const u16* Bt = (const u16*)(p.ws + O_WIN);
  u16* P = (u16*)(p.ws + O_P);
  constexpr int NTN = LDP / 128;
  const int xcd = blockIdx.x & 7, lb = blockIdx.x >> 3, nlb = gridDim.x >> 3;
  bool pre = false;
  for (int t = lb;; t += nlb) {
    const int mi = (xcd & 3) * 4 + (t & 3);
    const int ni = 2 * (t >> 2) + (xcd >> 2);
    if (ni >= NTN) break;
    f4v acc[8][4];
#pragma unroll
    for (int i = 0; i < 8; ++i)
#pragma unroll
      for (int j = 0; j < 4; ++j) acc[i][j] = fz();
    gemm_big(acc, A, 1024, Bt, 1024, 1024, mi * 256, ni * 128, smem, pre);
    {
      const int t2 = t + nlb;
      const int ni2 = 2 * (t2 >> 2) + (xcd >> 2);
      pre = ni2 < NTN;
      if (pre) gemm_big_prefetch(A, 1024, Bt, 1024, ((xcd & 3) * 4 + (t2 & 3)) * 256, ni2 * 128, smem);
    }
    if (MODE != 0) { if (acc[0][0][0] + acc[7][3][3] != 12345.678f) continue; }
#pragma unroll
    for (int mt = 0; mt < 8; ++mt) {
      u16* prow = P + (size_t)(mi * 256 + wm * 128 + mt * 16 + l15) * LDP + ni * 128 + wn * 64;
      st8bf_pair(prow, acc[mt][0], acc[mt][1], quad);
      st8bf_pair(prow + 32, acc[mt][2], acc[mt][3], quad);
    }
  }
}

DI void conv_item(const Params& p, int it) {
  const int tid = tidx();
  const int cb = it % 24, tb = (it / 24) & 31, b = it / (24 * 32);
  const int ch0 = cb * 128 + 2 * (tid & 63);
  const int t0 = tb * 64 + 16 * (tid >> 6);
  const u16* P = (const u16*)(p.ws + O_P);
  u16* xc = (u16*)(p.ws + O_XC);
  u16* xcT = (u16*)(p.ws + O_XCT);
  unsigned raw[19];
#pragma unroll
  for (int i = 0; i < 19; ++i) {
    const int t = t0 - 3 + i;
    raw[i] = (t >= 0) ? *reinterpret_cast<const unsigned*>(P + (size_t)(b * SEQ + t) * LDP + C_XBC + ch0) : 0u;
  }
  const int hd = ch0 >> 6;
  u16 dtr[16];
  const bool isx = ch0 < 2048, isxb = ch0 < 2560;
  if (isx) {
#pragma unroll
    for (int i = 0; i < 16; ++i) dtr[i] = P[(size_t)(b * SEQ + t0 + i) * LDP + C_DT + hd];
  }
  float wv[4][2];
#pragma unroll
  for (int k = 0; k < 4; ++k) { wv[k][0] = p.conv_w[k * 3072 + ch0]; wv[k][1] = p.conv_w[k * 3072 + ch0 + 1]; }
  const float b0 = p.conv_b[ch0], b1 = p.conv_b[ch0 + 1];
  float y0[16], y1[16];
#pragma unroll
  for (int i = 0; i < 16; ++i) {
    float a0 = b0, a1 = b1;
#pragma unroll
    for (int k = 0; k < 4; ++k) {
      a0 += wv[k][0] * __uint_as_float(raw[i + k] << 16);
      a1 += wv[k][1] * __uint_as_float(raw[i + k] & 0xffff0000u);
    }
    y0[i] = siluf_(a0); y1[i] = siluf_(a1);
    const unsigned pk = pk2(y0[i], y1[i]);
    if (ch0 >= 2048) *reinterpret_cast<unsigned*>(xc + (size_t)(b * SEQ + t0 + i) * 3072 + ch0) = pk;
  }
  if (isxb) {
    if (isx) {
      const float db = p.dt_bias[hd];
#pragma unroll
      for (int i = 0; i < 16; ++i) {
        const float dtv = softplusf_(bf2f(dtr[i]) + db);
        y0[i] *= dtv; y1[i] *= dtv;
      }
    }
    u16* d0 = xcT + ((size_t)b * 2560 + ch0) * TS + t0;
    *reinterpret_cast<s8v*>(d0) = pack8f(y0);
    *reinterpret_cast<s8v*>(d0 + 8) = pack8f(y0 + 8);
    *reinterpret_cast<s8v*>(d0 + TS) = pack8f(y1);
    *reinterpret_cast<s8v*>(d0 + TS + 8) = pack8f(y1 + 8);
  }
}
DI void dt_item(const Params& p, int it, float* sm) {
  const int tid = tidx(), hd = tid & 31, seg = tid >> 5;
  const int c = it & 15, b = it >> 4;
  const u16* P = (const u16*)(p.ws + O_P);
  float* dtb = (float*)(p.ws + O_DT);
  float* acs = (float*)(p.ws + O_ACS);
  const float db = p.dt_bias[hd];
  const float a = -expf(p.a_log[hd]);
  const int tbase = c * 128 + seg * 16;
  float v[16], cs[16];
#pragma unroll
  for (int i = 0; i < 16; ++i) v[i] = bf2f(P[(size_t)(b * SEQ + tbase + i) * LDP + C_DT + hd]);
  float run = 0.f;
#pragma unroll
  for (int i = 0; i < 16; ++i) { v[i] = softplusf_(v[i] + db); run += v[i] * a; cs[i] = run; }
  sm[seg * 32 + hd] = run;
  __syncthreads();
  float off = 0.f;
#pragma unroll
  for (int s2 = 0; s2 < 8; ++s2) off += (s2 < seg) ? sm[s2 * 32 + hd] : 0.f;
  float* d0 = dtb + ((size_t)b * 32 + hd) * SEQ + tbase;
  float* d1 = acs + ((size_t)b * 32 + hd) * SEQ + tbase;
#pragma unroll
  for (int i = 0; i < 4; ++i) {
    f4v x0 = {v[4 * i], v[4 * i + 1], v[4 * i + 2], v[4 * i + 3]};
    f4v x1 = {cs[4 * i] + off, cs[4 * i + 1] + off, cs[4 * i + 2] + off, cs[4 * i + 3] + off};
    *reinterpret_cast<f4v*>(d0 + 4 * i) = x0;
    *reinterpret_cast<f4v*>(d1 + 4 * i) = x1;
  }
  __syncthreads();
}
DI void vtr_item(const Params& p, int it) {
  const int tid = tidx();
  const int tb = it & 31, g = (it >> 5) & 3, b = (it >> 7) % NBG, kind = it / (128 * NBG);
  const u16* P = (const u16*)(p.ws + O_P);
  u16* dst = (u16*)(p.ws + (kind ? O_VWT : O_VST));
  const int d = tid & 63, tq = tid >> 6;
  const int t0 = tb * 64 + tq * 16;
  const int col = (kind ? C_VW : C_VS) + g * 64 + d;
  s8v v0, v1;
#pragma unroll
  for (int i = 0; i < 8; ++i) {
    v0[i] = (short)P[(size_t)(b * SEQ + t0 + i) * LDP + col];
    v1[i] = (short)P[(size_t)(b * SEQ + t0 + 8 + i) * LDP + col];
  }
  u16* o = dst + (((size_t)b * 4 + g) * 64 + d) * TS + t0;
  *reinterpret_cast<s8v*>(o) = v0;
  *reinterpret_cast<s8v*>(o + 8) = v1;
}
DI void cmp_item(const Params& p, int it, u16* sm) {
  const int tid = tidx(), lane = tid & 63, w = tid >> 6, l15 = lane & 15, quad = lane >> 4;
  const int jt = it & 7, g = (it >> 3) & 3, b = (it >> 5) % NBG, kind = it / (32 * NBG);
  const u16* P = (const u16*)(p.ws + O_P);
  const u16* W1 = (const u16*)(p.ws + (kind ? O_W1V : O_W1K));
  const u16* W2 = (const u16*)(p.ws + (kind ? O_W2V : O_W2K));
  const float* posb = (const float*)(p.ws + O_POSB) + kind * 256;
  const int col0 = (kind ? C_VC : C_KC) + g * 64;
  const int j = jt * 16 + l15;
  const bool rv = j < 127;
  const u16* arow = P + (size_t)(b * SEQ + (rv ? j : 0) * 16) * LDP + col0 + quad * 8;
  f4v hid[16];
#pragma unroll
  for (int nt = 0; nt < 16; ++nt) hid[nt] = fz();
  s8v zero8 = {0, 0, 0, 0, 0, 0, 0, 0};
#define CMP_LOAD(AF, BW, K2R)                                                                        \
  do {                                                                                               \
    const int _kk = 16 * w + (((K2R) + it) & 15);                        \
    const int _l = _kk >> 1, _d0 = (_kk & 1) * 32;                                                    \
    AF = rv ? ld8(arow + (size_t)_l * LDP + _d0) : zero8;                                             \
    const u16* _wb = W1 + (size_t)l15 * 2048 + _kk * 32 + quad * 8;                                   \
    _Pragma("unroll") for (int nt = 0; nt < 16; ++nt) BW[nt] = ld8(_wb + (size_t)nt * 16 * 2048);    \
  } while (0)
#define CMP_MMA(AF, BW)                                                                              \
  do {                                                                                               \
    _Pragma("unroll") for (int nt = 0; nt < 16; ++nt) hid[nt] = MFMA16(AF, BW[nt], hid[nt]);         \
  } while (0)
  {
    s8v a0, a1, b0[16], b1[16];
    CMP_LOAD(a0, b0, 0);
#pragma unroll 1
    for (int k2r = 0; k2r < 16; k2r += 2) {
      CMP_LOAD(a1, b1, k2r + 1);
      __builtin_amdgcn_sched_barrier(0);
      CMP_MMA(a0, b0);
      __builtin_amdgcn_sched_barrier(0);
      CMP_LOAD(a0, b0, k2r + 2);
      __builtin_amdgcn_sched_barrier(0);
      CMP_MMA(a1, b1);
      __builtin_amdgcn_sched_barrier(0);
    }
  }
#undef CMP_LOAD
#undef CMP_MMA
  float* red = reinterpret_cast<float*>(sm);
#pragma unroll
  for (int nt = 0; nt < 16; ++nt)
#pragma unroll
    for (int i = 0; i < 4; ++i) red[(w * 16 + quad * 4 + i) * 260 + nt * 16 + l15] = hid[nt][i];
  __syncthreads();
  u16 hb[16];
  {
    const float pb = posb[tid];
#pragma unroll
    for (int r = 0; r < 16; ++r) {
      const float v = red[r * 260 + tid] + red[(16 + r) * 260 + tid] + red[(32 + r) * 260 + tid] + red[(48 + r) * 260 + tid] + pb;
      hb[r] = f2bf(siluf_(v));
    }
  }
  __syncthreads();
  constexpr int HS = 264;
#pragma unroll
  for (int r = 0; r < 16; ++r) sm[r * HS + tid] = hb[r];
  __syncthreads();
  f4v res = fz();
#pragma unroll
  for (int ks = 0; ks < 8; ++ks) {
    const s8v a = ld8(sm + l15 * HS + ks * 32 + quad * 8);
    const s8v bw = ld8(W2 + (size_t)(w * 16 + l15) * 256 + ks * 32 + quad * 8);
    res = MFMA16(a, bw, res);
  }
  const int d = w * 16 + l15;
  const int jb = jt * 16 + quad * 4;
  if (kind == 0) {
    u16* kc = (u16*)(p.ws + O_KCMP) + ((size_t)(b * 4 + g) * 128) * 64;
#pragma unroll
    for (int i = 0; i < 4; ++i) kc[(size_t)(jb + i) * 64 + d] = (jb + i < 127) ? f2bf(res[i]) : (u16)0;
  } else {
    u16* vc = (u16*)(p.ws + O_VCT) + ((size_t)(b * 4 + g) * 64 + d) * 128 + jb;
    st4bf(vc, res[0], res[1], res[2], (jb + 3 < 127) ? res[3] : 0.f);
  }
  __syncthreads();
}

DI int q_next(unsigned* ctr) {
  __shared__ int q_slot;
  if (tidx() == 0) q_slot = (int)atomicAdd(ctr, 1u);
  __syncthreads();
  const int it = q_slot;
  __syncthreads();
  return it;
}
DI unsigned* q_counter(const Params& p, int pass, int phase, int rep) {
  return (unsigned*)(p.ws + O_BAR) + 3520 + 8 * (((pass * 4 + phase) * 2) + rep);
}

DI void phaseD(const Params& p, u16* smem, int sub, int pass, int rep) {
  constexpr int N_CMP = 2 * NBG * 32, N_CONV = NBG * 128 * 6, N_VTR = 2 * NBG * 128, N_DT = NBG * 16;
  constexpr int E1 = N_CONV, E2 = E1 + N_VTR, E3 = E2 + N_DT;
  const int ncb = ((int)gridDim.x >= 2 * N_CMP) ? N_CMP : 0;
  constexpr int TAIL = 320;
  int lo, hi, start, step;
  if (ncb == 0) {
    for (int it = blockIdx.x; it < N_CMP; it += gridDim.x)
      if (sub == 0 || sub == 1) cmp_item(p, it, smem);
    lo = 0; hi = E3; start = blockIdx.x; step = gridDim.x;
  } else if ((int)blockIdx.x < ncb) {
    if (sub == 0 || sub == 1) cmp_item(p, blockIdx.x, smem);
    lo = E3 - TAIL; hi = E3; start = lo + blockIdx.x; step = ncb;
  } else {
    lo = 0; hi = E3 - TAIL; start = (int)blockIdx.x - ncb; step = (int)gridDim.x - ncb;
  }
  for (int it = start; it < hi; it += step) {
    if (it < E1) { if (sub == 0 || sub == 2) conv_item(p, it); }
    else if (it < E2) { if (sub == 0 || sub == 3) vtr_item(p, it - E1); }
    else { if (sub == 0 || sub == 3) dt_item(p, it - E2, (float*)smem); }
  }
}

DI void ssd_item(const Params& p, int it, u16* sm) {
  const int tid = tidx(), lane = tid & 63, w = tid >> 6, l15 = lane & 15, quad = lane >> 4;
  const int qr = (it >> 3) & 3, cgx = ((it >> 5) << 3) | (it & 7);
  const int g = cgx & 3, c = (cgx >> 2) & 15, b = cgx >> 6;
  const int t0 = c * 128;
  const u16* xc = (const u16*)(p.ws + O_XC);
  const u16* xcT = (const u16*)(p.ws + O_XCT);
  const float* acsb = (const float*)(p.ws + O_ACS);
  const float* dtb = (const float*)(p.ws + O_DT);
  u16* yd = (u16*)(p.ws + O_YD);
  u16* stb = (u16*)(p.ws + O_ST);
  const u16* Bbase = xc + (size_t)(b * SEQ + t0) * 3072 + 2048 + g * 128;
  const u16* Cbase = xc + (size_t)(b * SEQ + t0) * 3072 + 2560 + g * 128;
  const u16* BT = xcT + ((size_t)b * 2560 + 2048 + g * 128) * TS + t0;
  const int h0 = g * 8 + qr * 2;
  constexpr int LS = 136;
  u16* Bs = sm;
  u16* Xs = sm + 128 * LS;
  float* As = reinterpret_cast<float*>(sm + 256 * LS);
  {
    s8v rb[8], rx[8];
#pragma unroll
    for (int r = 0; r < 8; ++r) {
      const int idx = tid + 256 * r, row = idx >> 4, seg = idx & 15;
      rb[r] = ld8(Bbase + (size_t)row * 3072 + seg * 8);
      rx[r] = ld8(xcT + ((size_t)b * 2560 + h0 * 64 + row) * TS + t0 + seg * 8);
    }
#pragma unroll
    for (int r = 0; r < 8; ++r) {
      const int idx = tid + 256 * r, row = idx >> 4, seg = idx & 15;
      *reinterpret_cast<s8v*>(Bs + row * LS + seg * 8) = rb[r];
      *reinterpret_cast<s8v*>(Xs + row * LS + seg * 8) = rx[r];
    }
    As[tid] = acsb[((size_t)b * 32 + h0 + (tid >> 7)) * SEQ + t0 + (tid & 127)];
  }
  __syncthreads();

#pragma unroll 1
  for (int li = 0; li < 2; ++li) {
    const int lt = li ? 7 - w : w;
    const int l = 16 * lt + l15;
    s8v cf[4];
#pragma unroll
    for (int ks = 0; ks < 4; ++ks) cf[ks] = ld8(Cbase + (size_t)l * 3072 + ks * 32 + quad * 8);
    f4v y[2][4];
#pragma unroll
    for (int hh = 0; hh < 2; ++hh)
#pragma unroll
      for (int pt = 0; pt < 4; ++pt) y[hh][pt] = fz();
    float acl[2];
#pragma unroll
    for (int hh = 0; hh < 2; ++hh) acl[hh] = As[hh * 128 + l];
    const int spn = lt >> 1;
    for (int sp = 0; sp <= spn; ++sp) {
      f4v cb[2];
#pragma unroll
      for (int si = 0; si < 2; ++si) {
        cb[si] = fz();
#pragma unroll
        for (int ks = 0; ks < 4; ++ks)
          cb[si] = MFMA16(ld8(Bs + (32 * sp + 16 * si + l15) * LS + ks * 32 + quad * 8), cf[ks], cb[si]);
      }
#pragma unroll
      for (int hh = 0; hh < 2; ++hh) {
        const float* ah = As + hh * 128;
        const f4v as0 = ldf4(ah + 32 * sp + quad * 4);
        const f4v as1 = ldf4(ah + 32 * sp + 16 + quad * 4);
        f4v m0, m1;
#pragma unroll
        for (int i = 0; i < 4; ++i) {
          const int s0 = 32 * sp + quad * 4 + i, s1 = s0 + 16;
          m0[i] = (s0 <= l) ? cb[0][i] * __expf(acl[hh] - as0[i]) : 0.f;
          m1[i] = (s1 <= l) ? cb[1][i] * __expf(acl[hh] - as1[i]) : 0.f;
        }
        const s8v pb = pack8(m0, m1);
#pragma unroll
        for (int pt = 0; pt < 4; ++pt) {
          const u16* xr = Xs + (hh * 64 + 16 * pt + l15) * LS + 32 * sp + quad * 4;
          y[hh][pt] = MFMA16(cat44(ld4(xr), ld4(xr + 16)), pb, y[hh][pt]);
        }
      }
    }
#pragma unroll
    for (int hh = 0; hh < 2; ++hh) {
      const float dinv = p.d_skip[h0 + hh] / dtb[((size_t)b * 32 + h0 + hh) * SEQ + t0 + l];
#pragma unroll
      for (int pt = 0; pt < 4; ++pt) {
#pragma unroll
        for (int i = 0; i < 4; ++i) y[hh][pt][i] += dinv * bf2f(Xs[(hh * 64 + 16 * pt + 4 * quad + i) * LS + l]);
      }
      u16* yrow = yd + (size_t)(b * SEQ + t0 + l) * 2048 + (h0 + hh) * 64;
      st8bf_pair(yrow, y[hh][0], y[hh][1], quad);
      st8bf_pair(yrow + 32, y[hh][2], y[hh][3], quad);
    }
  }
#pragma unroll 1
  for (int hh = 0; hh < 2; ++hh) {
    const int hd = h0 + hh;
    const float* ah = As + hh * 128;
    const float alast = ah[127];
    f4v st[2][4];
#pragma unroll
    for (int ni = 0; ni < 2; ++ni)
#pragma unroll
      for (int pt = 0; pt < 4; ++pt) st[ni][pt] = fz();
    s8v bt[4][2];
#pragma unroll
    for (int ks = 0; ks < 4; ++ks)
#pragma unroll
      for (int ni = 0; ni < 2; ++ni) bt[ks][ni] = ld8(BT + (size_t)(16 * (2 * w + ni) + l15) * TS + ks * 32 + quad * 8);
    __builtin_amdgcn_sched_barrier(0);
#pragma unroll
    for (int ks = 0; ks < 4; ++ks) {
      const f4v a0 = ldf4(ah + ks * 32 + quad * 8), a1 = ldf4(ah + ks * 32 + quad * 8 + 4);
      float wl[8];
#pragma unroll
      for (int j = 0; j < 4; ++j) { wl[j] = __expf(alast - a0[j]); wl[4 + j] = __expf(alast - a1[j]); }
#pragma unroll
      for (int pt = 0; pt < 4; ++pt) {
        const s8v raw = ld8(Xs + (hh * 64 + 16 * pt + l15) * LS + ks * 32 + quad * 8);
        float xf[8];
#pragma unroll
        for (int j = 0; j < 8; ++j) xf[j] = bfs(raw[j]) * wl[j];
        const s8v xw = pack8f(xf);
        st[0][pt] = MFMA16(bt[ks][0], xw, st[0][pt]);
        st[1][pt] = MFMA16(bt[ks][1], xw, st[1][pt]);
      }
    }
    u16* so = stb + (((size_t)(b * 16 + c) * 32 + hd) * 64) * 128;
#pragma unroll
    for (int pt = 0; pt < 4; ++pt) st8bf_pair(so + (size_t)(16 * pt + l15) * 128 + 32 * w, st[0][pt], st[1][pt], quad);
  }
  __syncthreads();
}

DI void cmpattn_item(const Params& p, int it, unsigned char* smraw) {
  const int tid = tidx(), lane = tid & 63, w = tid >> 6, l15 = lane & 15, quad = lane >> 4;
  const int tq2 = it & 63, g = (it >> 6) & 3, b = it >> 8;
  const int H = g * 4 + w;
  const float slope = exp2f(-0.5f * (float)(H + 1));
  const u16* P = (const u16*)(p.ws + O_P);
  const u16* kcg = (const u16*)(p.ws + O_KCMP) + (size_t)(b * 4 + g) * 128 * 64;
  const u16* vcg = (const u16*)(p.ws + O_VCT) + (size_t)(b * 4 + g) * 64 * 128;
  constexpr int KS = 72, VS = 136;
  u16* kcs = reinterpret_cast<u16*>(smraw);
  u16* vcs = kcs + 128 * KS;
  float* impA = reinterpret_cast<float*>(smraw + 36864);
  float* impB = impA + 2048;
  float* scl = impB + 2112;
  {
    s8v r0[4], r1[4];
#pragma unroll
    for (int r = 0; r < 4; ++r) {
      const int idx = tid + 256 * r;
      r0[r] = ld8(kcg + (size_t)(idx >> 3) * 64 + (idx & 7) * 8);
      r1[r] = ld8(vcg + (size_t)(idx >> 4) * 128 + (idx & 15) * 8);
    }
#pragma unroll
    for (int r = 0; r < 4; ++r) {
      const int idx = tid + 256 * r;
      *reinterpret_cast<s8v*>(kcs + (idx >> 3) * KS + (idx & 7) * 8) = r0[r];
      *reinterpret_cast<s8v*>(vcs + (idx >> 4) * VS + (idx & 15) * 8) = r1[r];
    }
  }
  __syncthreads();
#pragma unroll 1
  for (int sub = 0; sub < 2; ++sub) {
    const int q0 = tq2 * 32 + sub * 16;
    const int njt = (q0 >= 16) ? (((q0 - 16) >> 8) + 1) : 0;
    const int t = q0 + l15;
    const size_t trow = (size_t)(b * SEQ + t);
    s8v qf[2];
    qf[0] = ld8(P + trow * LDP + C_Q + H * 64 + quad * 8);
    qf[1] = ld8(P + trow * LDP + C_Q + H * 64 + 32 + quad * 8);
    f4v s[8];
#pragma unroll
    for (int jt = 0; jt < 8; ++jt) {
      s[jt] = fz();
      if (jt < njt) {
#pragma unroll
        for (int ks = 0; ks < 2; ++ks) s[jt] = MFMA16(ld8(kcs + (16 * jt + l15) * KS + ks * 32 + quad * 8), qf[ks], s[jt]);
      }
    }
    float mx = NEGB;
#pragma unroll
    for (int jt = 0; jt < 8; ++jt)
#pragma unroll
      for (int i = 0; i < 4; ++i) {
        const int j = 16 * jt + 4 * quad + i;
        const int dist = t - (16 * j + 31);
        const float sc = (dist >= 0) ? s[jt][i] * 0.125f - slope * (float)dist : NEGB;
        s[jt][i] = sc;
        mx = fmaxf(mx, sc);
      }
    mx = qmax(mx);
    float lsum = 0.f;
#pragma unroll
    for (int jt = 0; jt < 8; ++jt)
#pragma unroll
      for (int i = 0; i < 4; ++i) {
        const float e = (s[jt][i] > -1e29f) ? __expf(s[jt][i] - mx) : 0.f;
        s[jt][i] = e;
        lsum += e;
      }
    lsum = qsum(lsum);
    const float inv = lsum > 0.f ? 1.f / lsum : 0.f;
#pragma unroll
    for (int jt = 0; jt < 8; ++jt) {
      s[jt] = s[jt] * inv;
      const int k = 4 * jt + quad;
      impA[(w * 16 + l15) * 32 + k] = s[jt][0] + s[jt][1] + s[jt][2] + 0.5f * s[jt][3];
      impB[(w * 16 + l15) * 33 + k + 1] = 0.5f * s[jt][3];
    }
    f4v oc[4];
#pragma unroll
    for (int dt = 0; dt < 4; ++dt) oc[dt] = fz();
#pragma unroll
    for (int kp = 0; kp < 4; ++kp) {
      if (2 * kp < njt) {
        const s8v pb = pack8(s[2 * kp], s[2 * kp + 1]);
#pragma unroll
        for (int dt = 0; dt < 4; ++dt) {
          const u16* vr = vcs + (16 * dt + l15) * VS + 32 * kp + quad * 4;
          oc[dt] = MFMA16(cat44(ld4(vr), ld4(vr + 16)), pb, oc[dt]);
        }
      }
    }
    {
      const float g0 = sigmoidf_(bf2f(P[trow * LDP + C_G + H * 3 + 0]));
      u16* oo = (u16*)(p.ws + O_OCMP) + trow * 1024 + H * 64 + quad * 4;
#pragma unroll
      for (int dt = 0; dt < 4; ++dt) st4bf(oo + 16 * dt, oc[dt][0] * g0, oc[dt][1] * g0, oc[dt][2] * g0, oc[dt][3] * g0);
    }
    __syncthreads();
#pragma unroll
    for (int r = 0; r < 2; ++r) {
      const int idx = tid + 256 * r, q = idx >> 5, k = idx & 31;
      float im = 0.f;
#pragma unroll
      for (int hh = 0; hh < 4; ++hh) {
        im += impA[(hh * 16 + q) * 32 + k];
        if (k > 0) im += impB[(hh * 16 + q) * 33 + k];
      }
      const int blk = (q0 + q) >> 6;
      const bool forced = (k == 0) | (k == blk) | (k == blk - 1);
      scl[q * 32 + k] = forced ? im + 1000.f : ((k <= blk) ? im : -1.f);
    }
    __syncthreads();
    unsigned* sel = (unsigned*)(p.ws + O_SEL) + (size_t)(b * 4 + g) * SEQ + q0;
#pragma unroll
    for (int r = 0; r < 2; ++r) {
      const int idx = tid + 256 * r, q = idx >> 5, k = idx & 31;
      const float me = scl[q * 32 + k];
      int cnt = 0;
#pragma unroll
      for (int k2 = 0; k2 < 32; ++k2) {
        const float o = scl[q * 32 + k2];
        cnt += (o > me || (o == me && k2 < k)) ? 1 : 0;
      }
      const unsigned long long bal = __ballot(cnt < 16);
      if (k == 0) sel[q] = (unsigned)(bal >> (32 * (lane >> 5)));
    }
    __syncthreads();
  }
}

DI void phaseE(const Params& p, float* smf, int sub, int pass, int rep) {
  constexpr int N_SSD = NBG * 256;
  for (int it = blockIdx.x; it < N_SSD; it += gridDim.x) ssd_item(p, it, (u16*)smf);
}

DI void scan_item(const Params& p, int it) {
  const int gid = it * 256 + tidx();
  const int e = gid & 1023, hd = (gid >> 10) & 31, b = gid >> 15;
  u16* stb = (u16*)(p.ws + O_ST);
  const float* acs = (const float*)(p.ws + O_ACS) + ((size_t)b * 32 + hd) * SEQ;
  float carry[8];
#pragma unroll
  for (int j = 0; j < 8; ++j) carry[j] = 0.f;
  s8v sv[16];
  float dec[16];
#pragma unroll
  for (int c = 0; c < 16; ++c) {
    sv[c] = ld8(stb + (((size_t)(b * 16 + c) * 32 + hd) * 8192) + e * 8);
    dec[c] = acs[c * 128 + 127];
  }
#pragma unroll
  for (int c = 0; c < 16; ++c) {
    u16* ptr = stb + (((size_t)(b * 16 + c) * 32 + hd) * 8192) + e * 8;
    const float dc = __expf(dec[c]);
    const s8v pv = pack8f(carry);
#pragma unroll
    for (int j = 0; j < 8; ++j) carry[j] = carry[j] * dc + bfs(sv[c][j]);
    *reinterpret_cast<s8v*>(ptr) = pv;
  }
}

template <bool WIN, bool MASKED>
DI void attn_tile(const u16* Kt, const u16* Vt, const s8v (&qf)[2], const f4v (&cb)[4], int t, int kb, int q0, bool selb,
                  float slope2, float& m, float& l, f4v (&o)[4]) {
  const int lane = tidx() & 63, l15 = lane & 15, quad = lane >> 4;
  constexpr int LS = 72;
  const float bkb = slope2 * (float)(64 * kb - q0);
  f4v s[4];
#pragma unroll
  for (int kt = 0; kt < 4; ++kt) {
    s[kt] = cb[kt] + bkb;
    const u16* kr = Kt + (16 * kt + l15) * LS + quad * 8;
    s[kt] = MFMA16(ld8(kr), qf[0], s[kt]);
    s[kt] = MFMA16(ld8(kr + 32), qf[1], s[kt]);
  }
  if (MASKED) {
    const int dd0 = t - (64 * kb + 4 * quad);
#pragma unroll
    for (int kt = 0; kt < 4; ++kt)
#pragma unroll
      for (int i = 0; i < 4; ++i) {
        const int dd = dd0 - (16 * kt + i);
        const bool ok = WIN ? ((unsigned)dd < 512u) : (selb && dd >= 0);
        s[kt][i] = ok ? s[kt][i] : NEGB;
      }
  }
  float mx = fmaxf(fmaxf(fmaxf(s[0][0], s[0][1]), fmaxf(s[0][2], s[0][3])), fmaxf(fmaxf(s[1][0], s[1][1]), fmaxf(s[1][2], s[1][3])));
  mx = fmaxf(mx, fmaxf(fmaxf(fmaxf(s[2][0], s[2][1]), fmaxf(s[2][2], s[2][3])), fmaxf(fmaxf(s[3][0], s[3][1]), fmaxf(s[3][2], s[3][3]))));
  mx = qmax(mx);
  if (__ballot(mx > m + 6.f) != 0ull) {
    const float mn = fmaxf(m, mx);
    const float alpha = __builtin_amdgcn_exp2f(m - mn);
    m = mn;
    l *= alpha;
#pragma unroll
    for (int dt = 0; dt < 4; ++dt) o[dt] = o[dt] * alpha;
  }
  float ps = 0.f;
#pragma unroll
  for (int kt = 0; kt < 4; ++kt)
#pragma unroll
    for (int i = 0; i < 4; ++i) {
      float e = __builtin_amdgcn_exp2f(s[kt][i] - m);
      if (MASKED) e = (s[kt][i] > -1e29f) ? e : 0.f;
      s[kt][i] = e;
      ps += e;
    }
  l += ps;
#pragma unroll
  for (int kp = 0; kp < 2; ++kp) {
    const s8v pb = pack8(s[2 * kp], s[2 * kp + 1]);
#pragma unroll
    for (int dt = 0; dt < 4; ++dt) {
      const u16* vr = Vt + (16 * dt + l15) * LS + 32 * kp + quad * 4;
      o[dt] = MFMA16(cat44(ld4(vr), ld4(vr + 16)), pb, o[dt]);
    }
  }
}

template <bool WIN, int AV>
DI void attn_pass(const u16* __restrict__ Kbase  , const u16* __restrict__ VT  ,
                  const s8v (&qf)[2], const f4v (&cb)[4], int t, int q0, unsigned mymask, float slope2, unsigned tiles, f4v (&o)[4],
                  float& lout, u16* sm) {
  const int tid = tidx();
  constexpr int LS = 72, TB = 64 * LS;
  const int lrow = tid >> 3, lseg = tid & 7;
  const int blk = q0 >> 6;
  float m = NEGB, l = 0.f;
#pragma unroll
  for (int dt = 0; dt < 4; ++dt) o[dt] = fz();
  const u16* kp0 = Kbase + (size_t)lrow * LDP + lseg * 8;
  const u16* vp0 = VT + (size_t)lrow * TS + lseg * 8;
#define AT_LOAD(RK, RV, KB)                                                            \
  do {                                                                                 \
    RK[0] = ld8(kp0 + (size_t)(64 * (KB)) * LDP);                                       \
    RK[1] = ld8(kp0 + (size_t)(64 * (KB) + 32) * LDP);                                  \
    RV[0] = ld8(vp0 + 64 * (KB));                                                       \
    RV[1] = ld8(vp0 + (size_t)32 * TS + 64 * (KB));                                    \
  } while (0)
#define AT_STORE(RK, RV, BUF)                                                          \
  do {                                                                                 \
    u16* _d = sm + (BUF) * 2 * TB + lrow * LS + lseg * 8;                               \
    *reinterpret_cast<s8v*>(_d) = RK[0];                                                \
    *reinterpret_cast<s8v*>(_d + 32 * LS) = RK[1];                                      \
    *reinterpret_cast<s8v*>(_d + TB) = RV[0];                                           \
    *reinterpret_cast<s8v*>(_d + TB + 32 * LS) = RV[1];                                 \
  } while (0)
#define AT_POPL() do { if (tl) { kbl = 31 - __builtin_clz(tl); tl &= ~(1u << kbl); } } while (0)
#define AT_STEP(RK, RV)                                                                                              \
  {                                                                                                                  \
    const int kb = 31 - __builtin_clz(tc);                                                                            \
    tc &= ~(1u << kb);                                                                                                \
    const u16* Kt = sm + cur * 2 * TB;                                                                                \
    const bool selb = WIN ? true : (((mymask >> kb) & 1u) != 0u);                                                     \
    const bool need = WIN ? ((kb == blk) || (64 * kb <= q0 - 497)) : ((kb == blk) || (__ballot(selb) != ~0ull));      \
    if (AV != 2) {                                                                                                    \
    if (need) attn_tile<WIN, true>(Kt, Kt + TB, qf, cb, t, kb, q0, selb, slope2, m, l, o);                            \
    else attn_tile<WIN, false>(Kt, Kt + TB, qf, cb, t, kb, q0, selb, slope2, m, l, o);                                \
    }                                                                                                                 \
    if (AV != 1) {                                                                                                    \
    if (tc) AT_STORE(RK, RV, cur ^ 1);                                                                                \
    AT_POPL();                                                                                                        \
    AT_LOAD(RK, RV, kbl);                                                                                             \
    }                                                                                                                 \
    __syncthreads();                                                                                                  \
    if (!tc) break;                                                                                                   \
    cur ^= 1;                                                                                                         \
  }
  unsigned tc = tiles, tl = tiles;
  s8v ak[2], av[2], bk[2], bv[2];
  int kbl = 0;
  AT_POPL();
  AT_LOAD(ak, av, kbl);
  AT_STORE(ak, av, 0);
  AT_POPL();
  AT_LOAD(ak, av, kbl);
  AT_POPL();
  AT_LOAD(bk, bv, kbl);
  __syncthreads();
  int cur = 0;
  while (true) {
    AT_STEP(ak, av)
    AT_STEP(bk, bv)
  }
#undef AT_LOAD
#undef AT_STORE
#undef AT_POPL
#undef AT_STEP
  lout = qsum(l);
}

DI void cmp_part(const Params& p, int b, int g, int q0, const s8v (&qf)[2], unsigned char* smraw, f4v (&oc)[4], unsigned& mymask) {
  const int tid = tidx(), lane = tid & 63, w = tid >> 6, l15 = lane & 15, quad = lane >> 4;
  const int H = g * 4 + w;
  const float slope = exp2f(-0.5f * (float)(H + 1));
  const u16* P = (const u16*)(p.ws + O_P);
  const u16* kcg = (const u16*)(p.ws + O_KCMP) + (size_t)(b * 4 + g) * 128 * 64;
  const u16* vcg = (const u16*)(p.ws + O_VCT) + (size_t)(b * 4 + g) * 64 * 128;
  constexpr int KS = 72, VS = 136;
  u16* kcs = reinterpret_cast<u16*>(smraw);
  u16* vcs = kcs + 128 * KS;
  float* impA = reinterpret_cast<float*>(smraw + 36864);
  float* impB = impA + 2048;
  float* scl = impB + 2112;
  unsigned* selm = reinterpret_cast<unsigned*>(scl + 512);
  const int njt = (q0 >= 16) ? (((q0 - 16) >> 8) + 1) : 0;
  {
    s8v r0[4], r1[4];
#pragma unroll
    for (int r = 0; r < 4; ++r) {
      const int idx = tid + 256 * r;
      r0[r] = ld8(kcg + (size_t)(idx >> 3) * 64 + (idx & 7) * 8);
      r1[r] = ld8(vcg + (size_t)(idx >> 4) * 128 + (idx & 15) * 8);
    }
#pragma unroll
    for (int r = 0; r < 4; ++r) {
      const int idx = tid + 256 * r;
      *reinterpret_cast<s8v*>(kcs + (idx >> 3) * KS + (idx & 7) * 8) = r0[r];
      *reinterpret_cast<s8v*>(vcs + (idx >> 4) * VS + (idx & 15) * 8) = r1[r];
    }
  }
  __syncthreads();
  const int t = q0 + l15;
  const size_t trow = (size_t)(b * SEQ + t);
  f4v s[8];
#pragma unroll
  for (int jt = 0; jt < 8; ++jt) {
    s[jt] = fz();
    if (jt < njt) {
#pragma unroll
      for (int ks = 0; ks < 2; ++ks) s[jt] = MFMA16(ld8(kcs + (16 * jt + l15) * KS + ks * 32 + quad * 8), qf[ks], s[jt]);
    }
  }
  float mx = NEGB;
#pragma unroll
  for (int jt = 0; jt < 8; ++jt)
#pragma unroll
    for (int i = 0; i < 4; ++i) {
      const int j = 16 * jt + 4 * quad + i;
      const int dist = t - (16 * j + 31);
      const float sc = (dist >= 0) ? s[jt][i] * 0.125f - slope * (float)dist : NEGB;
      s[jt][i] = sc;
      mx = fmaxf(mx, sc);
    }
  mx = qmax(mx);
  float lsum = 0.f;
#pragma unroll
  for (int jt = 0; jt < 8; ++jt)
#pragma unroll
    for (int i = 0; i < 4; ++i) {
      const float e = (s[jt][i] > -1e29f) ? __expf(s[jt][i] - mx) : 0.f;
      s[jt][i] = e;
      lsum += e;
    }
  lsum = qsum(lsum);
  const float inv = lsum > 0.f ? 1.f / lsum : 0.f;
#pragma unroll
  for (int jt = 0; jt < 8; ++jt) {
    s[jt] = s[jt] * inv;
    const int k = 4 * jt + quad;
    impA[(w * 16 + l15) * 32 + k] = s[jt][0] + s[jt][1] + s[jt][2] + 0.5f * s[jt][3];
    impB[(w * 16 + l15) * 33 + k + 1] = 0.5f * s[jt][3];
  }
#pragma unroll
  for (int dt = 0; dt < 4; ++dt) oc[dt] = fz();
#pragma unroll
  for (int kp = 0; kp < 4; ++kp) {
    if (2 * kp < njt) {
      const s8v pb = pack8(s[2 * kp], s[2 * kp + 1]);
#pragma unroll
      for (int dt = 0; dt < 4; ++dt) {
        const u16* vr = vcs + (16 * dt + l15) * VS + 32 * kp + quad * 4;
        oc[dt] = MFMA16(cat44(ld4(vr), ld4(vr + 16)), pb, oc[dt]);
      }
    }
  }
  {
    const float g0 = sigmoidf_(bf2f(P[trow * LDP + C_G + H * 3 + 0]));
#pragma unroll
    for (int dt = 0; dt < 4; ++dt) oc[dt] = oc[dt] * g0;
  }
  __syncthreads();
#pragma unroll
  for (int r = 0; r < 2; ++r) {
    const int idx = tid + 256 * r, q = idx >> 5, k = idx & 31;
    float im = 0.f;
#pragma unroll
    for (int hh = 0; hh < 4; ++hh) {
      im += impA[(hh * 16 + q) * 32 + k];
      if (k > 0) im += impB[(hh * 16 + q) * 33 + k];
    }
    const int blk = (q0 + q) >> 6;
    const bool forced = (k == 0) | (k == blk) | (k == blk - 1);
    scl[q * 32 + k] = forced ? im + 1000.f : ((k <= blk) ? im : -1.f);
  }
  __syncthreads();
#pragma unroll
  for (int r = 0; r < 2; ++r) {
    const int idx = tid + 256 * r, q = idx >> 5, k = idx & 31;
    const float me = scl[q * 32 + k];
    int cnt = 0;
#pragma unroll
    for (int k2 = 0; k2 < 32; ++k2) {
      const float o = scl[q * 32 + k2];
      cnt += (o > me || (o == me && k2 < k)) ? 1 : 0;
    }
    const unsigned long long bal = __ballot(cnt < 16);
    if (k == 0) selm[q] = (unsigned)(bal >> (32 * (lane >> 5)));
  }
  __syncthreads();
  mymask = selm[l15];
  __syncthreads();
}

template <int AV>
DI void attn_item(const Params& p, int it, u16* sm) {
  const int tid = tidx(), lane = tid & 63, w = tid >> 6, l15 = lane & 15, quad = lane >> 4;
  const int tq = it & 127, g = (it >> 7) & 3, b = it >> 9;
  const int q0 = tq * 16;
  const int H = g * 4 + w;
  const float slope2 = exp2f(-0.5f * (float)(H + 1)) * 1.4426950408889634f;
  constexpr float SCALE2 = 0.125f * 1.4426950408889634f;
  const u16* P = (const u16*)(p.ws + O_P);
  const int t = q0 + l15;
  const size_t trow = (size_t)(b * SEQ + t);
  s8v qf[2], qraw[2];
#pragma unroll
  for (int ks = 0; ks < 2; ++ks) {
    const s8v raw = ld8(P + trow * LDP + C_Q + H * 64 + ks * 32 + quad * 8);
    qraw[ks] = raw;
    float qs[8];
#pragma unroll
    for (int j = 0; j < 8; ++j) qs[j] = bfs(raw[j]) * SCALE2;
    qf[ks] = pack8f(qs);
  }
  f4v ocm[4];
  unsigned mymask;
  cmp_part(p, b, g, q0, qraw, reinterpret_cast<unsigned char*>(sm), ocm, mymask);
  f4v cb[4];
#pragma unroll
  for (int kt = 0; kt < 4; ++kt)
#pragma unroll
    for (int i = 0; i < 4; ++i) cb[kt][i] = slope2 * (float)(16 * kt + 4 * quad + i);
  const int blk = q0 >> 6;
  const unsigned upto = (blk >= 31) ? 0xffffffffu : ((2u << blk) - 1u);
  unsigned um = mymask;
#pragma unroll
  for (int o = 1; o < 64; o <<= 1) um |= (unsigned)__shfl_xor((int)um, o);
  um = (unsigned)__builtin_amdgcn_readfirstlane((int)(um & upto));
  f4v os[4], ow[4];
  float ls, lw;
  attn_pass<false, AV>(P + (size_t)(b * SEQ) * LDP + C_KS + g * 64, (const u16*)(p.ws + O_VST) + (size_t)(b * 4 + g) * 64 * TS, qf, cb, t,
                   q0, mymask, slope2, um, os, ls, sm);
  const int wlo = (q0 - 511 > 0 ? q0 - 511 : 0) >> 6;
  const unsigned wm_ = (unsigned)__builtin_amdgcn_readfirstlane((int)(upto & ~((1u << wlo) - 1u)));
  attn_pass<true, AV>(P + (size_t)(b * SEQ) * LDP + C_KW + g * 64, (const u16*)(p.ws + O_VWT) + (size_t)(b * 4 + g) * 64 * TS, qf, cb, t,
                  q0, 0u, slope2, wm_, ow, lw, sm);
  if (AV != 0) { if (ls + lw + os[0][0] + ow[3][3] != 12345.678f) return; }
  const float g1 = sigmoidf_(bf2f(P[trow * LDP + C_G + H * 3 + 1])) / ls;
  const float g2 = sigmoidf_(bf2f(P[trow * LDP + C_G + H * 3 + 2])) / lw;
  const u16* za = P + trow * LDP + C_ZA + H * 64;
  u16* oo = (u16*)(p.ws + O_O) + trow * 1024 + H * 64;
  f4v rr[4];
  s4v zq[4];
  ld8bf_pair(za, quad, zq[0], zq[1]);
  ld8bf_pair(za + 32, quad, zq[2], zq[3]);
#pragma unroll
  for (int dt = 0; dt < 4; ++dt) {
#pragma unroll
    for (int i = 0; i < 4; ++i) rr[dt][i] = (ocm[dt][i] + g1 * os[dt][i] + g2 * ow[dt][i]) * siluf_(bfs(zq[dt][i]));
  }
  st8bf_pair(oo, rr[0], rr[1], quad);
  st8bf_pair(oo + 32, rr[2], rr[3], quad);
}

DI void phaseF(const Params& p, bool noscan, u16* sm, int pass, int rep) {
  constexpr int N_SC = NBG * 32 * 1024 / 256;
  const int xq = blockIdx.x & 7, lbq = blockIdx.x >> 3, nl = (int)gridDim.x >> 3;
  unsigned* ctr = q_counter(p, pass, 2, rep) + xq;
  const int nend = noscan ? 128 : 128 + N_SC / 8;
  bool first = true;
  while (true) {
    const int j = first ? lbq : q_next(ctr) + nl;
    first = false;
    if (j >= nend) break;
    if (j < 128) attn_item<0>(p, (xq >> 2) * 512 + (xq & 3) * 128 + (127 - j), sm);
    else scan_item(p, (j - 128) * 8 + xq);
  }
}

DI void phaseG(const Params& p, float* smf) {
  const int tid = tidx(), lane = tid & 63, w = tid >> 6, l15 = lane & 15, quad = lane >> 4;
  const u16* xc = (const u16*)(p.ws + O_XC);
  const u16* P = (const u16*)(p.ws + O_P);
  const u16* yd = (const u16*)(p.ws + O_YD);
  const u16* stb = (const u16*)(p.ws + O_ST);
  const float* acsb = (const float*)(p.ws + O_ACS);
  u16* yn = (u16*)(p.ws + O_YN);
  for (int it = blockIdx.x; it < NBG * 256; it += gridDim.x) {
    const int lq = (it >> 3) & 3, cgx = ((it >> 5) << 3) | (it & 7);
    const int g = cgx & 3, c = (cgx >> 2) & 15, b = cgx >> 6;
    const int t0 = b * SEQ + c * 128 + 32 * lq + l15;
    s8v cf[2][4];
#pragma unroll
    for (int li = 0; li < 2; ++li)
#pragma unroll
      for (int ks = 0; ks < 4; ++ks) cf[li][ks] = ld8(xc + (size_t)(t0 + 16 * li) * 3072 + 2560 + g * 128 + ks * 32 + quad * 8);
    f4v y[2][4][2];
    f4v* park = reinterpret_cast<f4v*>(smf + 1024);
    float ss[2] = {0.f, 0.f};
#pragma unroll
    for (int hh = 0; hh < 2; ++hh) {
      const int hd = g * 8 + 2 * w + hh;
      const u16* pv = stb + (((size_t)(b * 16 + c) * 32 + hd) * 64) * 128;
      s8v pf[4][4];
      s4v d4[4], z4[4];
#pragma unroll
      for (int pt = 0; pt < 4; ++pt) {
#pragma unroll
        for (int ks = 0; ks < 4; ++ks) pf[pt][ks] = ld8(pv + (size_t)(16 * pt + l15) * 128 + ks * 32 + quad * 8);
      }
#pragma unroll
      for (int pp = 0; pp < 2; ++pp) {
        ld8bf_pair(yd + (size_t)t0 * 2048 + hd * 64 + 32 * pp, quad, d4[2 * pp], d4[2 * pp + 1]);
        ld8bf_pair(P + (size_t)t0 * LDP + C_Z + hd * 64 + 32 * pp, quad, z4[2 * pp], z4[2 * pp + 1]);
      }
      float ea[2];
#pragma unroll
      for (int li = 0; li < 2; ++li) ea[li] = __expf(acsb[((size_t)b * 32 + hd) * SEQ + (t0 + 16 * li - b * SEQ)]);
      __builtin_amdgcn_sched_barrier(0);
#pragma unroll
      for (int pt = 0; pt < 4; ++pt) {
        y[hh][pt][0] = fz(); y[hh][pt][1] = fz();
#pragma unroll
        for (int ks = 0; ks < 4; ++ks) {
          y[hh][pt][0] = MFMA16(pf[pt][ks], cf[0][ks], y[hh][pt][0]);
          y[hh][pt][1] = MFMA16(pf[pt][ks], cf[1][ks], y[hh][pt][1]);
        }
      }
      __builtin_amdgcn_sched_barrier(0);
      s4v d5[4], z5[4];
#pragma unroll
      for (int pp = 0; pp < 2; ++pp) {
        ld8bf_pair(yd + (size_t)(t0 + 16) * 2048 + hd * 64 + 32 * pp, quad, d5[2 * pp], d5[2 * pp + 1]);
        ld8bf_pair(P + (size_t)(t0 + 16) * LDP + C_Z + hd * 64 + 32 * pp, quad, z5[2 * pp], z5[2 * pp + 1]);
      }
      __builtin_amdgcn_sched_barrier(0);
#pragma unroll
      for (int pt = 0; pt < 4; ++pt)
#pragma unroll
        for (int i = 0; i < 4; ++i) {
          const float v = (bfs(d4[pt][i]) + y[hh][pt][0][i] * ea[0]) * siluf_(bfs(z4[pt][i]));
          y[hh][pt][0][i] = v;
          ss[0] += v * v;
        }
      __builtin_amdgcn_sched_barrier(0);
#pragma unroll
      for (int pt = 0; pt < 4; ++pt)
#pragma unroll
        for (int i = 0; i < 4; ++i) {
          const float v = (bfs(d5[pt][i]) + y[hh][pt][1][i] * ea[1]) * siluf_(bfs(z5[pt][i]));
          y[hh][pt][1][i] = v;
          ss[1] += v * v;
        }
      if (hh == 0) {
#pragma unroll
        for (int pt = 0; pt < 4; ++pt) { park[(2 * pt) * 256 + tid] = y[0][pt][0]; park[(2 * pt + 1) * 256 + tid] = y[0][pt][1]; }
      }
    }
    ss[0] = qsum(ss[0]); ss[1] = qsum(ss[1]);
    if (quad == 0) { smf[w * 32 + l15] = ss[0]; smf[w * 32 + 16 + l15] = ss[1]; }
    f4v gnv[2][4];
#pragma unroll
    for (int hh = 0; hh < 2; ++hh)
#pragma unroll
      for (int pt = 0; pt < 4; ++pt) gnv[hh][pt] = ldf4(p.g_ssm_norm + (g * 8 + 2 * w + hh) * 64 + 16 * pt + quad * 4);
    __syncthreads();
    float rs[2];
#pragma unroll
    for (int li = 0; li < 2; ++li) {
      const float tot = smf[16 * li + l15] + smf[32 + 16 * li + l15] + smf[64 + 16 * li + l15] + smf[96 + 16 * li + l15];
      rs[li] = rsqrtf(tot * (1.f / 512.f) + EPS);
    }
#pragma unroll
    for (int hh = 0; hh < 2; ++hh) {
      const int hd = g * 8 + 2 * w + hh;
#pragma unroll
      for (int li = 0; li < 2; ++li) {
        f4v nv[4];
#pragma unroll
        for (int pt = 0; pt < 4; ++pt) {
          const f4v v = (hh == 0) ? park[(2 * pt + li) * 256 + tid] : y[1][pt][li];
          nv[pt] = v * gnv[hh][pt] * rs[li];
        }
        u16* nrow = yn + (size_t)(t0 + 16 * li) * 2048 + hd * 64;
        st8bf_pair(nrow, nv[0], nv[1], quad);
        st8bf_pair(nrow + 32, nv[2], nv[3], quad);
      }
    }
    __syncthreads();
  }
}

DI void phaseH(const Params& p, u16* smem) {
  const int lane = tidx() & 63, w = tidx() >> 6, wm = w >> 1, wn = w & 1, l15 = lane & 15, quad = lane >> 4;
  const u16* P = (const u16*)(p.ws + O_P);
  u16* mg = (u16*)(p.ws + O_H);
  float* tmp = (float*)(p.ws + O_YD);
  constexpr int MT = MP / 128;
  for (int it = blockIdx.x; it < MT * 16; it += gridDim.x) {
    const int mi = it % MT, ni = it / MT;
    f4v acc[4][2];
    u2v keep[4][2];
    zero_acc<2>(acc);
    gemm_k64(acc, (const u16*)(p.ws + O_YN), 2048, (const u16*)(p.ws + O_WSSM), 2048, 2048, mi * 128, ni * 64, smem);
    s4v gq[4][2];
#pragma unroll
    for (int mt = 0; mt < 4; ++mt)
      ld8bf_pair(P + (size_t)(mi * 128 + wm * 64 + mt * 16 + l15) * LDP + C_MG + ni * 64 + wn * 32, quad, gq[mt][0], gq[mt][1]);
    __builtin_amdgcn_sched_barrier(0);
#pragma unroll
    for (int mt = 0; mt < 4; ++mt)
#pragma unroll
      for (int nt = 0; nt < 2; ++nt) {
        const int m = mi * 128 + wm * 64 + mt * 16 + l15, n = ni * 64 + wn * 32 + nt * 16 + quad * 4;
        const s4v g0 = gq[mt][nt];
        f4v r;
#pragma unroll
        for (int i = 0; i < 4; ++i) r[i] = sigmoidf_(bfs(g0[i])) * acc[mt][nt][i];
        u2v kp = {pk2(r[0], r[1]), pk2(r[2], r[3])};
        keep[mt][nt] = kp;
      }
    zero_acc<2>(acc);
    gemm_k64(acc, (const u16*)(p.ws + O_O), 1024, (const u16*)(p.ws + O_WNSA), 1024, 1024, mi * 128, ni * 64, smem);
    f4v tq[4][2];
#pragma unroll
    for (int mt = 0; mt < 4; ++mt)
      ld8bf_pair(P + (size_t)(mi * 128 + wm * 64 + mt * 16 + l15) * LDP + C_MG + 1024 + ni * 64 + wn * 32, quad, gq[mt][0], gq[mt][1]);
#pragma unroll
    for (int mt = 0; mt < 4; ++mt)
#pragma unroll
      for (int nt = 0; nt < 2; ++nt) {
        const u2v kp = keep[mt][nt];
        f4v tv = {__uint_as_float(kp[0] << 16), __uint_as_float(kp[0] & 0xffff0000u), __uint_as_float(kp[1] << 16),
                  __uint_as_float(kp[1] & 0xffff0000u)};
        tq[mt][nt] = tv;
      }
    __builtin_amdgcn_sched_barrier(0);
#pragma unroll
    for (int mt = 0; mt < 4; ++mt) {
      f4v rr[2];
#pragma unroll
      for (int nt = 0; nt < 2; ++nt) {
        const s4v g1 = gq[mt][nt];
        const f4v t0 = tq[mt][nt];
#pragma unroll
        for (int i = 0; i < 4; ++i) rr[nt][i] = t0[i] + sigmoidf_(bfs(g1[i])) * acc[mt][nt][i];
      }
      st8bf_pair(mg + (size_t)(mi * 128 + wm * 64 + mt * 16 + l15) * 1024 + ni * 64 + wn * 32, rr[0], rr[1], quad);
    }
  }
}

DI void phaseI(const Params& p, u16* smem) {
  const int lane = tidx() & 63, w = tidx() >> 6, wm = w >> 1, wn = w & 1, l15 = lane & 15, quad = lane >> 4;
  u16* outb = (u16*)(p.ws + O_OUTF);
  float* rsq = (float*)(p.ws + O_RSQ);
  constexpr int MT = MP / 128;
  for (int it = blockIdx.x; it < MT * 16; it += gridDim.x) {
    const int mi = it % MT, ni = it / MT;
    f4v acc[4][2];
    zero_acc<2>(acc);
    gemm_k64(acc, (const u16*)(p.ws + O_H), 1024, (const u16*)(p.ws + O_WOUT), 1024, 1024, mi * 128, ni * 64, smem);
#pragma unroll
    for (int mt = 0; mt < 4; ++mt) {
      const int m = mi * 128 + wm * 64 + mt * 16 + l15;
      float ss = 0.f;
#pragma unroll
      for (int nt = 0; nt < 2; ++nt) {
        const f4v v = acc[mt][nt];
        ss += v[0] * v[0] + v[1] * v[1] + v[2] * v[2] + v[3] * v[3];
      }
      st8bf_pair(outb + (size_t)m * 1024 + ni * 64 + wn * 32, acc[mt][0], acc[mt][1], quad);
      ss = qsum(ss);
      if (quad == 0) rsq[(size_t)m * 32 + ni * 2 + wn] = ss;
    }
  }
}

DI void phaseJ(const Params& p, int pass) {
  const int tid = tidx(), lane = tid & 63, w = tid >> 6;
  const u16* outb = (const u16*)(p.ws + O_OUTF);
  const float* rsq = (const float*)(p.ws + O_RSQ);
  const float* ada = (const float*)(p.ws + O_ADA);
  for (int it = blockIdx.x; it < MP / 4; it += gridDim.x) {
    const int r = it * 4 + w;
    const int tg = pass * MP + r, b = tg >> 11;
    float part = (lane < 32) ? rsq[(size_t)r * 32 + lane] : 0.f;
    s4v ob[4];
    f4v xv[4], gp[4], gt[4];
#pragma unroll
    for (int i = 0; i < 4; ++i) {
      const int c0 = i * 256 + lane * 4;
      ob[i] = ld4(outb + (size_t)r * 1024 + c0);
      xv[i] = ldf4(p.x + (size_t)tg * 1024 + c0);
      gp[i] = ldf4(p.g_post + c0);
      gt[i] = ldf4(ada + b * 3072 + 2048 + c0);
    }
    __builtin_amdgcn_sched_barrier(0);
#pragma unroll
    for (int o = 1; o < 64; o <<= 1) part += __shfl_xor(part, o);
    const float rstd = rsqrtf(part * (1.f / 1024.f) + EPS);
#pragma unroll
    for (int i = 0; i < 4; ++i) {
      const int c0 = i * 256 + lane * 4;
      f4v rr;
#pragma unroll
      for (int k = 0; k < 4; ++k) rr[k] = xv[i][k] + gt[i][k] * (bfs(ob[i][k]) * rstd * gp[i][k]);
      *reinterpret_cast<f4v*>(p.out + (size_t)tg * 1024 + c0) = rr;
    }
  }
}

#define XB_TMO      128
#define XB_XCNT(j)  (256  + 64 * (j))
#define XB_XSUB(j)  (1280 + 64 * (j))
#define XB_XGEN(j)  (2304 + 64 * (j))
#define XB_TOP      3328
#define XB_TOPGEN   3392
#define XCD_BAR_WORDS 3456
#define XB_SPIN_CAP (1u << 18)
#define LAS __attribute__((address_space(3)))
DI unsigned xb_ld(unsigned* p)              { return __hip_atomic_load(p, __ATOMIC_RELAXED, __HIP_MEMORY_SCOPE_AGENT); }
DI unsigned xb_add(unsigned* p, unsigned v) { return __hip_atomic_fetch_add(p, v, __ATOMIC_RELAXED, __HIP_MEMORY_SCOPE_AGENT); }
DI unsigned xb_xcc_id() { return (unsigned)__builtin_amdgcn_s_getreg((3 << 11) | 20) & 0xFu; }
#define XB_SPIN(cond, bar) do { unsigned _sp = 0; while (cond) { __builtin_amdgcn_s_sleep(1); \
    if ((++_sp & 255u) == 0u) { if (xb_ld(&(bar)[XB_TMO])) break; if (_sp > XB_SPIN_CAP) { atomicAdd(&(bar)[XB_TMO], 1u); break; } } } } while (0)
struct XcdBarrier { unsigned* bar; unsigned x; volatile LAS unsigned* st; };
DI XcdBarrier xcd_barrier_post(unsigned* bar, volatile LAS unsigned* st) {
  XcdBarrier b; b.bar = bar; b.x = xb_xcc_id(); b.st = st;
  if (threadIdx.x == 0) (void)xb_add(&bar[XB_XCNT(b.x)], 1u);
  return b;
}
DI void xcd_barrier_complete(unsigned* bar, unsigned x, unsigned& nloc, unsigned& nx) {
  const unsigned G = gridDim.x * gridDim.y * gridDim.z;
  unsigned sum, cnt, mine, sp = 0u;
  for (;;) {
    sum = 0u; cnt = 0u; mine = 0u;
#pragma unroll
    for (unsigned j = 0; j < 16; ++j) { const unsigned c = xb_ld(&bar[XB_XCNT(j)]); sum += c; cnt += (c > 0u) ? 1u : 0u; mine = (j == x) ? c : mine; }
    if (sum == G) break;
    __builtin_amdgcn_s_sleep(1);
    if ((++sp & 255u) == 0u) { if (xb_ld(&bar[XB_TMO])) break; if (sp > XB_SPIN_CAP) { atomicAdd(&bar[XB_TMO], 1u); break; } }
  }
  nloc = mine > 0u ? mine : 1u; nx = cnt > 0u ? cnt : 1u;
}
DI void xcd_barrier(const XcdBarrier& b) {
  asm volatile("s_waitcnt vmcnt(0)" ::: "memory");
  __syncthreads();
  if (threadIdx.x == 0) {
    unsigned* bar = b.bar;
    __builtin_amdgcn_s_waitcnt(0);
    unsigned nloc = b.st[0], nx = b.st[1];
    if (nloc == 0u) { xcd_barrier_complete(bar, b.x, nloc, nx); b.st[0] = nloc; b.st[1] = nx; }
    const unsigned old = xb_add(&bar[XB_XSUB(b.x)], 1u);
    const unsigned gen = old / nloc;
    if (old + 1u == (gen + 1u) * nloc) {
      __builtin_amdgcn_fence(__ATOMIC_RELEASE, "agent");
      asm volatile("s_waitcnt vmcnt(0)" ::: "memory");
      const unsigned og = xb_add(&bar[XB_TOP], 1u);
      const unsigned tg = og / nx;
      if (og + 1u == (tg + 1u) * nx) xb_add(&bar[XB_TOPGEN], 1u);
      else XB_SPIN(xb_ld(&bar[XB_TOPGEN]) == tg, bar);
      __builtin_amdgcn_fence(__ATOMIC_ACQUIRE, "agent");
      xb_add(&bar[XB_XGEN(b.x)], 1u);
      asm volatile("s_waitcnt vmcnt(0)" ::: "memory");
    } else {
      XB_SPIN(xb_ld(&bar[XB_XGEN(b.x)]) == gen, bar);
      __builtin_amdgcn_fence(__ATOMIC_ACQUIRE, "agent");
      asm volatile("s_waitcnt vmcnt(0)" ::: "memory");
    }
  }
  __syncthreads();
}

constexpr int PH_PER_PASS = 8;
constexpr int N_PHASES = 2 + NPASS * PH_PER_PASS;

constexpr int REP_MASK = 0;
constexpr int REP_SUB = 0;
constexpr int REP_A = 0;
constexpr int CPROBE = 0;
__global__ void __launch_bounds__(256, 2) mega_kernel(Params p, int ph_lo, int ph_hi) {
  __shared__ __attribute__((aligned(16))) unsigned char smem[73728];
  __shared__ uint4 xb_words;
  cg::grid_group grid = cg::this_grid();
  if (threadIdx.x == 0) xb_words = make_uint4(0u, 0u, 0u, 0u);
  __syncthreads();
  const XcdBarrier xb = xcd_barrier_post((unsigned*)(p.ws + O_BAR), (volatile LAS unsigned*)&xb_words);
  for (int ph = ph_lo; ph < ph_hi; ++ph) {
    if (ph == 0) {
      phaseA(p, smem);
      if (REP_A) { xcd_barrier(xb); phaseA(p, smem); }
    } else if (ph == 1) {
      phaseB(p, 0);
    } else {
      const int pass = (ph - 2) / PH_PER_PASS, k = (ph - 2) % PH_PER_PASS;
      Params q = p;
      const int nrep = ((REP_MASK >> k) & 1) ? 2 : 1;
      for (int rep = 0; rep < nrep; ++rep) {
        if (rep) xcd_barrier(xb);
        if (rep && REP_SUB == 9) continue;
        switch (k) {
          case 0: if (REP_MASK != 0 && rep) phaseC<CPROBE>(q, (u16*)smem); else phaseC<0>(q, (u16*)smem); break;
          case 1: phaseD(q, (u16*)smem, rep ? REP_SUB : 0, pass, rep); break;
          case 2: phaseE(q, (float*)smem, rep ? REP_SUB : 0, pass, rep); break;
          case 3: phaseF(q, rep > 0, (u16*)smem, pass, rep); break;
          case 4: phaseG(q, (float*)smem); break;
          case 5: phaseH(q, (u16*)smem); break;
          case 6: phaseI(q, (u16*)smem); break;
          default:
            phaseJ(q, pass);
            if (pass + 1 < NPASS) phaseB(q, pass + 1);
            break;
        }
      }
    }
    if (ph + 1 < ph_hi) {
      if (ph_hi < 0) grid.sync();
      xcd_barrier(xb);
    }
  }
}

extern "C" void kernel_launch(void* const* d_in, const int* in_sizes, int n_in, void* d_out, int out_size, void* d_ws,
                              size_t ws_size, hipStream_t stream) {
  static int grid_blocks = 0;
  if (!grid_blocks) {
    int dev = 0, cus = 0, per_cu = 0;
    hipGetDevice(&dev);
    hipDeviceGetAttribute(&cus, hipDeviceAttributeMultiprocessorCount, dev);
    hipOccupancyMaxActiveBlocksPerMultiprocessor(&per_cu, mega_kernel, 256, 0);
    if (per_cu < 1) per_cu = 1;
    if (per_cu > 2) per_cu = 2;
    grid_blocks = cus * per_cu;
  }
  if (ws_size < O_END) { fprintf(stderr, "workspace too small: %zu < %zu\n", ws_size, (size_t)O_END); return; }
  Params p{};
  const float** pp = reinterpret_cast<const float**>(&p);
  for (int i = 0; i < 22; ++i) pp[i] = (const float*)d_in[i];
  p.out = (float*)d_out;
  p.ws = (unsigned char*)d_ws;
  hipMemsetAsync((unsigned char*)d_ws + O_BAR, 0, 16384, stream);
  int lo = 0, hi = N_PHASES;
  void* args[] = {&p, &lo, &hi};
  hipError_t e = hipLaunchCooperativeKernel((void*)mega_kernel, dim3(grid_blocks), dim3(256), args, 0, stream);
  if (e != hipSuccess) fprintf(stderr, "cooperative launch failed: %s (grid %d)\n", hipGetErrorString(e), grid_blocks);
}
```

```cpp
#include <hip/hip_runtime.h>
#include <hip/hip_cooperative_groups.h>
#include <cstdio>
namespace cg = cooperative_groups;

typedef unsigned short u16;
typedef short s8v __attribute__((ext_vector_type(8)));
typedef short s4v __attribute__((ext_vector_type(4)));
typedef float f4v __attribute__((ext_vector_type(4)));
#define DI __device__ __forceinline__
#define MFMA16(a, b, c) __builtin_amdgcn_mfma_f32_16x16x32_bf16((a), (b), (c), 0, 0, 0)

constexpr int SEQ = 2048, DM = 1024, NB = 8;
constexpr int TS = SEQ + 64;
constexpr int NBG = 2;
constexpr int MP = NBG * SEQ;
constexpr int NPASS = NB / NBG;
constexpr int NIN = 10832, LDP = 10880;
constexpr int C_Z = 0, C_XBC = 2048, C_DT = 5120, C_Q = 5152, C_KC = 6176, C_VC = 6432, C_KS = 6688, C_VS = 6944,
              C_KW = 7200, C_VW = 7456, C_G = 7712, C_ZA = 7760, C_MG = 8784;
constexpr float EPS = 1e-6f;
constexpr float NEGB = -1e30f;
constexpr int APROBE = 0;

constexpr size_t al256(size_t x) { return (x + 255) & ~size_t(255); }
constexpr size_t O_WIN = 0;
constexpr size_t O_WSSM = O_WIN + al256((size_t)LDP * 1024 * 2);
constexpr size_t O_WNSA = O_WSSM + al256((size_t)1024 * 2048 * 2);
constexpr size_t O_WOUT = O_WNSA + al256((size_t)1024 * 1024 * 2);
constexpr size_t O_W1K = O_WOUT + al256((size_t)1024 * 1024 * 2);
constexpr size_t O_W1V = O_W1K + al256((size_t)256 * 2048 * 2);
constexpr size_t O_W2K = O_W1V + al256((size_t)256 * 2048 * 2);
constexpr size_t O_W2V = O_W2K + al256((size_t)64 * 256 * 2);
constexpr size_t O_POSB = O_W2V + al256((size_t)64 * 256 * 2);
constexpr size_t O_ADA = O_POSB + al256(2 * 256 * 4);
constexpr size_t O_H = O_ADA + al256((size_t)8 * 3072 * 4);
constexpr size_t O_P = O_H + al256((size_t)MP * 1024 * 2);
constexpr size_t O_XC = O_P + al256((size_t)MP * LDP * 2);
constexpr size_t O_XCT = O_XC + al256((size_t)MP * 3072 * 2);
constexpr size_t O_DT = O_XCT + al256((size_t)NBG * 2560 * TS * 2);
constexpr size_t O_ACS = O_DT + al256((size_t)NBG * 32 * 2048 * 4);
constexpr size_t O_ST = O_ACS + al256((size_t)NBG * 32 * 2048 * 4);
constexpr size_t O_YD = O_ST + al256((size_t)NBG * 16 * 32 * 64 * 128 * 2);
constexpr size_t O_YN = O_YD;
constexpr size_t O_KCMP = O_YD + al256((size_t)MP * 2048 * 2);
constexpr size_t O_VCT = O_KCMP + al256((size_t)NBG * 4 * 128 * 64 * 2);
constexpr size_t O_VST = O_VCT + al256((size_t)NBG * 4 * 128 * 64 * 2);
constexpr size_t O_VWT = O_VST + al256((size_t)NBG * 4 * 64 * TS * 2);
constexpr size_t O_SEL = O_VWT + al256((size_t)NBG * 4 * 64 * TS * 2);
constexpr size_t O_OCMP = O_SEL + al256((size_t)NBG * 4 * 2048 * 4);
constexpr size_t O_O = O_XCT;
constexpr size_t O_BAR = O_OCMP + al256((size_t)MP * 1024 * 2);
constexpr size_t O_END = O_BAR + 16384;
static_assert(O_END <= (size_t)256 * 1024 * 1024, "workspace map must fit the guaranteed 256 MiB");
constexpr size_t O_OUTF = O_P;
constexpr size_t O_RSQ = O_P + al256((size_t)MP * 1024 * 4);

struct Params {
  const float *x, *c, *w_ada, *b_ada, *g_pre, *g_post, *w_in, *conv_w, *conv_b, *dt_bias, *a_log, *d_skip, *g_ssm_norm,
      *w_ssm_out, *cmp_pos_k, *cmp_w1_k, *cmp_w2_k, *cmp_pos_v, *cmp_w1_v, *cmp_w2_v, *w_nsa_out, *w_out;
  float* out;
  unsigned char* ws;
};

DI u16 f2bf(float f) { unsigned u = __float_as_uint(f); u += 0x7fffu + ((u >> 16) & 1u); return (u16)(u >> 16); }
DI float bf2f(u16 h) { return __uint_as_float(((unsigned)h) << 16); }
DI float bfs(short h) { return __uint_as_float(((unsigned)(u16)h) << 16); }
DI s8v ld8(const u16* p) { return *reinterpret_cast<const s8v*>(p); }
DI s4v ld4(const u16* p) { return *reinterpret_cast<const s4v*>(p); }
DI f4v ldf4(const float* p) { return *reinterpret_cast<const f4v*>(p); }
typedef __bf16 bf2v __attribute__((ext_vector_type(2)));
typedef float f2v __attribute__((ext_vector_type(2)));
typedef unsigned u2v __attribute__((ext_vector_type(2)));
typedef unsigned u4v __attribute__((ext_vector_type(4)));
DI unsigned pk2(float a, float b) {
  f2v v = {a, b};
  return __builtin_bit_cast(unsigned, __builtin_convertvector(v, bf2v));
}
DI void st4bf(u16* p, float a, float b, float c, float d) {
  u2v v = {pk2(a, b), pk2(c, d)};
  *reinterpret_cast<u2v*>(p) = v;
}
DI void st8bf_pair(u16* p, f4v a, f4v b, int quad) {
  unsigned ax = pk2(a[0], a[1]), ay = pk2(a[2], a[3]), bx = pk2(b[0], b[1]), by = pk2(b[2], b[3]);
  const auto r0 = __builtin_amdgcn_permlane16_swap(ax, bx, false, false);
  const auto r1 = __builtin_amdgcn_permlane16_swap(ay, by, false, false);
  u4v v = {r0[0], r1[0], r0[1], r1[1]};
  *reinterpret_cast<u4v*>(p + (quad & 1) * 16 + (quad >> 1) * 8) = v;
}
DI void ld8bf_pair(const u16* p, int quad, s4v& a, s4v& b) {
  const u4v x = *reinterpret_cast<const u4v*>(p + (quad & 1) * 16 + (quad >> 1) * 8);
  const auto r0 = __builtin_amdgcn_permlane16_swap(x[0], x[2], false, false);
  const auto r1 = __builtin_amdgcn_permlane16_swap(x[1], x[3], false, false);
  u2v ua = {r0[0], r1[0]}, ub = {r0[1], r1[1]};
  a = __builtin_bit_cast(s4v, ua);
  b = __builtin_bit_cast(s4v, ub);
}
DI s8v pack8(f4v a, f4v b) {
  u4v v = {pk2(a[0], a[1]), pk2(a[2], a[3]), pk2(b[0], b[1]), pk2(b[2], b[3])};
  return __builtin_bit_cast(s8v, v);
}
DI s8v pack8f(const float* x) {
  u4v v = {pk2(x[0], x[1]), pk2(x[2], x[3]), pk2(x[4], x[5]), pk2(x[6], x[7])};
  return __builtin_bit_cast(s8v, v);
}
DI s8v cat44(s4v a, s4v b) { s8v v; v[0]=a[0]; v[1]=a[1]; v[2]=a[2]; v[3]=a[3]; v[4]=b[0]; v[5]=b[1]; v[6]=b[2]; v[7]=b[3]; return v; }
DI float sigmoidf_(float x) { return __builtin_amdgcn_rcpf(1.f + __expf(-x)); }
DI float siluf_(float x) { return x * __builtin_amdgcn_rcpf(1.f + __expf(-x)); }
DI float softplusf_(float x) {
  const float y = __expf(x);
  const float small = y * (1.f - y * (0.5f - y * (0.33333334f - 0.25f * y)));
  const float big = __logf(1.f + y);
  return x > 20.f ? x : (y < 0.03f ? small : big);
}
DI float qmax(float v) { v = fmaxf(v, __shfl_xor(v, 16)); v = fmaxf(v, __shfl_xor(v, 32)); return v; }
DI float qsum(float v) { v += __shfl_xor(v, 16); v += __shfl_xor(v, 32); return v; }
DI int tidx() { int t = __builtin_amdgcn_workitem_id_x(); asm volatile("" : "+v"(t)); return t; }
DI f4v fz() { f4v z = {0.f, 0.f, 0.f, 0.f}; return z; }

DI int lds_byte32(int r, int c) {
  const int ob = (r & 15) * 64 + c * 2;
  return (r >> 4) * 1024 + (ob ^ (((ob >> 9) & 1) << 5));
}
DI void stage_rc32(int b, int& R, int& C) {
  const int st = b >> 10, sb = b & 1023, swz = sb ^ (((sb >> 9) & 1) << 5);
  R = st * 16 + (swz >> 6);
  C = (swz & 63) >> 1;
}
template <int N> DI void wait_vm() {
  if constexpr (N == 0) asm volatile("s_waitcnt vmcnt(0)" ::: "memory");
  else if constexpr (N == 3) asm volatile("s_waitcnt vmcnt(3)" ::: "memory");
  else if constexpr (N == 4) asm volatile("s_waitcnt vmcnt(4)" ::: "memory");
  else if constexpr (N == 6) asm volatile("s_waitcnt vmcnt(6)" ::: "memory");
  else asm volatile("s_waitcnt vmcnt(8)" ::: "memory");
}
template <int NT, int MODE = 0>
DI void gemm_mainloop(f4v (&acc)[4][NT], const u16* __restrict__ A, int lda, const u16* __restrict__ Bt, int ldb, int K,
                      int m0, int n0, u16* smem) {
  const int tid = tidx(), lane = tid & 63, w = tid >> 6, wm = w >> 1, wn = w & 1;
  const int l15 = lane & 15, quad = lane >> 4;
  constexpr int TA = 8192, TBB = NT * 2048, TBUF = TA + TBB;
  constexpr int NBP = NT / 2;
  constexpr int L = 2 + NBP;
  char* sbase = reinterpret_cast<char*>(smem);
  const unsigned lbase = (unsigned)(size_t)sbase;
  int Rr[2], Cc[2];
#pragma unroll
  for (int i = 0; i < 2; ++i) stage_rc32(tid * 16 + i * 4096, Rr[i], Cc[i]);
  const u16* ga0 = A + (size_t)(m0 + Rr[0]) * lda + Cc[0];
  const u16* ga1 = A + (size_t)(m0 + Rr[1]) * lda + Cc[1];
  const u16* gb0 = Bt + (size_t)(n0 + Rr[0]) * ldb + Cc[0];
  const u16* gb1 = Bt + (size_t)(n0 + Rr[NBP - 1]) * ldb + Cc[NBP - 1];
  unsigned offa[4], offb[NT];
#pragma unroll
  for (int t = 0; t < 4; ++t) offa[t] = lds_byte32(wm * 64 + t * 16 + l15, quad * 8);
#pragma unroll
  for (int t = 0; t < NT; ++t) offb[t] = TA + lds_byte32(wn * 16 * NT + t * 16 + l15, quad * 8);
  const int ns = K >> 5;
#define GEMM_STAGE(j)                                                                                                 \
  do {                                                                                                               \
    char* _d = sbase + ((j) & 3) * TBUF + tid * 16;                                                                   \
    __builtin_amdgcn_global_load_lds((const unsigned*)(ga0 + (j) * 32), (unsigned*)(_d), 16, 0, 0);                   \
    __builtin_amdgcn_global_load_lds((const unsigned*)(ga1 + (j) * 32), (unsigned*)(_d + 4096), 16, 0, 0);            \
    __builtin_amdgcn_global_load_lds((const unsigned*)(gb0 + (j) * 32), (unsigned*)(_d + TA), 16, 0, 0);              \
    if (NBP == 2) __builtin_amdgcn_global_load_lds((const unsigned*)(gb1 + (j) * 32), (unsigned*)(_d + TA + 4096), 16, 0, 0); \
  } while (0)
  asm volatile("s_waitcnt vmcnt(0)" ::: "memory");
  if (MODE != 1) { GEMM_STAGE(0); GEMM_STAGE(1); GEMM_STAGE(2); }
  for (int j = 0; j < ns; ++j) {
    if (j + 2 < ns) wait_vm<2 * L>();
    else if (j + 1 < ns) wait_vm<L>();
    else wait_vm<0>();
    asm volatile("s_waitcnt lgkmcnt(0)" ::: "memory");
    __builtin_amdgcn_s_barrier();
    if (MODE != 1 && j + 3 < ns) GEMM_STAGE(j + 3);
    if (MODE == 2) continue;
    const unsigned sl = lbase + (unsigned)((j & 3) * TBUF);
    s8v af[4], bg[NT];
    if constexpr (NT == 4) {
      asm volatile(
          "ds_read_b128 %0, %8\n\tds_read_b128 %1, %9\n\tds_read_b128 %2, %10\n\tds_read_b128 %3, %11\n\t"
          "ds_read_b128 %4, %12\n\tds_read_b128 %5, %13\n\tds_read_b128 %6, %14\n\tds_read_b128 %7, %15\n\t"
          "s_waitcnt lgkmcnt(0)"
          : "=&v"(af[0]), "=&v"(af[1]), "=&v"(af[2]), "=&v"(af[3]), "=&v"(bg[0]), "=&v"(bg[1]), "=&v"(bg[2]), "=&v"(bg[3])
          : "v"(sl + offa[0]), "v"(sl + offa[1]), "v"(sl + offa[2]), "v"(sl + offa[3]), "v"(sl + offb[0]), "v"(sl + offb[1]),
            "v"(sl + offb[2]), "v"(sl + offb[3])
          : "memory");
    } else {
      asm volatile(
          "ds_read_b128 %0, %6\n\tds_read_b128 %1, %7\n\tds_read_b128 %2, %8\n\tds_read_b128 %3, %9\n\t"
          "ds_read_b128 %4, %10\n\tds_read_b128 %5, %11\n\t"
          "s_waitcnt lgkmcnt(0)"
          : "=&v"(af[0]), "=&v"(af[1]), "=&v"(af[2]), "=&v"(af[3]), "=&v"(bg[0]), "=&v"(bg[1])
          : "v"(sl + offa[0]), "v"(sl + offa[1]), "v"(sl + offa[2]), "v"(sl + offa[3]), "v"(sl + offb[0]), "v"(sl + offb[1])
          : "memory");
    }
#pragma unroll
    for (int mt = 0; mt < 4; ++mt)
#pragma unroll
      for (int nt = 0; nt < NT; ++nt) acc[mt][nt] = MFMA16(bg[nt], af[mt], acc[mt][nt]);
  }
#undef GEMM_STAGE
  asm volatile("s_waitcnt lgkmcnt(0)" ::: "memory");
  __builtin_amdgcn_s_barrier();
}
template <int NT>
DI void zero_acc(f4v (&acc)[4][NT]) {
#pragma unroll
  for (int i = 0; i < 4; ++i)
#pragma unroll
    for (int j = 0; j < NT; ++j) acc[i][j] = fz();
}

DI void gemm_big_prefetch(const u16* __restrict__ A, int lda, const u16* __restrict__ Bt, int ldb, int m0, int n0, u16* smem) {
  const int tid = tidx();
  char* sbase = reinterpret_cast<char*>(smem);
#pragma unroll
  for (int sl = 0; sl < 2; ++sl) {
    char* d = sbase + sl * 24576 + tid * 16;
#pragma unroll
    for (int i = 0; i < 4; ++i) {
      int R, C;
      stage_rc32(tid * 16 + i * 4096, R, C);
      __builtin_amdgcn_global_load_lds((const unsigned*)(A + (size_t)(m0 + R) * lda + C + sl * 32), (unsigned*)(d + i * 4096), 16, 0, 0);
      if (i < 2)
        __builtin_amdgcn_global_load_lds((const unsigned*)(Bt + (size_t)(n0 + R) * ldb + C + sl * 32), (unsigned*)(d + 16384 + i * 4096), 16, 0, 0);
    }
  }
}
DI void gemm_big(f4v (&acc)[8][4], const u16* __restrict__ A, int lda, const u16* __restrict__ Bt, int ldb, int K, int m0, int n0,
                 u16* smem, bool prestaged) {
  const int tid = tidx(), lane = tid & 63, w = tid >> 6, wm = w >> 1, wn = w & 1;
  const int l15 = lane & 15, quad = lane >> 4;
  constexpr int TA = 16384, TBUF = 24576;
  char* sbase = reinterpret_cast<char*>(smem);
  const unsigned lbase = (unsigned)(size_t)sbase;
  const u16* ga[4];
  const u16* gb[2];
#pragma unroll
  for (int i = 0; i < 4; ++i) {
    int R, C;
    stage_rc32(tid * 16 + i * 4096, R, C);
    ga[i] = A + (size_t)(m0 + R) * lda + C;
    if (i < 2) gb[i] = Bt + (size_t)(n0 + R) * ldb + C;
  }
  unsigned offa[8], offb[4];
#pragma unroll
  for (int t = 0; t < 8; ++t) offa[t] = lds_byte32(wm * 128 + t * 16 + l15, quad * 8);
#pragma unroll
  for (int t = 0; t < 4; ++t) offb[t] = TA + lds_byte32(wn * 64 + t * 16 + l15, quad * 8);
  const int ns = K >> 5;
#define BIG_STAGE(j, slot)                                                                                            \
  do {                                                                                                               \
    char* _d = sbase + (slot) * TBUF + tid * 16;                                                                      \
    _Pragma("unroll") for (int _i = 0; _i < 4; ++_i)                                                                 \
      __builtin_amdgcn_global_load_lds((const unsigned*)(ga[_i] + (j) * 32), (unsigned*)(_d + _i * 4096), 16, 0, 0);  \
    _Pragma("unroll") for (int _i = 0; _i < 2; ++_i)                                                                 \
      __builtin_amdgcn_global_load_lds((const unsigned*)(gb[_i] + (j) * 32), (unsigned*)(_d + TA + _i * 4096), 16, 0, 0); \
  } while (0)
  if (!prestaged) {
    asm volatile("s_waitcnt vmcnt(0)" ::: "memory");
    BIG_STAGE(0, 0);
    BIG_STAGE(1, 1);
  }
  int slot = 0;
  for (int j = 0; j < ns; ++j) {
    if (j + 1 < ns) wait_vm<6>();
    else wait_vm<0>();
    asm volatile("s_waitcnt lgkmcnt(0)" ::: "memory");
    __builtin_amdgcn_s_barrier();
    const int s2 = (slot == 0) ? 2 : slot - 1;
    if (j + 2 < ns) BIG_STAGE(j + 2, s2);
    const unsigned sl = lbase + (unsigned)(slot * TBUF);
    s8v af[8], bg[4];
    asm volatile(
        "ds_read_b128 %0, %12\n\tds_read_b128 %1, %13\n\tds_read_b128 %2, %14\n\tds_read_b128 %3, %15\n\t"
        "ds_read_b128 %4, %16\n\tds_read_b128 %5, %17\n\tds_read_b128 %6, %18\n\tds_read_b128 %7, %19\n\t"
        "ds_read_b128 %8, %20\n\tds_read_b128 %9, %21\n\tds_read_b128 %10, %22\n\tds_read_b128 %11, %23\n\t"
        "s_waitcnt lgkmcnt(0)"
        : "=&v"(bg[0]), "=&v"(bg[1]), "=&v"(bg[2]), "=&v"(bg[3]), "=&v"(af[0]), "=&v"(af[1]), "=&v"(af[2]), "=&v"(af[3]),
          "=&v"(af[4]), "=&v"(af[5]), "=&v"(af[6]), "=&v"(af[7])
        : "v"(sl + offb[0]), "v"(sl + offb[1]), "v"(sl + offb[2]), "v"(sl + offb[3]), "v"(sl + offa[0]), "v"(sl + offa[1]),
          "v"(sl + offa[2]), "v"(sl + offa[3]), "v"(sl + offa[4]), "v"(sl + offa[5]), "v"(sl + offa[6]), "v"(sl + offa[7])
        : "memory");
#pragma unroll
    for (int mt = 0; mt < 8; ++mt)
#pragma unroll
      for (int nt = 0; nt < 4; ++nt) acc[mt][nt] = MFMA16(bg[nt], af[mt], acc[mt][nt]);
    slot = (slot == 2) ? 0 : slot + 1;
  }
#undef BIG_STAGE
  asm volatile("s_waitcnt lgkmcnt(0)" ::: "memory");
  __builtin_amdgcn_s_barrier();
}

DI void gemm_k64(f4v (&acc)[4][2], const u16* __restrict__ A, int lda, const u16* __restrict__ Bt, int ldb, int K, int m0, int n0,
                 u16* smem) {
  const int tid = tidx(), lane = tid & 63, w = tid >> 6, wm = w >> 1, wn = w & 1;
  const int l15 = lane & 15, quad = lane >> 4;
  constexpr int TA = 16384, TBUF = 24576;
  char* sbase = reinterpret_cast<char*>(smem);
  const unsigned lbase = (unsigned)(size_t)sbase;
  const u16* ga[4];
  const u16* gb[2];
#pragma unroll
  for (int i = 0; i < 4; ++i) {
    int R, C;
    stage_rc32(tid * 16 + (i & 1) * 4096, R, C);
    ga[i] = A + (size_t)(m0 + R) * lda + C + 32 * (i >> 1);
  }
  {
    int R, C;
    stage_rc32(tid * 16, R, C);
    gb[0] = Bt + (size_t)(n0 + R) * ldb + C;
    gb[1] = gb[0] + 32;
  }
  unsigned offa[8], offb[4];
#pragma unroll
  for (int t = 0; t < 8; ++t) offa[t] = (t >> 2) * 8192 + lds_byte32(wm * 64 + (t & 3) * 16 + l15, quad * 8);
#pragma unroll
  for (int t = 0; t < 4; ++t) offb[t] = TA + (t >> 1) * 4096 + lds_byte32(wn * 32 + (t & 1) * 16 + l15, quad * 8);
  const int ns = K >> 6;
#define K64_STAGE(j, slot)                                                                                            \
  do {                                                                                                               \
    char* _d = sbase + (slot) * TBUF + tid * 16;                                                                      \
    _Pragma("unroll") for (int _i = 0; _i < 4; ++_i)                                                                 \
      __builtin_amdgcn_global_load_lds((const unsigned*)(ga[_i] + (j) * 64), (unsigned*)(_d + _i * 4096), 16, 0, 0);  \
    _Pragma("unroll") for (int _i = 0; _i < 2; ++_i)                                                                 \
      __builtin_amdgcn_global_load_lds((const unsigned*)(gb[_i] + (j) * 64), (unsigned*)(_d + TA + _i * 4096), 16, 0, 0); \
  } while (0)
  asm volatile("s_waitcnt vmcnt(0)" ::: "memory");
  K64_STAGE(0, 0);
  if (ns > 1) K64_STAGE(1, 1);
  int slot = 0;
  for (int j = 0; j < ns; ++j) {
    if (j + 1 < ns) wait_vm<6>();
    else wait_vm<0>();
    asm volatile("s_waitcnt lgkmcnt(0)" ::: "memory");
    __builtin_amdgcn_s_barrier();
    const int s2 = (slot == 0) ? 2 : slot - 1;
    if (j + 2 < ns) K64_STAGE(j + 2, s2);
    const unsigned sl = lbase + (unsigned)(slot * TBUF);
    s8v af[8], bg[4];
    asm volatile(
        "ds_read_b128 %0, %12\n\tds_read_b128 %1, %13\n\tds_read_b128 %2, %14\n\tds_read_b128 %3, %15\n\t"
        "ds_read_b128 %4, %16\n\tds_read_b128 %5, %17\n\tds_read_b128 %6, %18\n\tds_read_b128 %7, %19\n\t"
        "ds_read_b128 %8, %20\n\tds_read_b128 %9, %21\n\tds_read_b128 %10, %22\n\tds_read_b128 %11, %23\n\t"
        "s_waitcnt lgkmcnt(0)"
        : "=&v"(bg[0]), "=&v"(bg[1]), "=&v"(bg[2]), "=&v"(bg[3]), "=&v"(af[0]), "=&v"(af[1]), "=&v"(af[2]), "=&v"(af[3]),
          "=&v"(af[4]), "=&v"(af[5]), "=&v"(af[6]), "=&v"(af[7])
        : "v"(sl + offb[0]), "v"(sl + offb[1]), "v"(sl + offb[2]), "v"(sl + offb[3]), "v"(sl + offa[0]), "v"(sl + offa[1]),
          "v"(sl + offa[2]), "v"(sl + offa[3]), "v"(sl + offa[4]), "v"(sl + offa[5]), "v"(sl + offa[6]), "v"(sl + offa[7])
        : "memory");
#pragma unroll
    for (int h = 0; h < 2; ++h)
#pragma unroll
      for (int mt = 0; mt < 4; ++mt)
#pragma unroll
        for (int nt = 0; nt < 2; ++nt) acc[mt][nt] = MFMA16(bg[h * 2 + nt], af[h * 4 + mt], acc[mt][nt]);
    slot = (slot == 2) ? 0 : slot + 1;
  }
#undef K64_STAGE
  asm volatile("s_waitcnt lgkmcnt(0)" ::: "memory");
  __builtin_amdgcn_s_barrier();
}

DI void convT_tile(const float* __restrict__ w, int K, int N, u16* __restrict__ wt, int tile, float* sm) {
  const int tid = tidx();
  const int tiles_k = K >> 6;
  const int tk = tile % tiles_k, tn = tile / tiles_k;
  const int k0 = tk * 64, n0 = tn * 64;
  {
    const int c = tid & 63, r0 = tid >> 6;
    const bool ok = (n0 + c) < N;
    float v[16];
#pragma unroll
    for (int i = 0; i < 16; ++i) v[i] = ok ? w[(size_t)(k0 + r0 + 4 * i) * N + n0 + c] : 0.f;
    __builtin_amdgcn_sched_barrier(0);
#pragma unroll
    for (int i = 0; i < 16; ++i) sm[(r0 + 4 * i) * 65 + c] = v[i];
  }
  __syncthreads();
  {
    const int n = tid >> 2, ks = (tid & 3) * 16;
    float t0[8], t1[8];
#pragma unroll
    for (int j = 0; j < 8; ++j) { t0[j] = sm[(ks + j) * 65 + n]; t1[j] = sm[(ks + 8 + j) * 65 + n]; }
    const s8v v0 = pack8f(t0), v1 = pack8f(t1);
    u16* dst = wt + (size_t)(n0 + n) * K + k0 + ks;
    *reinterpret_cast<s8v*>(dst) = v0;
    *reinterpret_cast<s8v*>(dst + 8) = v1;
  }
  __syncthreads();
}

template <int NR>
DI void gemv_cols(const float* __restrict__ vec, int K, const float* __restrict__ W, int N, const float* __restrict__ bias,
                  float* __restrict__ out, int col0, float* sm) {
  const int tid = tidx(), kg = tid >> 6, cl = tid & 63;
  const int kper = K >> 2;
  float acc[NR];
#pragma unroll
  for (int r = 0; r < NR; ++r) acc[r] = 0.f;
  for (int k0 = kg * kper; k0 < (kg + 1) * kper; k0 += 16) {
    float wv[16];
#pragma unroll
    for (int j = 0; j < 16; ++j) wv[j] = W[(size_t)(k0 + j) * N + col0 + cl];
    __builtin_amdgcn_sched_barrier(0);
#pragma unroll
    for (int j = 0; j < 16; ++j)
#pragma unroll
      for (int r = 0; r < NR; ++r) acc[r] += vec[r * K + k0 + j] * wv[j];
    __builtin_amdgcn_sched_barrier(0);
  }
#pragma unroll
  for (int r = 0; r < NR; ++r) sm[(kg * NR + r) * 64 + cl] = acc[r];
  __syncthreads();
  for (int idx = tid; idx < NR * 64; idx += 256) {
    const int r = idx >> 6, c2 = idx & 63;
    float s = bias ? bias[col0 + c2] : 0.f;
#pragma unroll
    for (int g = 0; g < 4; ++g) s += sm[(g * NR + r) * 64 + c2];
    out[(size_t)r * N + col0 + c2] = s;
  }
  __syncthreads();
}

DI void phaseA(const Params& p, unsigned char* smem_raw) {
  float* smf = reinterpret_cast<float*>(smem_raw);
  unsigned char* ws = p.ws;
  constexpr int T0 = 16 * 170, T1 = T0 + 32 * 16, T2 = T1 + 16 * 16, T3 = T2 + 16 * 16, T4 = T3 + 32 * 4, T5 = T4 + 32 * 4,
                T6 = T5 + 4, T7 = T6 + 4, T8 = T7 + 48, T9 = T8 + 8;
  for (int it = blockIdx.x; it < T9; it += gridDim.x) {
    if (it < T0) convT_tile(p.w_in, 1024, NIN, (u16*)(ws + O_WIN), it, smf);
    else if (it < T1) convT_tile(p.w_ssm_out, 2048, 1024, (u16*)(ws + O_WSSM), it - T0, smf);
    else if (it < T2) convT_tile(p.w_nsa_out, 1024, 1024, (u16*)(ws + O_WNSA), it - T1, smf);
    else if (it < T3) convT_tile(p.w_out, 1024, 1024, (u16*)(ws + O_WOUT), it - T2, smf);
    else if (it < T4) convT_tile(p.cmp_w1_k, 2048, 256, (u16*)(ws + O_W1K), it - T3, smf);
    else if (it < T5) convT_tile(p.cmp_w1_v, 2048, 256, (u16*)(ws + O_W1V), it - T4, smf);
    else if (it < T6) convT_tile(p.cmp_w2_k, 256, 64, (u16*)(ws + O_W2K), it - T5, smf);
    else if (it < T7) convT_tile(p.cmp_w2_v, 256, 64, (u16*)(ws + O_W2V), it - T6, smf);
    else if (it < T8) gemv_cols<8>(p.c, 1024, p.w_ada, 3072, p.b_ada, (float*)(ws + O_ADA), (it - T7) * 64, smf);
    else {
      const int j = it - T8, kind = j >> 2, cb = j & 3;
      gemv_cols<1>(kind ? p.cmp_pos_v : p.cmp_pos_k, 2048, kind ? p.cmp_w1_v : p.cmp_w1_k, 256, nullptr,
                   (float*)(ws + O_POSB) + kind * 256, cb * 64, smf);
    }
  }
}

DI void phaseB(const Params& p, int pass) {
  const int tid = tidx(), lane = tid & 63, w = tid >> 6;
  const float* ada = (const float*)(p.ws + O_ADA);
  u16* h = (u16*)(p.ws + O_H);
  for (int it = blockIdx.x; it < MP / 4; it += gridDim.x) {
    const int r = it * 4 + w;
    const int tg = pass * MP + r;
    const int b = tg >> 11;
    const float* xr = p.x + (size_t)tg * DM;
    f4v v[4];
    float ss = 0.f;
#pragma unroll
    for (int i = 0; i < 4; ++i) {
      v[i] = ldf4(xr + i * 256 + lane * 4);
      ss += v[i][0] * v[i][0] + v[i][1] * v[i][1] + v[i][2] * v[i][2] + v[i][3] * v[i][3];
    }
#pragma unroll
    for (int o = 1; o < 64; o <<= 1) ss += __shfl_xor(ss, o);
    const float rstd = rsqrtf(ss * (1.f / DM) + EPS);
    f4v gg[4], shh[4], scc[4];
#pragma unroll
    for (int i = 0; i < 4; ++i) {
      const int c0 = i * 256 + lane * 4;
      gg[i] = ldf4(p.g_pre + c0);
      shh[i] = ldf4(ada + b * 3072 + c0);
      scc[i] = ldf4(ada + b * 3072 + 1024 + c0);
    }
    __builtin_amdgcn_sched_barrier(0);
#pragma unroll
    for (int i = 0; i < 4; ++i) {
      const int c0 = i * 256 + lane * 4;
      const f4v g = gg[i], sh = shh[i], sc = scc[i];
      float o0 = v[i][0] * rstd * g[0] * (1.f + sc[0]) + sh[0];
      float o1 = v[i][1] * rstd * g[1] * (1.f + sc[1]) + sh[1];
      float o2 = v[i][2] * rstd * g[2] * (1.f + sc[2]) + sh[2];
      float o3 = v[i][3] * rstd * g[3] * (1.f + sc[3]) + sh[3];
      st4bf(h + (size_t)r * DM + c0, o0, o1, o2, o3);
    }
  }
}

template <int MODE>
DI void phaseC(const Params& p, u16* smem) {
  const int lane = tidx() & 63, w = tidx() >> 6, wm = w >> 1, wn = w & 1, l15 = lane & 15, quad = lane >> 4;
  const u16* A = (const u16*)(p.ws + O_H);
  const u16* Bt = (const u16*)(p.ws + O_WIN);
  u16* P = (u16*)(p.ws + O_P);
  constexpr int NTN = LDP / 128;
  const int xcd = blockIdx.x & 7, lb = blockIdx.x >> 3, nlb = gridDim.x >> 3;
  bool pre = false;
  for (int t = lb;; t += nlb) {
    const int mi = (xcd & 3) * 4 + (t & 3);
    const int ni = 2 * (t >> 2) + (xcd >> 2);
    if (ni >= NTN) break;
    f4v acc[8][4];
#pragma unroll
    for (int i = 0; i < 8; ++i)
#pragma unroll
      for (int j = 0; j < 4; ++j) acc[i][j] = fz();
    gemm_big(acc, A, 1024, Bt, 1024, 1024, mi * 256, ni * 128, smem, pre);
    {
      const int t2 = t + nlb;
      const int ni2 = 2 * (t2 >> 2) + (xcd >> 2);
      pre = ni2 < NTN;
      if (pre) gemm_big_prefetch(A, 1024, Bt, 1024, ((xcd & 3) * 4 + (t2 & 3)) * 256, ni2 * 128, smem);
    }
    if (MODE != 0) { if (acc[0][0][0] + acc[7][3][3] != 12345.678f) continue; }
#pragma unroll
    for (int mt = 0; mt < 8; ++mt) {
      u16* prow = P + (size_t)(mi * 256 + wm * 128 + mt * 16 + l15) * LDP + ni * 128 + wn * 64;
      st8bf_pair(prow, acc[mt][0], acc[mt][1], quad);
      st8bf_pair(prow + 32, acc[mt][2], acc[mt][3], quad);
    }
  }
}

DI void conv_item(const Params& p, int it) {
  const int tid = tidx();
  const int cb = it % 24, tb = (it / 24) & 31, b = it / (24 * 32);
  const int ch0 = cb * 128 + 2 * (tid & 63);
  const int t0 = tb * 64 + 16 * (tid >> 6);
  const u16* P = (const u16*)(p.ws + O_P);
  u16* xc = (u16*)(p.ws + O_XC);
  u16* xcT = (u16*)(p.ws + O_XCT);
  unsigned raw[19];
#pragma unroll
  for (int i = 0; i < 19; ++i) {
    const int t = t0 - 3 + i;
    raw[i] = (t >= 0) ? *reinterpret_cast<const unsigned*>(P + (size_t)(b * SEQ + t) * LDP + C_XBC + ch0) : 0u;
  }
  const int hd = ch0 >> 6;
  u16 dtr[16];
  const bool isx = ch0 < 2048, isxb = ch0 < 2560;
  if (isx) {
#pragma unroll
    for (int i = 0; i < 16; ++i) dtr[i] = P[(size_t)(b * SEQ + t0 + i) * LDP + C_DT + hd];
  }
  float wv[4][2];
#pragma unroll
  for (int k = 0; k < 4; ++k) { wv[k][0] = p.conv_w[k * 3072 + ch0]; wv[k][1] = p.conv_w[k * 3072 + ch0 + 1]; }
  const float b0 = p.conv_b[ch0], b1 = p.conv_b[ch0 + 1];
  float y0[16], y1[16];
#pragma unroll
  for (int i = 0; i < 16; ++i) {
    float a0 = b0, a1 = b1;
#pragma unroll
    for (int k = 0; k < 4; ++k) {
      a0 += wv[k][0] * __uint_as_float(raw[i + k] << 16);
      a1 += wv[k][1] * __uint_as_float(raw[i + k] & 0xffff0000u);
    }
    y0[i] = siluf_(a0); y1[i] = siluf_(a1);
    const unsigned pk = pk2(y0[i], y1[i]);
    if (ch0 >= 2048) *reinterpret_cast<unsigned*>(xc + (size_t)(b * SEQ + t0 + i) * 3072 + ch0) = pk;
  }
  if (isxb) {
    if (isx) {
      const float db = p.dt_bias[hd];
#pragma unroll
      for (int i = 0; i < 16; ++i) {
        const float dtv = softplusf_(bf2f(dtr[i]) + db);
        y0[i] *= dtv; y1[i] *= dtv;
      }
    }
    u16* d0 = xcT + ((size_t)b * 2560 + ch0) * TS + t0;
    *reinterpret_cast<s8v*>(d0) = pack8f(y0);
    *reinterpret_cast<s8v*>(d0 + 8) = pack8f(y0 + 8);
    *reinterpret_cast<s8v*>(d0 + TS) = pack8f(y1);
    *reinterpret_cast<s8v*>(d0 + TS + 8) = pack8f(y1 + 8);
  }
}
DI void dt_item(const Params& p, int it, float* sm) {
  const int tid = tidx(), hd = tid & 31, seg = tid >> 5;
  const int c = it & 15, b = it >> 4;
  const u16* P = (const u16*)(p.ws + O_P);
  float* dtb = (float*)(p.ws + O_DT);
  float* acs = (float*)(p.ws + O_ACS);
  const float db = p.dt_bias[hd];
  const float a = -expf(p.a_log[hd]);
  const int tbase = c * 128 + seg * 16;
  float v[16], cs[16];
#pragma unroll
  for (int i = 0; i < 16; ++i) v[i] = bf2f(P[(size_t)(b * SEQ + tbase + i) * LDP + C_DT + hd]);
  float run = 0.f;
#pragma unroll
  for (int i = 0; i < 16; ++i) { v[i] = softplusf_(v[i] + db); run += v[i] * a; cs[i] = run; }
  sm[seg * 32 + hd] = run;
  __syncthreads();
  float off = 0.f;
#pragma unroll
  for (int s2 = 0; s2 < 8; ++s2) off += (s2 < seg) ? sm[s2 * 32 + hd] : 0.f;
  float* d0 = dtb + ((size_t)b * 32 + hd) * SEQ + tbase;
  float* d1 = acs + ((size_t)b * 32 + hd) * SEQ + tbase;
#pragma unroll
  for (int i = 0; i < 4; ++i) {
    f4v x0 = {v[4 * i], v[4 * i + 1], v[4 * i + 2], v[4 * i + 3]};
    f4v x1 = {cs[4 * i] + off, cs[4 * i + 1] + off, cs[4 * i + 2] + off, cs[4 * i + 3] + off};
    *reinterpret_cast<f4v*>(d0 + 4 * i) = x0;
    *reinterpret_cast<f4v*>(d1 + 4 * i) = x1;
  }
  __syncthreads();
}
DI void vtr_item(const Params& p, int it) {
  const int tid = tidx();
  const int tb = it & 31, g = (it >> 5) & 3, b = (it >> 7) % NBG, kind = it / (128 * NBG);
  const u16* P = (const u16*)(p.ws + O_P);
  u16* dst = (u16*)(p.ws + (kind ? O_VWT : O_VST));
  const int d = tid & 63, tq = tid >> 6;
  const int t0 = tb * 64 + tq * 16;
  const int col = (kind ? C_VW : C_VS) + g * 64 + d;
  s8v v0, v1;
#pragma unroll
  for (int i = 0; i < 8; ++i) {
    v0[i] = (short)P[(size_t)(b * SEQ + t0 + i) * LDP + col];
    v1[i] = (short)P[(size_t)(b * SEQ + t0 + 8 + i) * LDP + col];
  }
  u16* o = dst + (((size_t)b * 4 + g) * 64 + d) * TS + t0;
  *reinterpret_cast<s8v*>(o) = v0;
  *reinterpret_cast<s8v*>(o + 8) = v1;
}
DI void cmp_item(const Params& p, int it, u16* sm) {
  const int tid = tidx(), lane = tid & 63, w = tid >> 6, l15 = lane & 15, quad = lane >> 4;
  const int jt = it & 7, g = (it >> 3) & 3, b = (it >> 5) % NBG, kind = it / (32 * NBG);
  const u16* P = (const u16*)(p.ws + O_P);
  const u16* W1 = (const u16*)(p.ws + (kind ? O_W1V : O_W1K));
  const u16* W2 = (const u16*)(p.ws + (kind ? O_W2V : O_W2K));
  const float* posb = (const float*)(p.ws + O_POSB) + kind * 256;
  const int col0 = (kind ? C_VC : C_KC) + g * 64;
  const int j = jt * 16 + l15;
  const bool rv = j < 127;
  const u16* arow = P + (size_t)(b * SEQ + (rv ? j : 0) * 16) * LDP + col0 + quad * 8;
  f4v hid[16];
#pragma unroll
  for (int nt = 0; nt < 16; ++nt) hid[nt] = fz();
  s8v zero8 = {0, 0, 0, 0, 0, 0, 0, 0};
#define CMP_LOAD(AF, BW, K2R)                                                                        \
  do {                                                                                               \
    const int _kk = 16 * w + (((K2R) + it) & 15);                        \
    const int _l = _kk >> 1, _d0 = (_kk & 1) * 32;                                                    \
    AF = rv ? ld8(arow + (size_t)_l * LDP + _d0) : zero8;                                             \
    const u16* _wb = W1 + (size_t)l15 * 2048 + _kk * 32 + quad * 8;                                   \
    _Pragma("unroll") for (int nt = 0; nt < 16; ++nt) BW[nt] = ld8(_wb + (size_t)nt * 16 * 2048);    \
  } while (0)
#define CMP_MMA(AF, BW)                                                                              \
  do {                                                                                               \
    _Pragma("unroll") for (int nt = 0; nt < 16; ++nt) hid[nt] = MFMA16(AF, BW[nt], hid[nt]);         \
  } while (0)
  {
    s8v a0, a1, b0[16], b1[16];
    CMP_LOAD(a0, b0, 0);
#pragma unroll 1
    for (int k2r = 0; k2r < 16; k2r += 2) {
      CMP_LOAD(a1, b1, k2r + 1);
      __builtin_amdgcn_sched_barrier(0);
      CMP_MMA(a0, b0);
      __builtin_amdgcn_sched_barrier(0);
      CMP_LOAD(a0, b0, k2r + 2);
      __builtin_amdgcn_sched_barrier(0);
      CMP_MMA(a1, b1);
      __builtin_amdgcn_sched_barrier(0);
    }
  }
#undef CMP_LOAD
#undef CMP_MMA
  float* red = reinterpret_cast<float*>(sm);
#pragma unroll
  for (int nt = 0; nt < 16; ++nt)
#pragma unroll
    for (int i = 0; i < 4; ++i) red[(w * 16 + quad * 4 + i) * 260 + nt * 16 + l15] = hid[nt][i];
  __syncthreads();
  u16 hb[16];
  {
    const float pb = posb[tid];
#pragma unroll
    for (int r = 0; r < 16; ++r) {
      const float v = red[r * 260 + tid] + red[(16 + r) * 260 + tid] + red[(32 + r) * 260 + tid] + red[(48 + r) * 260 + tid] + pb;
      hb[r] = f2bf(siluf_(v));
    }
  }
  __syncthreads();
  constexpr int HS = 264;
#pragma unroll
  for (int r = 0; r < 16; ++r) sm[r * HS + tid] = hb[r];
  __syncthreads();
  f4v res = fz();
#pragma unroll
  for (int ks = 0; ks < 8; ++ks) {
    const s8v a = ld8(sm + l15 * HS + ks * 32 + quad * 8);
    const s8v bw = ld8(W2 + (size_t)(w * 16 + l15) * 256 + ks * 32 + quad * 8);
    res = MFMA16(a, bw, res);
  }
  const int d = w * 16 + l15;
  const int jb = jt * 16 + quad * 4;
  if (kind == 0) {
    u16* kc = (u16*)(p.ws + O_KCMP) + ((size_t)(b * 4 + g) * 128) * 64;
#pragma unroll
    for (int i = 0; i < 4; ++i) kc[(size_t)(jb + i) * 64 + d] = (jb + i < 127) ? f2bf(res[i]) : (u16)0;
  } else {
    u16* vc = (u16*)(p.ws + O_VCT) + ((size_t)(b * 4 + g) * 64 + d) * 128 + jb;
    st4bf(vc, res[0], res[1], res[2], (jb + 3 < 127) ? res[3] : 0.f);
  }
  __syncthreads();
}

DI int q_next(unsigned* ctr) {
  __shared__ int q_slot;
  if (tidx() == 0) q_slot = (int)atomicAdd(ctr, 1u);
  __syncthreads();
  const int it = q_slot;
  __syncthreads();
  return it;
}
DI unsigned* q_counter(const Params& p, int pass, int phase, int rep) {
  return (unsigned*)(p.ws + O_BAR) + 3520 + 8 * (((pass * 4 + phase) * 2) + rep);
}

DI void phaseD(const Params& p, u16* smem, int sub, int pass, int rep) {
  constexpr int N_CMP = 2 * NBG * 32, N_CONV = NBG * 128 * 6, N_VTR = 2 * NBG * 128, N_DT = NBG * 16;
  constexpr int E1 = N_CONV, E2 = E1 + N_VTR, E3 = E2 + N_DT;
  const int ncb = ((int)gridDim.x >= 2 * N_CMP) ? N_CMP : 0;
  constexpr int TAIL = 320;
  int lo, hi, start, step;
  if (ncb == 0) {
    for (int it = blockIdx.x; it < N_CMP; it += gridDim.x)
      if (sub == 0 || sub == 1) cmp_item(p, it, smem);
    lo = 0; hi = E3; start = blockIdx.x; step = gridDim.x;
  } else if ((int)blockIdx.x < ncb) {
    if (sub == 0 || sub == 1) cmp_item(p, blockIdx.x, smem);
    lo = E3 - TAIL; hi = E3; start = lo + blockIdx.x; step = ncb;
  } else {
    lo = 0; hi = E3 - TAIL; start = (int)blockIdx.x - ncb; step = (int)gridDim.x - ncb;
  }
  for (int it = start; it < hi; it += step) {
    if (it < E1) { if (sub == 0 || sub == 2) conv_item(p, it); }
    else if (it < E2) { if (sub == 0 || sub == 3) vtr_item(p, it - E1); }
    else { if (sub == 0 || sub == 3) dt_item(p, it - E2, (float*)smem); }
  }
}

DI void ssd_item(const Params& p, int it, u16* sm) {
  const int tid = tidx(), lane = tid & 63, w = tid >> 6, l15 = lane & 15, quad = lane >> 4;
  const int qr = (it >> 3) & 3, cgx = ((it >> 5) << 3) | (it & 7);
  const int g = cgx & 3, c = (cgx >> 2) & 15, b = cgx >> 6;
  const int t0 = c * 128;
  const u16* xc = (const u16*)(p.ws + O_XC);
  const u16* xcT = (const u16*)(p.ws + O_XCT);
  const float* acsb = (const float*)(p.ws + O_ACS);
  const float* dtb = (const float*)(p.ws + O_DT);
  u16* yd = (u16*)(p.ws + O_YD);
  u16* stb = (u16*)(p.ws + O_ST);
  const u16* Bbase = xc + (size_t)(b * SEQ + t0) * 3072 + 2048 + g * 128;
  const u16* Cbase = xc + (size_t)(b * SEQ + t0) * 3072 + 2560 + g * 128;
  const u16* BT = xcT + ((size_t)b * 2560 + 2048 + g * 128) * TS + t0;
  const int h0 = g * 8 + qr * 2;
  constexpr int LS = 136;
  u16* Bs = sm;
  u16* Xs = sm + 128 * LS;
  float* As = reinterpret_cast<float*>(sm + 256 * LS);
  {
    s8v rb[8], rx[8];
#pragma unroll
    for (int r = 0; r < 8; ++r) {
      const int idx = tid + 256 * r, row = idx >> 4, seg = idx & 15;
      rb[r] = ld8(Bbase + (size_t)row * 3072 + seg * 8);
      rx[r] = ld8(xcT + ((size_t)b * 2560 + h0 * 64 + row) * TS + t0 + seg * 8);
    }
#pragma unroll
    for (int r = 0; r < 8; ++r) {
      const int idx = tid + 256 * r, row = idx >> 4, seg = idx & 15;
      *reinterpret_cast<s8v*>(Bs + row * LS + seg * 8) = rb[r];
      *reinterpret_cast<s8v*>(Xs + row * LS + seg * 8) = rx[r];
    }
    As[tid] = acsb[((size_t)b * 32 + h0 + (tid >> 7)) * SEQ + t0 + (tid & 127)];
  }
  __syncthreads();

#pragma unroll 1
  for (int li = 0; li < 2; ++li) {
    const int lt = li ? 7 - w : w;
    const int l = 16 * lt + l15;
    s8v cf[4];
#pragma unroll
    for (int ks = 0; ks < 4; ++ks) cf[ks] = ld8(Cbase + (size_t)l * 3072 + ks * 32 + quad * 8);
    f4v y[2][4];
#pragma unroll
    for (int hh = 0; hh < 2; ++hh)
#pragma unroll
      for (int pt = 0; pt < 4; ++pt) y[hh][pt] = fz();
    float acl[2];
#pragma unroll
    for (int hh = 0; hh < 2; ++hh) acl[hh] = As[hh * 128 + l];
    const int spn = lt >> 1;
    for (int sp = 0; sp <= spn; ++sp) {
      f4v cb[2];
#pragma unroll
      for (int si = 0; si < 2; ++si) {
        cb[si] = fz();
#pragma unroll
        for (int ks = 0; ks < 4; ++ks)
          cb[si] = MFMA16(ld8(Bs + (32 * sp + 16 * si + l15) * LS + ks * 32 + quad * 8), cf[ks], cb[si]);
      }
#pragma unroll
      for (int hh = 0; hh < 2; ++hh) {
        const float* ah = As + hh * 128;
        const f4v as0 = ldf4(ah + 32 * sp + quad * 4);
        const f4v as1 = ldf4(ah + 32 * sp + 16 + quad * 4);
        f4v m0, m1;
#pragma unroll
        for (int i = 0; i < 4; ++i) {
          const int s0 = 32 * sp + quad * 4 + i, s1 = s0 + 16;
          m0[i] = (s0 <= l) ? cb[0][i] * __expf(acl[hh] - as0[i]) : 0.f;
          m1[i] = (s1 <= l) ? cb[1][i] * __expf(acl[hh] - as1[i]) : 0.f;
        }
        const s8v pb = pack8(m0, m1);
#pragma unroll
        for (int pt = 0; pt < 4; ++pt) {
          const u16* xr = Xs + (hh * 64 + 16 * pt + l15) * LS + 32 * sp + quad * 4;
          y[hh][pt] = MFMA16(cat44(ld4(xr), ld4(xr + 16)), pb, y[hh][pt]);
        }
      }
    }
#pragma unroll
    for (int hh = 0; hh < 2; ++hh) {
      const float dinv = p.d_skip[h0 + hh] / dtb[((size_t)b * 32 + h0 + hh) * SEQ + t0 + l];
#pragma unroll
      for (int pt = 0; pt < 4; ++pt) {
#pragma unroll
        for (int i = 0; i < 4; ++i) y[hh][pt][i] += dinv * bf2f(Xs[(hh * 64 + 16 * pt + 4 * quad + i) * LS + l]);
      }
      u16* yrow = yd + (size_t)(b * SEQ + t0 + l) * 2048 + (h0 + hh) * 64;
      st8bf_pair(yrow, y[hh][0], y[hh][1], quad);
      st8bf_pair(yrow + 32, y[hh][2], y[hh][3], quad);
    }
  }
#pragma unroll 1
  for (int hh = 0; hh < 2; ++hh) {
    const int hd = h0 + hh;
    const float* ah = As + hh * 128;
    const float alast = ah[127];
    f4v st[2][4];
#pragma unroll
    for (int ni = 0; ni < 2; ++ni)
#pragma unroll
      for (int pt = 0; pt < 4; ++pt) st[ni][pt] = fz();
    s8v bt[4][2];
#pragma unroll
    for (int ks = 0; ks < 4; ++ks)
#pragma unroll
      for (int ni = 0; ni < 2; ++ni) bt[ks][ni] = ld8(BT + (size_t)(16 * (2 * w + ni) + l15) * TS + ks * 32 + quad * 8);
    __builtin_amdgcn_sched_barrier(0);
#pragma unroll
    for (int ks = 0; ks < 4; ++ks) {
      const f4v a0 = ldf4(ah + ks * 32 + quad * 8), a1 = ldf4(ah + ks * 32 + quad * 8 + 4);
      float wl[8];
#pragma unroll
      for (int j = 0; j < 4; ++j) { wl[j] = __expf(alast - a0[j]); wl[4 + j] = __expf(alast - a1[j]); }
#pragma unroll
      for (int pt = 0; pt < 4; ++pt) {
        const s8v raw = ld8(Xs + (hh * 64 + 16 * pt + l15) * LS + ks * 32 + quad * 8);
        float xf[8];
#pragma unroll
        for (int j = 0; j < 8; ++j) xf[j] = bfs(raw[j]) * wl[j];
        const s8v xw = pack8f(xf);
        st[0][pt] = MFMA16(bt[ks][0], xw, st[0][pt]);
        st[1][pt] = MFMA16(bt[ks][1], xw, st[1][pt]);
      }
    }
    u16* so = stb + (((size_t)(b * 16 + c) * 32 + hd) * 64) * 128;
#pragma unroll
    for (int pt = 0; pt < 4; ++pt) st8bf_pair(so + (size_t)(16 * pt + l15) * 128 + 32 * w, st[0][pt], st[1][pt], quad);
  }
  __syncthreads();
}

DI void cmpattn_item(const Params& p, int it, unsigned char* smraw) {
  const int tid = tidx(), lane = tid & 63, w = tid >> 6, l15 = lane & 15, quad = lane >> 4;
  const int tq2 = it & 63, g = (it >> 6) & 3, b = it >> 8;
  const int H = g * 4 + w;
  const float slope = exp2f(-0.5f * (float)(H + 1));
  const u16* P = (const u16*)(p.ws + O_P);
  const u16* kcg = (const u16*)(p.ws + O_KCMP) + (size_t)(b * 4 + g) * 128 * 64;
  const u16* vcg = (const u16*)(p.ws + O_VCT) + (size_t)(b * 4 + g) * 64 * 128;
  constexpr int KS = 72, VS = 136;
  u16* kcs = reinterpret_cast<u16*>(smraw);
  u16* vcs = kcs + 128 * KS;
  float* impA = reinterpret_cast<float*>(smraw + 36864);
  float* impB = impA + 2048;
  float* scl = impB + 2112;
  {
    s8v r0[4], r1[4];
#pragma unroll
    for (int r = 0; r < 4; ++r) {
      const int idx = tid + 256 * r;
      r0[r] = ld8(kcg + (size_t)(idx >> 3) * 64 + (idx & 7) * 8);
      r1[r] = ld8(vcg + (size_t)(idx >> 4) * 128 + (idx & 15) * 8);
    }
#pragma unroll
    for (int r = 0; r < 4; ++r) {
      const int idx = tid + 256 * r;
      *reinterpret_cast<s8v*>(kcs + (idx >> 3) * KS + (idx & 7) * 8) = r0[r];
      *reinterpret_cast<s8v*>(vcs + (idx >> 4) * VS + (idx & 15) * 8) = r1[r];
    }
  }
  __syncthreads();
#pragma unroll 1
  for (int sub = 0; sub < 2; ++sub) {
    const int q0 = tq2 * 32 + sub * 16;
    const int njt = (q0 >= 16) ? (((q0 - 16) >> 8) + 1) : 0;
    const int t = q0 + l15;
    const size_t trow = (size_t)(b * SEQ + t);
    s8v qf[2];
    qf[0] = ld8(P + trow * LDP + C_Q + H * 64 + quad * 8);
    qf[1] = ld8(P + trow * LDP + C_Q + H * 64 + 32 + quad * 8);
    f4v s[8];
#pragma unroll
    for (int jt = 0; jt < 8; ++jt) {
      s[jt] = fz();
      if (jt < njt) {
#pragma unroll
        for (int ks = 0; ks < 2; ++ks) s[jt] = MFMA16(ld8(kcs + (16 * jt + l15) * KS + ks * 32 + quad * 8), qf[ks], s[jt]);
      }
    }
    float mx = NEGB;
#pragma unroll
    for (int jt = 0; jt < 8; ++jt)
#pragma unroll
      for (int i = 0; i < 4; ++i) {
        const int j = 16 * jt + 4 * quad + i;
        const int dist = t - (16 * j + 31);
        const float sc = (dist >= 0) ? s[jt][i] * 0.125f - slope * (float)dist : NEGB;
        s[jt][i] = sc;
        mx = fmaxf(mx, sc);
      }
    mx = qmax(mx);
    float lsum = 0.f;
#pragma unroll
    for (int jt = 0; jt < 8; ++jt)
#pragma unroll
      for (int i = 0; i < 4; ++i) {
        const float e = (s[jt][i] > -1e29f) ? __expf(s[jt][i] - mx) : 0.f;
        s[jt][i] = e;
        lsum += e;
      }
    lsum = qsum(lsum);
    const float inv = lsum > 0.f ? 1.f / lsum : 0.f;
#pragma unroll
    for (int jt = 0; jt < 8; ++jt) {
      s[jt] = s[jt] * inv;
      const int k = 4 * jt + quad;
      impA[(w * 16 + l15) * 32 + k] = s[jt][0] + s[jt][1] + s[jt][2] + 0.5f * s[jt][3];
      impB[(w * 16 + l15) * 33 + k + 1] = 0.5f * s[jt][3];
    }
    f4v oc[4];
#pragma unroll
    for (int dt = 0; dt < 4; ++dt) oc[dt] = fz();
#pragma unroll
    for (int kp = 0; kp < 4; ++kp) {
      if (2 * kp < njt) {
        const s8v pb = pack8(s[2 * kp], s[2 * kp + 1]);
#pragma unroll
        for (int dt = 0; dt < 4; ++dt) {
          const u16* vr = vcs + (16 * dt + l15) * VS + 32 * kp + quad * 4;
          oc[dt] = MFMA16(cat44(ld4(vr), ld4(vr + 16)), pb, oc[dt]);
        }
      }
    }
    {
      const float g0 = sigmoidf_(bf2f(P[trow * LDP + C_G + H * 3 + 0]));
      u16* oo = (u16*)(p.ws + O_OCMP) + trow * 1024 + H * 64 + quad * 4;
#pragma unroll
      for (int dt = 0; dt < 4; ++dt) st4bf(oo + 16 * dt, oc[dt][0] * g0, oc[dt][1] * g0, oc[dt][2] * g0, oc[dt][3] * g0);
    }
    __syncthreads();
#pragma unroll
    for (int r = 0; r < 2; ++r) {
      const int idx = tid + 256 * r, q = idx >> 5, k = idx & 31;
      float im = 0.f;
#pragma unroll
      for (int hh = 0; hh < 4; ++hh) {
        im += impA[(hh * 16 + q) * 32 + k];
        if (k > 0) im += impB[(hh * 16 + q) * 33 + k];
      }
      const int blk = (q0 + q) >> 6;
      const bool forced = (k == 0) | (k == blk) | (k == blk - 1);
      scl[q * 32 + k] = forced ? im + 1000.f : ((k <= blk) ? im : -1.f);
    }
    __syncthreads();
    unsigned* sel = (unsigned*)(p.ws + O_SEL) + (size_t)(b * 4 + g) * SEQ + q0;
#pragma unroll
    for (int r = 0; r < 2; ++r) {
      const int idx = tid + 256 * r, q = idx >> 5, k = idx & 31;
      const float me = scl[q * 32 + k];
      int cnt = 0;
#pragma unroll
      for (int k2 = 0; k2 < 32; ++k2) {
        const float o = scl[q * 32 + k2];
        cnt += (o > me || (o == me && k2 < k)) ? 1 : 0;
      }
      const unsigned long long bal = __ballot(cnt < 16);
      if (k == 0) sel[q] = (unsigned)(bal >> (32 * (lane >> 5)));
    }
    __syncthreads();
  }
}

DI void phaseE(const Params& p, float* smf, int sub, int pass, int rep) {
  constexpr int N_SSD = NBG * 256;
  for (int it = blockIdx.x; it < N_SSD; it += gridDim.x) ssd_item(p, it, (u16*)smf);
}

DI void scan_item(const Params& p, int it) {
  const int gid = it * 256 + tidx();
  const int e = gid & 1023, hd = (gid >> 10) & 31, b = gid >> 15;
  u16* stb = (u16*)(p.ws + O_ST);
  const float* acs = (const float*)(p.ws + O_ACS) + ((size_t)b * 32 + hd) * SEQ;
  float carry[8];
#pragma unroll
  for (int j = 0; j < 8; ++j) carry[j] = 0.f;
  s8v sv[16];
  float dec[16];
#pragma unroll
  for (int c = 0; c < 16; ++c) {
    sv[c] = ld8(stb + (((size_t)(b * 16 + c) * 32 + hd) * 8192) + e * 8);
    dec[c] = acs[c * 128 + 127];
  }
#pragma unroll
  for (int c = 0; c < 16; ++c) {
    u16* ptr = stb + (((size_t)(b * 16 + c) * 32 + hd) * 8192) + e * 8;
    const float dc = __expf(dec[c]);
    const s8v pv = pack8f(carry);
#pragma unroll
    for (int j = 0; j < 8; ++j) carry[j] = carry[j] * dc + bfs(sv[c][j]);
    *reinterpret_cast<s8v*>(ptr) = pv;
  }
}

template <bool WIN, bool MASKED>
DI void attn_tile(const u16* Kt, const u16* Vt, const s8v (&qf)[2], const f4v (&cb)[4], int t, int kb, int q0, bool selb,
                  float slope2, float& m, float& l, f4v (&o)[4]) {
  const int lane = tidx() & 63, l15 = lane & 15, quad = lane >> 4;
  constexpr int LS = 72;
  const float bkb = slope2 * (float)(64 * kb - q0);
  f4v s[4];
#pragma unroll
  for (int kt = 0; kt < 4; ++kt) {
    s[kt] = cb[kt] + bkb;
    const u16* kr = Kt + (16 * kt + l15) * LS + quad * 8;
    s[kt] = MFMA16(ld8(kr), qf[0], s[kt]);
    s[kt] = MFMA16(ld8(kr + 32), qf[1], s[kt]);
  }
  if (MASKED) {
    const int dd0 = t - (64 * kb + 4 * quad);
#pragma unroll
    for (int kt = 0; kt < 4; ++kt)
#pragma unroll
      for (int i = 0; i < 4; ++i) {
        const int dd = dd0 - (16 * kt + i);
        const bool ok = WIN ? ((unsigned)dd < 512u) : (selb && dd >= 0);
        s[kt][i] = ok ? s[kt][i] : NEGB;
      }
  }
  float mx = fmaxf(fmaxf(fmaxf(s[0][0], s[0][1]), fmaxf(s[0][2], s[0][3])), fmaxf(fmaxf(s[1][0], s[1][1]), fmaxf(s[1][2], s[1][3])));
  mx = fmaxf(mx, fmaxf(fmaxf(fmaxf(s[2][0], s[2][1]), fmaxf(s[2][2], s[2][3])), fmaxf(fmaxf(s[3][0], s[3][1]), fmaxf(s[3][2], s[3][3]))));
  mx = qmax(mx);
  if (__ballot(mx > m + 6.f) != 0ull) {
    const float mn = fmaxf(m, mx);
    const float alpha = __builtin_amdgcn_exp2f(m - mn);
    m = mn;
    l *= alpha;
#pragma unroll
    for (int dt = 0; dt < 4; ++dt) o[dt] = o[dt] * alpha;
  }
  float ps = 0.f;
#pragma unroll
  for (int kt = 0; kt < 4; ++kt)
#pragma unroll
    for (int i = 0; i < 4; ++i) {
      float e = __builtin_amdgcn_exp2f(s[kt][i] - m);
      if (MASKED) e = (s[kt][i] > -1e29f) ? e : 0.f;
      s[kt][i] = e;
      ps += e;
    }
  l += ps;
#pragma unroll
  for (int kp = 0; kp < 2; ++kp) {
    const s8v pb = pack8(s[2 * kp], s[2 * kp + 1]);
#pragma unroll
    for (int dt = 0; dt < 4; ++dt) {
      const u16* vr = Vt + (16 * dt + l15) * LS + 32 * kp + quad * 4;
      o[dt] = MFMA16(cat44(ld4(vr), ld4(vr + 16)), pb, o[dt]);
    }
  }
}

template <bool WIN, int AV>
DI void attn_pass(const u16* __restrict__ Kbase  , const u16* __restrict__ VT  ,
                  const s8v (&qf)[2], const f4v (&cb)[4], int t, int q0, unsigned mymask, float slope2, unsigned tiles, f4v (&o)[4],
                  float& lout, u16* sm) {
  const int tid = tidx();
  constexpr int LS = 72, TB = 64 * LS;
  const int lrow = tid >> 3, lseg = tid & 7;
  const int blk = q0 >> 6;
  float m = NEGB, l = 0.f;
#pragma unroll
  for (int dt = 0; dt < 4; ++dt) o[dt] = fz();
  const u16* kp0 = Kbase + (size_t)lrow * LDP + lseg * 8;
  const u16* vp0 = VT + (size_t)lrow * TS + lseg * 8;
#define AT_LOAD(RK, RV, KB)                                                            \
  do {                                                                                 \
    RK[0] = ld8(kp0 + (size_t)(64 * (KB)) * LDP);                                       \
    RK[1] = ld8(kp0 + (size_t)(64 * (KB) + 32) * LDP);                                  \
    RV[0] = ld8(vp0 + 64 * (KB));                                                       \
    RV[1] = ld8(vp0 + (size_t)32 * TS + 64 * (KB));                                    \
  } while (0)
#define AT_STORE(RK, RV, BUF)                                                          \
  do {                                                                                 \
    u16* _d = sm + (BUF) * 2 * TB + lrow * LS + lseg * 8;                               \
    *reinterpret_cast<s8v*>(_d) = RK[0];                                                \
    *reinterpret_cast<s8v*>(_d + 32 * LS) = RK[1];                                      \
    *reinterpret_cast<s8v*>(_d + TB) = RV[0];                                           \
    *reinterpret_cast<s8v*>(_d + TB + 32 * LS) = RV[1];                                 \
  } while (0)
#define AT_POPL() do { if (tl) { kbl = 31 - __builtin_clz(tl); tl &= ~(1u << kbl); } } while (0)
#define AT_STEP(RK, RV)                                                                                              \
  {                                                                                                                  \
    const int kb = 31 - __builtin_clz(tc);                                                                            \
    tc &= ~(1u << kb);                                                                                                \
    const u16* Kt = sm + cur * 2 * TB;                                                                                \
    const bool selb = WIN ? true : (((mymask >> kb) & 1u) != 0u);                                                     \
    const bool need = WIN ? ((kb == blk) || (64 * kb <= q0 - 497)) : ((kb == blk) || (__ballot(selb) != ~0ull));      \
    if (AV != 2) {                                                                                                    \
    if (need) attn_tile<WIN, true>(Kt, Kt + TB, qf, cb, t, kb, q0, selb, slope2, m, l, o);                            \
    else attn_tile<WIN, false>(Kt, Kt + TB, qf, cb, t, kb, q0, selb, slope2, m, l, o);                                \
    }                                                                                                                 \
    if (AV != 1) {                                                                                                    \
    if (tc) AT_STORE(RK, RV, cur ^ 1);                                                                                \
    AT_POPL();                                                                                                        \
    AT_LOAD(RK, RV, kbl);                                                                                             \
    }                                                                                                                 \
    __syncthreads();                                                                                                  \
    if (!tc) break;                                                                                                   \
    cur ^= 1;                                                                                                         \
  }
  unsigned tc = tiles, tl = tiles;
  s8v ak[2], av[2], bk[2], bv[2];
  int kbl = 0;
  AT_POPL();
  AT_LOAD(ak, av, kbl);
  AT_STORE(ak, av, 0);
  AT_POPL();
  AT_LOAD(ak, av, kbl);
  AT_POPL();
  AT_LOAD(bk, bv, kbl);
  __syncthreads();
  int cur = 0;
  while (true) {
    AT_STEP(ak, av)
    AT_STEP(bk, bv)
  }
#undef AT_LOAD
#undef AT_STORE
#undef AT_POPL
#undef AT_STEP
  lout = qsum(l);
}

DI void cmp_part(const Params& p, int b, int g, int q0, const s8v (&qf)[2], unsigned char* smraw, f4v (&oc)[4], unsigned& mymask) {
  const int tid = tidx(), lane = tid & 63, w = tid >> 6, l15 = lane & 15, quad = lane >> 4;
  const int H = g * 4 + w;
  const float slope = exp2f(-0.5f * (float)(H + 1));
  const u16* P = (const u16*)(p.ws + O_P);
  const u16* kcg = (const u16*)(p.ws + O_KCMP) + (size_t)(b * 4 + g) * 128 * 64;
  const u16* vcg = (const u16*)(p.ws + O_VCT) + (size_t)(b * 4 + g) * 64 * 128;
  constexpr int KS = 72, VS = 136;
  u16* kcs = reinterpret_cast<u16*>(smraw);
  u16* vcs = kcs + 128 * KS;
  float* impA = reinterpret_cast<float*>(smraw + 36864);
  float* impB = impA + 2048;
  float* scl = impB + 2112;
  unsigned* selm = reinterpret_cast<unsigned*>(scl + 512);
  const int njt = (q0 >= 16) ? (((q0 - 16) >> 8) + 1) : 0;
  {
    s8v r0[4], r1[4];
#pragma unroll
    for (int r = 0; r < 4; ++r) {
      const int idx = tid + 256 * r;
      r0[r] = ld8(kcg + (size_t)(idx >> 3) * 64 + (idx & 7) * 8);
      r1[r] = ld8(vcg + (size_t)(idx >> 4) * 128 + (idx & 15) * 8);
    }
#pragma unroll
    for (int r = 0; r < 4; ++r) {
      const int idx = tid + 256 * r;
      *reinterpret_cast<s8v*>(kcs + (idx >> 3) * KS + (idx & 7) * 8) = r0[r];
      *reinterpret_cast<s8v*>(vcs + (idx >> 4) * VS + (idx & 15) * 8) = r1[r];
    }
  }
  __syncthreads();
  const int t = q0 + l15;
  const size_t trow = (size_t)(b * SEQ + t);
  f4v s[8];
#pragma unroll
  for (int jt = 0; jt < 8; ++jt) {
    s[jt] = fz();
    if (jt < njt) {
#pragma unroll
      for (int ks = 0; ks < 2; ++ks) s[jt] = MFMA16(ld8(kcs + (16 * jt + l15) * KS + ks * 32 + quad * 8), qf[ks], s[jt]);
    }
  }
  float mx = NEGB;
#pragma unroll
  for (int jt = 0; jt < 8; ++jt)
#pragma unroll
    for (int i = 0; i < 4; ++i) {
      const int j = 16 * jt + 4 * quad + i;
      const int dist = t - (16 * j + 31);
      const float sc = (dist >= 0) ? s[jt][i] * 0.125f - slope * (float)dist : NEGB;
      s[jt][i] = sc;
      mx = fmaxf(mx, sc);
    }
  mx = qmax(mx);
  float lsum = 0.f;
#pragma unroll
  for (int jt = 0; jt < 8; ++jt)
#pragma unroll
    for (int i = 0; i < 4; ++i) {
      const float e = (s[jt][i] > -1e29f) ? __expf(s[jt][i] - mx) : 0.f;
      s[jt][i] = e;
      lsum += e;
    }
  lsum = qsum(lsum);
  const float inv = lsum > 0.f ? 1.f / lsum : 0.f;
#pragma unroll
  for (int jt = 0; jt < 8; ++jt) {
    s[jt] = s[jt] * inv;
    const int k = 4 * jt + quad;
    impA[(w * 16 + l15) * 32 + k] = s[jt][0] + s[jt][1] + s[jt][2] + 0.5f * s[jt][3];
    impB[(w * 16 + l15) * 33 + k + 1] = 0.5f * s[jt][3];
  }
#pragma unroll
  for (int dt = 0; dt < 4; ++dt) oc[dt] = fz();
#pragma unroll
  for (int kp = 0; kp < 4; ++kp) {
    if (2 * kp < njt) {
      const s8v pb = pack8(s[2 * kp], s[2 * kp + 1]);
#pragma unroll
      for (int dt = 0; dt < 4; ++dt) {
        const u16* vr = vcs + (16 * dt + l15) * VS + 32 * kp + quad * 4;
        oc[dt] = MFMA16(cat44(ld4(vr), ld4(vr + 16)), pb, oc[dt]);
      }
    }
  }
  {
    const float g0 = sigmoidf_(bf2f(P[trow * LDP + C_G + H * 3 + 0]));
#pragma unroll
    for (int dt = 0; dt < 4; ++dt) oc[dt] = oc[dt] * g0;
  }
  __syncthreads();
#pragma unroll
  for (int r = 0; r < 2; ++r) {
    const int idx = tid + 256 * r, q = idx >> 5, k = idx & 31;
    float im = 0.f;
#pragma unroll
    for (int hh = 0; hh < 4; ++hh) {
      im += impA[(hh * 16 + q) * 32 + k];
      if (k > 0) im += impB[(hh * 16 + q) * 33 + k];
    }
    const int blk = (q0 + q) >> 6;
    const bool forced = (k == 0) | (k == blk) | (k == blk - 1);
    scl[q * 32 + k] = forced ? im + 1000.f : ((k <= blk) ? im : -1.f);
  }
  __syncthreads();
#pragma unroll
  for (int r = 0; r < 2; ++r) {
    const int idx = tid + 256 * r, q = idx >> 5, k = idx & 31;
    const float me = scl[q * 32 + k];
    int cnt = 0;
#pragma unroll
    for (int k2 = 0; k2 < 32; ++k2) {
      const float o = scl[q * 32 + k2];
      cnt += (o > me || (o == me && k2 < k)) ? 1 : 0;
    }
    const unsigned long long bal = __ballot(cnt < 16);
    if (k == 0) selm[q] = (unsigned)(bal >> (32 * (lane >> 5)));
  }
  __syncthreads();
  mymask = selm[l15];
  __syncthreads();
}

template <int AV>
DI void attn_item(const Params& p, int it, u16* sm) {
  const int tid = tidx(), lane = tid & 63, w = tid >> 6, l15 = lane & 15, quad = lane >> 4;
  const int tq = it & 127, g = (it >> 7) & 3, b = it >> 9;
  const int q0 = tq * 16;
  const int H = g * 4 + w;
  const float slope2 = exp2f(-0.5f * (float)(H + 1)) * 1.4426950408889634f;
  constexpr float SCALE2 = 0.125f * 1.4426950408889634f;
  const u16* P = (const u16*)(p.ws + O_P);
  const int t = q0 + l15;
  const size_t trow = (size_t)(b * SEQ + t);
  s8v qf[2], qraw[2];
#pragma unroll
  for (int ks = 0; ks < 2; ++ks) {
    const s8v raw = ld8(P + trow * LDP + C_Q + H * 64 + ks * 32 + quad * 8);
    qraw[ks] = raw;
    float qs[8];
#pragma unroll
    for (int j = 0; j < 8; ++j) qs[j] = bfs(raw[j]) * SCALE2;
    qf[ks] = pack8f(qs);
  }
  f4v ocm[4];
  unsigned mymask;
  cmp_part(p, b, g, q0, qraw, reinterpret_cast<unsigned char*>(sm), ocm, mymask);
  f4v cb[4];
#pragma unroll
  for (int kt = 0; kt < 4; ++kt)
#pragma unroll
    for (int i = 0; i < 4; ++i) cb[kt][i] = slope2 * (float)(16 * kt + 4 * quad + i);
  const int blk = q0 >> 6;
  const unsigned upto = (blk >= 31) ? 0xffffffffu : ((2u << blk) - 1u);
  unsigned um = mymask;
#pragma unroll
  for (int o = 1; o < 64; o <<= 1) um |= (unsigned)__shfl_xor((int)um, o);
  um = (unsigned)__builtin_amdgcn_readfirstlane((int)(um & upto));
  f4v os[4], ow[4];
  float ls, lw;
  attn_pass<false, AV>(P + (size_t)(b * SEQ) * LDP + C_KS + g * 64, (const u16*)(p.ws + O_VST) + (size_t)(b * 4 + g) * 64 * TS, qf, cb, t,
                   q0, mymask, slope2, um, os, ls, sm);
  const int wlo = (q0 - 511 > 0 ? q0 - 511 : 0) >> 6;
  const unsigned wm_ = (unsigned)__builtin_amdgcn_readfirstlane((int)(upto & ~((1u << wlo) - 1u)));
  attn_pass<true, AV>(P + (size_t)(b * SEQ) * LDP + C_KW + g * 64, (const u16*)(p.ws + O_VWT) + (size_t)(b * 4 + g) * 64 * TS, qf, cb, t,
                  q0, 0u, slope2, wm_, ow, lw, sm);
  if (AV != 0) { if (ls + lw + os[0][0] + ow[3][3] != 12345.678f) return; }
  const float g1 = sigmoidf_(bf2f(P[trow * LDP + C_G + H * 3 + 1])) / ls;
  const float g2 = sigmoidf_(bf2f(P[trow * LDP + C_G + H * 3 + 2])) / lw;
  const u16* za = P + trow * LDP + C_ZA + H * 64;
  u16* oo = (u16*)(p.ws + O_O) + trow * 1024 + H * 64;
  f4v rr[4];
  s4v zq[4];
  ld8bf_pair(za, quad, zq[0], zq[1]);
  ld8bf_pair(za + 32, quad, zq[2], zq[3]);
#pragma unroll
  for (int dt = 0; dt < 4; ++dt) {
#pragma unroll
    for (int i = 0; i < 4; ++i) rr[dt][i] = (ocm[dt][i] + g1 * os[dt][i] + g2 * ow[dt][i]) * siluf_(bfs(zq[dt][i]));
  }
  st8bf_pair(oo, rr[0], rr[1], quad);
  st8bf_pair(oo + 32, rr[2], rr[3], quad);
}

DI void phaseF(const Params& p, bool noscan, u16* sm, int pass, int rep) {
  constexpr int N_SC = NBG * 32 * 1024 / 256;
  const int xq = blockIdx.x & 7, lbq = blockIdx.x >> 3, nl = (int)gridDim.x >> 3;
  unsigned* ctr = q_counter(p, pass, 2, rep) + xq;
  const int nend = noscan ? 128 : 128 + N_SC / 8;
  bool first = true;
  while (true) {
    const int j = first ? lbq : q_next(ctr) + nl;
    first = false;
    if (j >= nend) break;
    if (j < 128) attn_item<0>(p, (xq >> 2) * 512 + (xq & 3) * 128 + (127 - j), sm);
    else scan_item(p, (j - 128) * 8 + xq);
  }
}

DI void phaseG(const Params& p, float* smf) {
  const int tid = tidx(), lane = tid & 63, w = tid >> 6, l15 = lane & 15, quad = lane >> 4;
  const u16* xc = (const u16*)(p.ws + O_XC);
  const u16* P = (const u16*)(p.ws + O_P);
  const u16* yd = (const u16*)(p.ws + O_YD);
  const u16* stb = (const u16*)(p.ws + O_ST);
  const float* acsb = (const float*)(p.ws + O_ACS);
  u16* yn = (u16*)(p.ws + O_YN);
  for (int it = blockIdx.x; it < NBG * 256; it += gridDim.x) {
    const int lq = (it >> 3) & 3, cgx = ((it >> 5) << 3) | (it & 7);
    const int g = cgx & 3, c = (cgx >> 2) & 15, b = cgx >> 6;
    const int t0 = b * SEQ + c * 128 + 32 * lq + l15;
    s8v cf[2][4];
#pragma unroll
    for (int li = 0; li < 2; ++li)
#pragma unroll
      for (int ks = 0; ks < 4; ++ks) cf[li][ks] = ld8(xc + (size_t)(t0 + 16 * li) * 3072 + 2560 + g * 128 + ks * 32 + quad * 8);
    f4v y[2][4][2];
    f4v* park = reinterpret_cast<f4v*>(smf + 1024);
    float ss[2] = {0.f, 0.f};
#pragma unroll
    for (int hh = 0; hh < 2; ++hh) {
      const int hd = g * 8 + 2 * w + hh;
      const u16* pv = stb + (((size_t)(b * 16 + c) * 32 + hd) * 64) * 128;
      s8v pf[4][4];
      s4v d4[4], z4[4];
#pragma unroll
      for (int pt = 0; pt < 4; ++pt) {
#pragma unroll
        for (int ks = 0; ks < 4; ++ks) pf[pt][ks] = ld8(pv + (size_t)(16 * pt + l15) * 128 + ks * 32 + quad * 8);
      }
#pragma unroll
      for (int pp = 0; pp < 2; ++pp) {
        ld8bf_pair(yd + (size_t)t0 * 2048 + hd * 64 + 32 * pp, quad, d4[2 * pp], d4[2 * pp + 1]);
        ld8bf_pair(P + (size_t)t0 * LDP + C_Z + hd * 64 + 32 * pp, quad, z4[2 * pp], z4[2 * pp + 1]);
      }
      float ea[2];
#pragma unroll
      for (int li = 0; li < 2; ++li) ea[li] = __expf(acsb[((size_t)b * 32 + hd) * SEQ + (t0 + 16 * li - b * SEQ)]);
      __builtin_amdgcn_sched_barrier(0);
#pragma unroll
      for (int pt = 0; pt < 4; ++pt) {
        y[hh][pt][0] = fz(); y[hh][pt][1] = fz();
#pragma unroll
        for (int ks = 0; ks < 4; ++ks) {
          y[hh][pt][0] = MFMA16(pf[pt][ks], cf[0][ks], y[hh][pt][0]);
          y[hh][pt][1] = MFMA16(pf[pt][ks], cf[1][ks], y[hh][pt][1]);
        }
      }
      __builtin_amdgcn_sched_barrier(0);
      s4v d5[4], z5[4];
#pragma unroll
      for (int pp = 0; pp < 2; ++pp) {
        ld8bf_pair(yd + (size_t)(t0 + 16) * 2048 + hd * 64 + 32 * pp, quad, d5[2 * pp], d5[2 * pp + 1]);
        ld8bf_pair(P + (size_t)(t0 + 16) * LDP + C_Z + hd * 64 + 32 * pp, quad, z5[2 * pp], z5[2 * pp + 1]);
      }
      __builtin_amdgcn_sched_barrier(0);
#pragma unroll
      for (int pt = 0; pt < 4; ++pt)
#pragma unroll
        for (int i = 0; i < 4; ++i) {
          const float v = (bfs(d4[pt][i]) + y[hh][pt][0][i] * ea[0]) * siluf_(bfs(z4[pt][i]));
          y[hh][pt][0][i] = v;
          ss[0] += v * v;
        }
      __builtin_amdgcn_sched_barrier(0);
#pragma unroll
      for (int pt = 0; pt < 4; ++pt)
#pragma unroll
        for (int i = 0; i < 4; ++i) {
          const float v = (bfs(d5[pt][i]) + y[hh][pt][1][i] * ea[1]) * siluf_(bfs(z5[pt][i]));
          y[hh][pt][1][i] = v;
          ss[1] += v * v;
        }
      if (hh == 0) {
#pragma unroll
        for (int pt = 0; pt < 4; ++pt) { park[(2 * pt) * 256 + tid] = y[0][pt][0]; park[(2 * pt + 1) * 256 + tid] = y[0][pt][1]; }
      }
    }
    ss[0] = qsum(ss[0]); ss[1] = qsum(ss[1]);
    if (quad == 0) { smf[w * 32 + l15] = ss[0]; smf[w * 32 + 16 + l15] = ss[1]; }
    f4v gnv[2][4];
#pragma unroll
    for (int hh = 0; hh < 2; ++hh)
#pragma unroll
      for (int pt = 0; pt < 4; ++pt) gnv[hh][pt] = ldf4(p.g_ssm_norm + (g * 8 + 2 * w + hh) * 64 + 16 * pt + quad * 4);
    __syncthreads();
    float rs[2];
#pragma unroll
    for (int li = 0; li < 2; ++li) {
      const float tot = smf[16 * li + l15] + smf[32 + 16 * li + l15] + smf[64 + 16 * li + l15] + smf[96 + 16 * li + l15];
      rs[li] = rsqrtf(tot * (1.f / 512.f) + EPS);
    }
#pragma unroll
    for (int hh = 0; hh < 2; ++hh) {
      const int hd = g * 8 + 2 * w + hh;
#pragma unroll
      for (int li = 0; li < 2; ++li) {
        f4v nv[4];
#pragma unroll
        for (int pt = 0; pt < 4; ++pt) {
          const f4v v = (hh == 0) ? park[(2 * pt + li) * 256 + tid] : y[1][pt][li];
          nv[pt] = v * gnv[hh][pt] * rs[li];
        }
        u16* nrow = yn + (size_t)(t0 + 16 * li) * 2048 + hd * 64;
        st8bf_pair(nrow, nv[0], nv[1], quad);
        st8bf_pair(nrow + 32, nv[2], nv[3], quad);
      }
    }
    __syncthreads();
  }
}

DI void phaseH(const Params& p, u16* smem) {
  const int lane = tidx() & 63, w = tidx() >> 6, wm = w >> 1, wn = w & 1, l15 = lane & 15, quad = lane >> 4;
  const u16* P = (const u16*)(p.ws + O_P);
  u16* mg = (u16*)(p.ws + O_H);
  float* tmp = (float*)(p.ws + O_YD);
  constexpr int MT = MP / 128;
  for (int it = blockIdx.x; it < MT * 16; it += gridDim.x) {
    const int mi = it % MT, ni = it / MT;
    f4v acc[4][2];
    u2v keep[4][2];
    zero_acc<2>(acc);
    gemm_k64(acc, (const u16*)(p.ws + O_YN), 2048, (const u16*)(p.ws + O_WSSM), 2048, 2048, mi * 128, ni * 64, smem);
    s4v gq[4][2];
#pragma unroll
    for (int mt = 0; mt < 4; ++mt)
      ld8bf_pair(P + (size_t)(mi * 128 + wm * 64 + mt * 16 + l15) * LDP + C_MG + ni * 64 + wn * 32, quad, gq[mt][0], gq[mt][1]);
    __builtin_amdgcn_sched_barrier(0);
#pragma unroll
    for (int mt = 0; mt < 4; ++mt)
#pragma unroll
      for (int nt = 0; nt < 2; ++nt) {
        const int m = mi * 128 + wm * 64 + mt * 16 + l15, n = ni * 64 + wn * 32 + nt * 16 + quad * 4;
        const s4v g0 = gq[mt][nt];
        f4v r;
#pragma unroll
        for (int i = 0; i < 4; ++i) r[i] = sigmoidf_(bfs(g0[i])) * acc[mt][nt][i];
        u2v kp = {pk2(r[0], r[1]), pk2(r[2], r[3])};
        keep[mt][nt] = kp;
      }
    zero_acc<2>(acc);
    gemm_k64(acc, (const u16*)(p.ws + O_O), 1024, (const u16*)(p.ws + O_WNSA), 1024, 1024, mi * 128, ni * 64, smem);
    f4v tq[4][2];
#pragma unroll
    for (int mt = 0; mt < 4; ++mt)
      ld8bf_pair(P + (size_t)(mi * 128 + wm * 64 + mt * 16 + l15) * LDP + C_MG + 1024 + ni * 64 + wn * 32, quad, gq[mt][0], gq[mt][1]);
#pragma unroll
    for (int mt = 0; mt < 4; ++mt)
#pragma unroll
      for (int nt = 0; nt < 2; ++nt) {
        const u2v kp = keep[mt][nt];
        f4v tv = {__uint_as_float(kp[0] << 16), __uint_as_float(kp[0] & 0xffff0000u), __uint_as_float(kp[1] << 16),
                  __uint_as_float(kp[1] & 0xffff0000u)};
        tq[mt][nt] = tv;
      }
    __builtin_amdgcn_sched_barrier(0);
#pragma unroll
    for (int mt = 0; mt < 4; ++mt) {
      f4v rr[2];
#pragma unroll
      for (int nt = 0; nt < 2; ++nt) {
        const s4v g1 = gq[mt][nt];
        const f4v t0 = tq[mt][nt];
#pragma unroll
        for (int i = 0; i < 4; ++i) rr[nt][i] = t0[i] + sigmoidf_(bfs(g1[i])) * acc[mt][nt][i];
      }
      st8bf_pair(mg + (size_t)(mi * 128 + wm * 64 + mt * 16 + l15) * 1024 + ni * 64 + wn * 32, rr[0], rr[1], quad);
    }
  }
}

DI void phaseI(const Params& p, u16* smem) {
  const int lane = tidx() & 63, w = tidx() >> 6, wm = w >> 1, wn = w & 1, l15 = lane & 15, quad = lane >> 4;
  u16* outb = (u16*)(p.ws + O_OUTF);
  float* rsq = (float*)(p.ws + O_RSQ);
  constexpr int MT = MP / 128;
  for (int it = blockIdx.x; it < MT * 16; it += gridDim.x) {
    const int mi = it % MT, ni = it / MT;
    f4v acc[4][2];
    zero_acc<2>(acc);
    gemm_k64(acc, (const u16*)(p.ws + O_H), 1024, (const u16*)(p.ws + O_WOUT), 1024, 1024, mi * 128, ni * 64, smem);
#pragma unroll
    for (int mt = 0; mt < 4; ++mt) {
      const int m = mi * 128 + wm * 64 + mt * 16 + l15;
      float ss = 0.f;
#pragma unroll
      for (int nt = 0; nt < 2; ++nt) {
        const f4v v = acc[mt][nt];
        ss += v[0] * v[0] + v[1] * v[1] + v[2] * v[2] + v[3] * v[3];
      }
      st8bf_pair(outb + (size_t)m * 1024 + ni * 64 + wn * 32, acc[mt][0], acc[mt][1], quad);
      ss = qsum(ss);
      if (quad == 0) rsq[(size_t)m * 32 + ni * 2 + wn] = ss;
    }
  }
}

DI void phaseJ(const Params& p, int pass) {
  const int tid = tidx(), lane = tid & 63, w = tid >> 6;
  const u16* outb = (const u16*)(p.ws + O_OUTF);
  const float* rsq = (const float*)(p.ws + O_RSQ);
  const float* ada = (const float*)(p.ws + O_ADA);
  for (int it = blockIdx.x; it < MP / 4; it += gridDim.x) {
    const int r = it * 4 + w;
    const int tg = pass * MP + r, b = tg >> 11;
    float part = (lane < 32) ? rsq[(size_t)r * 32 + lane] : 0.f;
    s4v ob[4];
    f4v xv[4], gp[4], gt[4];
#pragma unroll
    for (int i = 0; i < 4; ++i) {
      const int c0 = i * 256 + lane * 4;
      ob[i] = ld4(outb + (size_t)r * 1024 + c0);
      xv[i] = ldf4(p.x + (size_t)tg * 1024 + c0);
      gp[i] = ldf4(p.g_post + c0);
      gt[i] = ldf4(ada + b * 3072 + 2048 + c0);
    }
    __builtin_amdgcn_sched_barrier(0);
#pragma unroll
    for (int o = 1; o < 64; o <<= 1) part += __shfl_xor(part, o);
    const float rstd = rsqrtf(part * (1.f / 1024.f) + EPS);
#pragma unroll
    for (int i = 0; i < 4; ++i) {
      const int c0 = i * 256 + lane * 4;
      f4v rr;
#pragma unroll
      for (int k = 0; k < 4; ++k) rr[k] = xv[i][k] + gt[i][k] * (bfs(ob[i][k]) * rstd * gp[i][k]);
      *reinterpret_cast<f4v*>(p.out + (size_t)tg * 1024 + c0) = rr;
    }
  }
}

#define XB_TMO      128
#define XB_XCNT(j)  (256  + 64 * (j))
#define XB_XSUB(j)  (1280 + 64 * (j))
#define XB_XGEN(j)  (2304 + 64 * (j))
#define XB_TOP      3328
#define XB_TOPGEN   3392
#define XCD_BAR_WORDS 3456
#define XB_SPIN_CAP (1u << 18)
#define LAS __attribute__((address_space(3)))
DI unsigned xb_ld(unsigned* p)              { return __hip_atomic_load(p, __ATOMIC_RELAXED, __HIP_MEMORY_SCOPE_AGENT); }
DI unsigned xb_add(unsigned* p, unsigned v) { return __hip_atomic_fetch_add(p, v, __ATOMIC_RELAXED, __HIP_MEMORY_SCOPE_AGENT); }
DI unsigned xb_xcc_id() { return (unsigned)__builtin_amdgcn_s_getreg((3 << 11) | 20) & 0xFu; }
#define XB_SPIN(cond, bar) do { unsigned _sp = 0; while (cond) { __builtin_amdgcn_s_sleep(1); \
    if ((++_sp & 255u) == 0u) { if (xb_ld(&(bar)[XB_TMO])) break; if (_sp > XB_SPIN_CAP) { atomicAdd(&(bar)[XB_TMO], 1u); break; } } } } while (0)
struct XcdBarrier { unsigned* bar; unsigned x; volatile LAS unsigned* st; };
DI XcdBarrier xcd_barrier_post(unsigned* bar, volatile LAS unsigned* st) {
  XcdBarrier b; b.bar = bar; b.x = xb_xcc_id(); b.st = st;
  if (threadIdx.x == 0) (void)xb_add(&bar[XB_XCNT(b.x)], 1u);
  return b;
}
DI void xcd_barrier_complete(unsigned* bar, unsigned x, unsigned& nloc, unsigned& nx) {
  const unsigned G = gridDim.x * gridDim.y * gridDim.z;
  unsigned sum, cnt, mine, sp = 0u;
  for (;;) {
    sum = 0u; cnt = 0u; mine = 0u;
#pragma unroll
    for (unsigned j = 0; j < 16; ++j) { const unsigned c = xb_ld(&bar[XB_XCNT(j)]); sum += c; cnt += (c > 0u) ? 1u : 0u; mine = (j == x) ? c : mine; }
    if (sum == G) break;
    __builtin_amdgcn_s_sleep(1);
    if ((++sp & 255u) == 0u) { if (xb_ld(&bar[XB_TMO])) break; if (sp > XB_SPIN_CAP) { atomicAdd(&bar[XB_TMO], 1u); break; } }
  }
  nloc = mine > 0u ? mine : 1u; nx = cnt > 0u ? cnt : 1u;
}
DI void xcd_barrier(const XcdBarrier& b) {
  asm volatile("s_waitcnt vmcnt(0)" ::: "memory");
  __syncthreads();
  if (threadIdx.x == 0) {
    unsigned* bar = b.bar;
    __builtin_amdgcn_s_waitcnt(0);
    unsigned nloc = b.st[0], nx = b.st[1];
    if (nloc == 0u) { xcd_barrier_complete(bar, b.x, nloc, nx); b.st[0] = nloc; b.st[1] = nx; }
    const unsigned old = xb_add(&bar[XB_XSUB(b.x)], 1u);
    const unsigned gen = old / nloc;
    if (old + 1u == (gen + 1u) * nloc) {
      __builtin_amdgcn_fence(__ATOMIC_RELEASE, "agent");
      asm volatile("s_waitcnt vmcnt(0)" ::: "memory");
      const unsigned og = xb_add(&bar[XB_TOP], 1u);
      const unsigned tg = og / nx;
      if (og + 1u == (tg + 1u) * nx) xb_add(&bar[XB_TOPGEN], 1u);
      else XB_SPIN(xb_ld(&bar[XB_TOPGEN]) == tg, bar);
      __builtin_amdgcn_fence(__ATOMIC_ACQUIRE, "agent");
      xb_add(&bar[XB_XGEN(b.x)], 1u);
      asm volatile("s_waitcnt vmcnt(0)" ::: "memory");
    } else {
      XB_SPIN(xb_ld(&bar[XB_XGEN(b.x)]) == gen, bar);
      __builtin_amdgcn_fence(__ATOMIC_ACQUIRE, "agent");
      asm volatile("s_waitcnt vmcnt(0)" ::: "memory");
    }
  }
  __syncthreads();
}

constexpr int PH_PER_PASS = 8;
constexpr int N_PHASES = 2 + NPASS * PH_PER_PASS;

constexpr int REP_MASK = 0;
constexpr int REP_SUB = 0;
constexpr int REP_A = 0;
constexpr int CPROBE = 0;
__global__ void __launch_bounds__(256, 2) mega_kernel(Params p, int ph_lo, int ph_hi) {
  __shared__ __attribute__((aligned(16))) unsigned char smem[73728];
  __shared__ uint4 xb_words;
  cg::grid_group grid = cg::this_grid();
  if (threadIdx.x == 0) xb_words = make_uint4(0u, 0u, 0u, 0u);
  __syncthreads();
  const XcdBarrier xb = xcd_barrier_post((unsigned*)(p.ws + O_BAR), (volatile LAS unsigned*)&xb_words);
  for (int ph = ph_lo; ph < ph_hi; ++ph) {
    if (ph == 0) {
      phaseA(p, smem);
      if (REP_A) { xcd_barrier(xb); phaseA(p, smem); }
    } else if (ph == 1) {
      phaseB(p, 0);
    } else {
      const int pass = (ph - 2) / PH_PER_PASS, k = (ph - 2) % PH_PER_PASS;
      Params q = p;
      const int nrep = ((REP_MASK >> k) & 1) ? 2 : 1;
      for (int rep = 0; rep < nrep; ++rep) {
        if (rep) xcd_barrier(xb);
        if (rep && REP_SUB == 9) continue;
        switch (k) {
          case 0: if (REP_MASK != 0 && rep) phaseC<CPROBE>(q, (u16*)smem); else phaseC<0>(q, (u16*)smem); break;
          case 1: phaseD(q, (u16*)smem, rep ? REP_SUB : 0, pass, rep); break;
          case 2: phaseE(q, (float*)smem, rep ? REP_SUB : 0, pass, rep); break;
          case 3: phaseF(q, rep > 0, (u16*)smem, pass, rep); break;
          case 4: phaseG(q, (float*)smem); break;
          case 5: phaseH(q, (u16*)smem); break;
          case 6: phaseI(q, (u16*)smem); break;
          default:
            phaseJ(q, pass);
            if (pass + 1 < NPASS) phaseB(q, pass + 1);
            break;
        }
      }
    }
    if (ph + 1 < ph_hi) {
      if (ph_hi < 0) grid.sync();
      xcd_barrier(xb);
    }
  }
}

extern "C" void kernel_launch(void* const* d_in, const int* in_sizes, int n_in, void* d_out, int out_size, void* d_ws,
                              size_t ws_size, hipStream_t stream) {
  static int grid_blocks = 0;
  if (!grid_blocks) {
    int dev = 0, cus = 0, per_cu = 0;
    hipGetDevice(&dev);
    hipDeviceGetAttribute(&cus, hipDeviceAttributeMultiprocessorCount, dev);
    hipOccupancyMaxActiveBlocksPerMultiprocessor(&per_cu, mega_kernel, 256, 0);
    if (per_cu < 1) per_cu = 1;
    if (per_cu > 2) per_cu = 2;
    grid_blocks = cus * per_cu;
  }
  if (ws_size < O_END) { fprintf(stderr, "workspace too small: %zu < %zu\n", ws_size, (size_t)O_END); return; }
  Params p{};
  const float** pp = reinterpret_cast<const float**>(&p);
  for (int i = 0; i < 22; ++i) pp[i] = (const float*)d_in[i];
  p.out = (float*)d_out;
  p.ws = (unsigned char*)d_ws;
  hipMemsetAsync((unsigned char*)d_ws + O_BAR, 0, 16384, stream);
  int lo = 0, hi = N_PHASES;
  void* args[] = {&p, &lo, &hi};
  hipError_t e = hipLaunchCooperativeKernel((void*)mega_kernel, dim3(grid_blocks), dim3(256), args, 0, stream);
  if (e != hipSuccess) fprintf(stderr, "cooperative launch failed: %s (grid %d)\n", hipGetErrorString(e), grid_blocks);
}
```

```cpp
#include <hip/hip_runtime.h>
#include <hip/hip_cooperative_groups.h>
#include <cstdio>
namespace cg = cooperative_groups;

typedef unsigned short u16;
typedef short s8v __attribute__((ext_vector_type(8)));
typedef short s4v __attribute__((ext_vector_type(4)));
typedef float f4v __attribute__((ext_vector_type(4)));
#define DI __device__ __forceinline__
#define MFMA16(a, b, c) __builtin_amdgcn_mfma_f32_16x16x32_bf16((a), (b), (c), 0, 0, 0)

constexpr int SEQ = 2048, DM = 1024, NB = 8;
constexpr int TS = SEQ + 64;
constexpr int NBG = 2;
constexpr int MP = NBG * SEQ;
constexpr int NPASS = NB / NBG;
constexpr int NIN = 10832, LDP = 10880;
constexpr int C_Z = 0, C_XBC = 2048, C_DT = 5120, C_Q = 5152, C_KC = 6176, C_VC = 6432, C_KS = 6688, C_VS = 6944,
              C_KW = 7200, C_VW = 7456, C_G = 7712, C_ZA = 7760, C_MG = 8784;
constexpr float EPS = 1e-6f;
constexpr float NEGB = -1e30f;
constexpr int APROBE = 0;

constexpr size_t al256(size_t x) { return (x + 255) & ~size_t(255); }
constexpr size_t O_WIN = 0;
constexpr size_t O_WSSM = O_WIN + al256((size_t)LDP * 1024 * 2);
constexpr size_t O_WNSA = O_WSSM + al256((size_t)1024 * 2048 * 2);
constexpr size_t O_WOUT = O_WNSA + al256((size_t)1024 * 1024 * 2);
constexpr size_t O_W1K = O_WOUT + al256((size_t)1024 * 1024 * 2);
constexpr size_t O_W1V = O_W1K + al256((size_t)256 * 2048 * 2);
constexpr size_t O_W2K = O_W1V + al256((size_t)256 * 2048 * 2);
constexpr size_t O_W2V = O_W2K + al256((size_t)64 * 256 * 2);
constexpr size_t O_POSB = O_W2V + al256((size_t)64 * 256 * 2);
constexpr size_t O_ADA = O_POSB + al256(2 * 256 * 4);
constexpr size_t O_H = O_ADA + al256((size_t)8 * 3072 * 4);
constexpr size_t O_P = O_H + al256((size_t)MP * 1024 * 2);
constexpr size_t O_XC = O_P + al256((size_t)MP * LDP * 2);
constexpr size_t O_XCT = O_XC + al256((size_t)MP * 3072 * 2);
constexpr size_t O_DT = O_XCT + al256((size_t)NBG * 2560 * TS * 2);
constexpr size_t O_ACS = O_DT + al256((size_t)NBG * 32 * 2048 * 4);
constexpr size_t O_ST = O_ACS + al256((size_t)NBG * 32 * 2048 * 4);
constexpr size_t O_YD = O_ST + al256((size_t)NBG * 16 * 32 * 64 * 128 * 2);
constexpr size_t O_YN = O_YD;
constexpr size_t O_KCMP = O_YD + al256((size_t)MP * 2048 * 2);
constexpr size_t O_VCT = O_KCMP + al256((size_t)NBG * 4 * 128 * 64 * 2);
constexpr size_t O_VST = O_VCT + al256((size_t)NBG * 4 * 128 * 64 * 2);
constexpr size_t O_VWT = O_VST + al256((size_t)NBG * 4 * 64 * TS * 2);
constexpr size_t O_SEL = O_VWT + al256((size_t)NBG * 4 * 64 * TS * 2);
constexpr size_t O_OCMP = O_SEL + al256((size_t)NBG * 4 * 2048 * 4);
constexpr size_t O_O = O_XCT;
constexpr size_t O_BAR = O_OCMP + al256((size_t)MP * 1024 * 2);
constexpr size_t O_END = O_BAR + 16384;
static_assert(O_END <= (size_t)256 * 1024 * 1024, "workspace map must fit the guaranteed 256 MiB");
constexpr size_t O_OUTF = O_P;
constexpr size_t O_RSQ = O_P + al256((size_t)MP * 1024 * 4);

struct Params {
  const float *x, *c, *w_ada, *b_ada, *g_pre, *g_post, *w_in, *conv_w, *conv_b, *dt_bias, *a_log, *d_skip, *g_ssm_norm,
      *w_ssm_out, *cmp_pos_k, *cmp_w1_k, *cmp_w2_k, *cmp_pos_v, *cmp_w1_v, *cmp_w2_v, *w_nsa_out, *w_out;
  float* out;
  unsigned char* ws;
};

DI u16 f2bf(float f) { unsigned u = __float_as_uint(f); u += 0x7fffu + ((u >> 16) & 1u); return (u16)(u >> 16); }
DI float bf2f(u16 h) { return __uint_as_float(((unsigned)h) << 16); }
DI float bfs(short h) { return __uint_as_float(((unsigned)(u16)h) << 16); }
DI s8v ld8(const u16* p) { return *reinterpret_cast<const s8v*>(p); }
DI s4v ld4(const u16* p) { return *reinterpret_cast<const s4v*>(p); }
DI f4v ldf4(const float* p) { return *reinterpret_cast<const f4v*>(p); }
DI f4v ldf4_nt(const float* p) { return __builtin_nontemporal_load(reinterpret_cast<const f4v*>(p)); }
DI void stf4_nt(float* p, f4v v) { __builtin_nontemporal_store(v, reinterpret_cast<f4v*>(p)); }
typedef __bf16 bf2v __attribute__((ext_vector_type(2)));
typedef float f2v __attribute__((ext_vector_type(2)));
typedef unsigned u2v __attribute__((ext_vector_type(2)));
typedef unsigned u4v __attribute__((ext_vector_type(4)));
DI unsigned pk2(float a, float b) {
  f2v v = {a, b};
  return __builtin_bit_cast(unsigned, __builtin_convertvector(v, bf2v));
}
DI void st4bf(u16* p, float a, float b, float c, float d) {
  u2v v = {pk2(a, b), pk2(c, d)};
  *reinterpret_cast<u2v*>(p) = v;
}
DI void st8bf_pair(u16* p, f4v a, f4v b, int quad) {
  unsigned ax = pk2(a[0], a[1]), ay = pk2(a[2], a[3]), bx = pk2(b[0], b[1]), by = pk2(b[2], b[3]);
  const auto r0 = __builtin_amdgcn_permlane16_swap(ax, bx, false, false);
  const auto r1 = __builtin_amdgcn_permlane16_swap(ay, by, false, false);
  u4v v = {r0[0], r1[0], r0[1], r1[1]};
  *reinterpret_cast<u4v*>(p + (quad & 1) * 16 + (quad >> 1) * 8) = v;
}
DI void ld8bf_pair(const u16* p, int quad, s4v& a, s4v& b) {
  const u4v x = *reinterpret_cast<const u4v*>(p + (quad & 1) * 16 + (quad >> 1) * 8);
  const auto r0 = __builtin_amdgcn_permlane16_swap(x[0], x[2], false, false);
  const auto r1 = __builtin_amdgcn_permlane16_swap(x[1], x[3], false, false);
  u2v ua = {r0[0], r1[0]}, ub = {r0[1], r1[1]};
  a = __builtin_bit_cast(s4v, ua);
  b = __builtin_bit_cast(s4v, ub);
}
DI s8v pack8(f4v a, f4v b) {
  u4v v = {pk2(a[0], a[1]), pk2(a[2], a[3]), pk2(b[0], b[1]), pk2(b[2], b[3])};
  return __builtin_bit_cast(s8v, v);
}
DI s8v pack8f(const float* x) {
  u4v v = {pk2(x[0], x[1]), pk2(x[2], x[3]), pk2(x[4], x[5]), pk2(x[6], x[7])};
  return __builtin_bit_cast(s8v, v);
}
DI s8v cat44(s4v a, s4v b) { s8v v; v[0]=a[0]; v[1]=a[1]; v[2]=a[2]; v[3]=a[3]; v[4]=b[0]; v[5]=b[1]; v[6]=b[2]; v[7]=b[3]; return v; }
DI float sigmoidf_(float x) { return __builtin_amdgcn_rcpf(1.f + __expf(-x)); }
DI float siluf_(float x) { return x * __builtin_amdgcn_rcpf(1.f + __expf(-x)); }
DI float softplusf_(float x) {
  const float y = __expf(x);
  const float small = y * (1.f - y * (0.5f - y * (0.33333334f - 0.25f * y)));
  const float big = __logf(1.f + y);
  return x > 20.f ? x : (y < 0.03f ? small : big);
}
DI float qmax(float v) { v = fmaxf(v, __shfl_xor(v, 16)); v = fmaxf(v, __shfl_xor(v, 32)); return v; }
DI float qsum(float v) { v += __shfl_xor(v, 16); v += __shfl_xor(v, 32); return v; }
DI int tidx() { int t = __builtin_amdgcn_workitem_id_x(); asm volatile("" : "+v"(t)); return t; }
DI f4v fz() { f4v z = {0.f, 0.f, 0.f, 0.f}; return z; }

DI int lds_byte32(int r, int c) {
  const int ob = (r & 15) * 64 + c * 2;
  return (r >> 4) * 1024 + (ob ^ (((ob >> 9) & 1) << 5));
}
DI void stage_rc32(int b, int& R, int& C) {
  const int st = b >> 10, sb = b & 1023, swz = sb ^ (((sb >> 9) & 1) << 5);
  R = st * 16 + (swz >> 6);
  C = (swz & 63) >> 1;
}
template <int N> DI void wait_vm() {
  if constexpr (N == 0) asm volatile("s_waitcnt vmcnt(0)" ::: "memory");
  else if constexpr (N == 3) asm volatile("s_waitcnt vmcnt(3)" ::: "memory");
  else if constexpr (N == 4) asm volatile("s_waitcnt vmcnt(4)" ::: "memory");
  else if constexpr (N == 6) asm volatile("s_waitcnt vmcnt(6)" ::: "memory");
  else asm volatile("s_waitcnt vmcnt(8)" ::: "memory");
}
template <int NT, int MODE = 0>
DI void gemm_mainloop(f4v (&acc)[4][NT], const u16* __restrict__ A, int lda, const u16* __restrict__ Bt, int ldb, int K,
                      int m0, int n0, u16* smem) {
  const int tid = tidx(), lane = tid & 63, w = tid >> 6, wm = w >> 1, wn = w & 1;
  const int l15 = lane & 15, quad = lane >> 4;
  constexpr int TA = 8192, TBB = NT * 2048, TBUF = TA + TBB;
  constexpr int NBP = NT / 2;
  constexpr int L = 2 + NBP;
  char* sbase = reinterpret_cast<char*>(smem);
  const unsigned lbase = (unsigned)(size_t)sbase;
  int Rr[2], Cc[2];
#pragma unroll
  for (int i = 0; i < 2; ++i) stage_rc32(tid * 16 + i * 4096, Rr[i], Cc[i]);
  const u16* ga0 = A + (size_t)(m0 + Rr[0]) * lda + Cc[0];
  const u16* ga1 = A + (size_t)(m0 + Rr[1]) * lda + Cc[1];
  const u16* gb0 = Bt + (size_t)(n0 + Rr[0]) * ldb + Cc[0];
  const u16* gb1 = Bt + (size_t)(n0 + Rr[NBP - 1]) * ldb + Cc[NBP - 1];
  unsigned offa[4], offb[NT];
#pragma unroll
  for (int t = 0; t < 4; ++t) offa[t] = lds_byte32(wm * 64 + t * 16 + l15, quad * 8);
#pragma unroll
  for (int t = 0; t < NT; ++t) offb[t] = TA + lds_byte32(wn * 16 * NT + t * 16 + l15, quad * 8);
  const int ns = K >> 5;
#define GEMM_STAGE(j)                                                                                                 \
  do {                                                                                                               \
    char* _d = sbase + ((j) & 3) * TBUF + tid * 16;                                                                   \
    __builtin_amdgcn_global_load_lds((const unsigned*)(ga0 + (j) * 32), (unsigned*)(_d), 16, 0, 0);                   \
    __builtin_amdgcn_global_load_lds((const unsigned*)(ga1 + (j) * 32), (unsigned*)(_d + 4096), 16, 0, 0);            \
    __builtin_amdgcn_global_load_lds((const unsigned*)(gb0 + (j) * 32), (unsigned*)(_d + TA), 16, 0, 0);              \
    if (NBP == 2) __builtin_amdgcn_global_load_lds((const unsigned*)(gb1 + (j) * 32), (unsigned*)(_d + TA + 4096), 16, 0, 0); \
  } while (0)
  asm volatile("s_waitcnt vmcnt(0)" ::: "memory");
  if (MODE != 1) { GEMM_STAGE(0); GEMM_STAGE(1); GEMM_STAGE(2); }
  for (int j = 0; j < ns; ++j) {
    if (j + 2 < ns) wait_vm<2 * L>();
    else if (j + 1 < ns) wait_vm<L>();
    else wait_vm<0>();
    asm volatile("s_waitcnt lgkmcnt(0)" ::: "memory");
    __builtin_amdgcn_s_barrier();
    if (MODE != 1 && j + 3 < ns) GEMM_STAGE(j + 3);
    if (MODE == 2) continue;
    const unsigned sl = lbase + (unsigned)((j & 3) * TBUF);
    s8v af[4], bg[NT];
    if constexpr (NT == 4) {
      asm volatile(
          "ds_read_b128 %0, %8\n\tds_read_b128 %1, %9\n\tds_read_b128 %2, %10\n\tds_read_b128 %3, %11\n\t"
          "ds_read_b128 %4, %12\n\tds_read_b128 %5, %13\n\tds_read_b128 %6, %14\n\tds_read_b128 %7, %15\n\t"
          "s_waitcnt lgkmcnt(0)"
          : "=&v"(af[0]), "=&v"(af[1]), "=&v"(af[2]), "=&v"(af[3]), "=&v"(bg[0]), "=&v"(bg[1]), "=&v"(bg[2]), "=&v"(bg[3])
          : "v"(sl + offa[0]), "v"(sl + offa[1]), "v"(sl + offa[2]), "v"(sl + offa[3]), "v"(sl + offb[0]), "v"(sl + offb[1]),
            "v"(sl + offb[2]), "v"(sl + offb[3])
          : "memory");
    } else {
      asm volatile(
          "ds_read_b128 %0, %6\n\tds_read_b128 %1, %7\n\tds_read_b128 %2, %8\n\tds_read_b128 %3, %9\n\t"
          "ds_read_b128 %4, %10\n\tds_read_b128 %5, %11\n\t"
          "s_waitcnt lgkmcnt(0)"
          : "=&v"(af[0]), "=&v"(af[1]), "=&v"(af[2]), "=&v"(af[3]), "=&v"(bg[0]), "=&v"(bg[1])
          : "v"(sl + offa[0]), "v"(sl + offa[1]), "v"(sl + offa[2]), "v"(sl + offa[3]), "v"(sl + offb[0]), "v"(sl + offb[1])
          : "memory");
    }
#pragma unroll
    for (int mt = 0; mt < 4; ++mt)
#pragma unroll
      for (int nt = 0; nt < NT; ++nt) acc[mt][nt] = MFMA16(bg[nt], af[mt], acc[mt][nt]);
  }
#undef GEMM_STAGE
  asm volatile("s_waitcnt lgkmcnt(0)" ::: "memory");
  __builtin_amdgcn_s_barrier();
}
template <int NT>
DI void zero_acc(f4v (&acc)[4][NT]) {
#pragma unroll
  for (int i = 0; i < 4; ++i)
#pragma unroll
    for (int j = 0; j < NT; ++j) acc[i][j] = fz();
}

DI void gemm_big_prefetch(const u16* __restrict__ A, int lda, const u16* __restrict__ Bt, int ldb, int m0, int n0, u16* smem) {
  const int tid = tidx();
  char* sbase = reinterpret_cast<char*>(smem);
#pragma unroll
  for (int sl = 0; sl < 2; ++sl) {
    char* d = sbase + sl * 24576 + tid * 16;
#pragma unroll
    for (int i = 0; i < 4; ++i) {
      int R, C;
      stage_rc32(tid * 16 + i * 4096, R, C);
      __builtin_amdgcn_global_load_lds((const unsigned*)(A + (size_t)(m0 + R) * lda + C + sl * 32), (unsigned*)(d + i * 4096), 16, 0, 0);
      if (i < 2)
        __builtin_amdgcn_global_load_lds((const unsigned*)(Bt + (size_t)(n0 + R) * ldb + C + sl * 32), (unsigned*)(d + 16384 + i * 4096), 16, 0, 0);
    }
  }
}
DI void gemm_big(f4v (&acc)[8][4], const u16* __restrict__ A, int lda, const u16* __restrict__ Bt, int ldb, int K, int m0, int n0,
                 u16* smem, bool prestaged) {
  const int tid = tidx(), lane = tid & 63, w = tid >> 6, wm = w >> 1, wn = w & 1;
  const int l15 = lane & 15, quad = lane >> 4;
  constexpr int TA = 16384, TBUF = 24576;
  char* sbase = reinterpret_cast<char*>(smem);
  const unsigned lbase = (unsigned)(size_t)sbase;
  const u16* ga[4];
  const u16* gb[2];
#pragma unroll
  for (int i = 0; i < 4; ++i) {
    int R, C;
    stage_rc32(tid * 16 + i * 4096, R, C);
    ga[i] = A + (size_t)(m0 + R) * lda + C;
    if (i < 2) gb[i] = Bt + (size_t)(n0 + R) * ldb + C;
  }
  unsigned offa[8], offb[4];
#pragma unroll
  for (int t = 0; t < 8; ++t) offa[t] = lds_byte32(wm * 128 + t * 16 + l15, quad * 8);
#pragma unroll
  for (int t = 0; t < 4; ++t) offb[t] = TA + lds_byte32(wn * 64 + t * 16 + l15, quad * 8);
  const int ns = K >> 5;
#define BIG_STAGE(j, slot)                                                                                            \
  do {                                                                                                               \
    char* _d = sbase + (slot) * TBUF + tid * 16;                                                                      \
    _Pragma("unroll") for (int _i = 0; _i < 4; ++_i)                                                                 \
      __builtin_amdgcn_global_load_lds((const unsigned*)(ga[_i] + (j) * 32), (unsigned*)(_d + _i * 4096), 16, 0, 0);  \
    _Pragma("unroll") for (int _i = 0; _i < 2; ++_i)                                                                 \
      __builtin_amdgcn_global_load_lds((const unsigned*)(gb[_i] + (j) * 32), (unsigned*)(_d + TA + _i * 4096), 16, 0, 0); \
  } while (0)
  if (!prestaged) {
    asm volatile("s_waitcnt vmcnt(0)" ::: "memory");
    BIG_STAGE(0, 0);
    BIG_STAGE(1, 1);
  }
  int slot = 0;
  for (int j = 0; j < ns; ++j) {
    if (j + 1 < ns) wait_vm<6>();
    else wait_vm<0>();
    asm volatile("s_waitcnt lgkmcnt(0)" ::: "memory");
    __builtin_amdgcn_s_barrier();
    const int s2 = (slot == 0) ? 2 : slot - 1;
    if (j + 2 < ns) BIG_STAGE(j + 2, s2);
    const unsigned sl = lbase + (unsigned)(slot * TBUF);
    s8v af[8], bg[4];
    asm volatile(
        "ds_read_b128 %0, %12\n\tds_read_b128 %1, %13\n\tds_read_b128 %2, %14\n\tds_read_b128 %3, %15\n\t"
        "ds_read_b128 %4, %16\n\tds_read_b128 %5, %17\n\tds_read_b128 %6, %18\n\tds_read_b128 %7, %19\n\t"
        "ds_read_b128 %8, %20\n\tds_read_b128 %9, %21\n\tds_read_b128 %10, %22\n\tds_read_b128 %11, %23\n\t"
        "s_waitcnt lgkmcnt(0)"
        : "=&v"(bg[0]), "=&v"(bg[1]), "=&v"(bg[2]), "=&v"(bg[3]), "=&v"(af[0]), "=&v"(af[1]), "=&v"(af[2]), "=&v"(af[3]),
          "=&v"(af[4]), "=&v"(af[5]), "=&v"(af[6]), "=&v"(af[7])
        : "v"(sl + offb[0]), "v"(sl + offb[1]), "v"(sl + offb[2]), "v"(sl + offb[3]), "v"(sl + offa[0]), "v"(sl + offa[1]),
          "v"(sl + offa[2]), "v"(sl + offa[3]), "v"(sl + offa[4]), "v"(sl + offa[5]), "v"(sl + offa[6]), "v"(sl + offa[7])
        : "memory");
#pragma unroll
    for (int mt = 0; mt < 8; ++mt)
#pragma unroll
      for (int nt = 0; nt < 4; ++nt) acc[mt][nt] = MFMA16(bg[nt], af[mt], acc[mt][nt]);
    slot = (slot == 2) ? 0 : slot + 1;
  }
#undef BIG_STAGE
  asm volatile("s_waitcnt lgkmcnt(0)" ::: "memory");
  __builtin_amdgcn_s_barrier();
}

DI void gemm_k64(f4v (&acc)[4][2], const u16* __restrict__ A, int lda, const u16* __restrict__ Bt, int ldb, int K, int m0, int n0,
                 u16* smem) {
  const int tid = tidx(), lane = tid & 63, w = tid >> 6, wm = w >> 1, wn = w & 1;
  const int l15 = lane & 15, quad = lane >> 4;
  constexpr int TA = 16384, TBUF = 24576;
  char* sbase = reinterpret_cast<char*>(smem);
  const unsigned lbase = (unsigned)(size_t)sbase;
  const u16* ga[4];
  const u16* gb[2];
#pragma unroll
  for (int i = 0; i < 4; ++i) {
    int R, C;
    stage_rc32(tid * 16 + (i & 1) * 4096, R, C);
    ga[i] = A + (size_t)(m0 + R) * lda + C + 32 * (i >> 1);
  }
  {
    int R, C;
    stage_rc32(tid * 16, R, C);
    gb[0] = Bt + (size_t)(n0 + R) * ldb + C;
    gb[1] = gb[0] + 32;
  }
  unsigned offa[8], offb[4];
#pragma unroll
  for (int t = 0; t < 8; ++t) offa[t] = (t >> 2) * 8192 + lds_byte32(wm * 64 + (t & 3) * 16 + l15, quad * 8);
#pragma unroll
  for (int t = 0; t < 4; ++t) offb[t] = TA + (t >> 1) * 4096 + lds_byte32(wn * 32 + (t & 1) * 16 + l15, quad * 8);
  const int ns = K >> 6;
#define K64_STAGE(j, slot)                                                                                            \
  do {                                                                                                               \
    char* _d = sbase + (slot) * TBUF + tid * 16;                                                                      \
    _Pragma("unroll") for (int _i = 0; _i < 4; ++_i)                                                                 \
      __builtin_amdgcn_global_load_lds((const unsigned*)(ga[_i] + (j) * 64), (unsigned*)(_d + _i * 4096), 16, 0, 0);  \
    _Pragma("unroll") for (int _i = 0; _i < 2; ++_i)                                                                 \
      __builtin_amdgcn_global_load_lds((const unsigned*)(gb[_i] + (j) * 64), (unsigned*)(_d + TA + _i * 4096), 16, 0, 0); \
  } while (0)
  asm volatile("s_waitcnt vmcnt(0)" ::: "memory");
  K64_STAGE(0, 0);
  if (ns > 1) K64_STAGE(1, 1);
  int slot = 0;
  for (int j = 0; j < ns; ++j) {
    if (j + 1 < ns) wait_vm<6>();
    else wait_vm<0>();
    asm volatile("s_waitcnt lgkmcnt(0)" ::: "memory");
    __builtin_amdgcn_s_barrier();
    const int s2 = (slot == 0) ? 2 : slot - 1;
    if (j + 2 < ns) K64_STAGE(j + 2, s2);
    const unsigned sl = lbase + (unsigned)(slot * TBUF);
    s8v af[8], bg[4];
    asm volatile(
        "ds_read_b128 %0, %12\n\tds_read_b128 %1, %13\n\tds_read_b128 %2, %14\n\tds_read_b128 %3, %15\n\t"
        "ds_read_b128 %4, %16\n\tds_read_b128 %5, %17\n\tds_read_b128 %6, %18\n\tds_read_b128 %7, %19\n\t"
        "ds_read_b128 %8, %20\n\tds_read_b128 %9, %21\n\tds_read_b128 %10, %22\n\tds_read_b128 %11, %23\n\t"
        "s_waitcnt lgkmcnt(0)"
        : "=&v"(bg[0]), "=&v"(bg[1]), "=&v"(bg[2]), "=&v"(bg[3]), "=&v"(af[0]), "=&v"(af[1]), "=&v"(af[2]), "=&v"(af[3]),
          "=&v"(af[4]), "=&v"(af[5]), "=&v"(af[6]), "=&v"(af[7])
        : "v"(sl + offb[0]), "v"(sl + offb[1]), "v"(sl + offb[2]), "v"(sl + offb[3]), "v"(sl + offa[0]), "v"(sl + offa[1]),
          "v"(sl + offa[2]), "v"(sl + offa[3]), "v"(sl + offa[4]), "v"(sl + offa[5]), "v"(sl + offa[6]), "v"(sl + offa[7])
        : "memory");
#pragma unroll
    for (int h = 0; h < 2; ++h)
#pragma unroll
      for (int mt = 0; mt < 4; ++mt)
#pragma unroll
        for (int nt = 0; nt < 2; ++nt) acc[mt][nt] = MFMA16(bg[h * 2 + nt], af[h * 4 + mt], acc[mt][nt]);
    slot = (slot == 2) ? 0 : slot + 1;
  }
#undef K64_STAGE
  asm volatile("s_waitcnt lgkmcnt(0)" ::: "memory");
  __builtin_amdgcn_s_barrier();
}

DI void convT_tile(const float* __restrict__ w, int K, int N, u16* __restrict__ wt, int tile, float* sm) {
  const int tid = tidx();
  const int tiles_k = K >> 6;
  const int tk = tile % tiles_k, tn = tile / tiles_k;
  const int k0 = tk * 64, n0 = tn * 64;
  {
    const int c = tid & 63, r0 = tid >> 6;
    const bool ok = (n0 + c) < N;
    float v[16];
#pragma unroll
    for (int i = 0; i < 16; ++i) v[i] = ok ? __builtin_nontemporal_load(w + (size_t)(k0 + r0 + 4 * i) * N + n0 + c) : 0.f;
    __builtin_amdgcn_sched_barrier(0);
#pragma unroll
    for (int i = 0; i < 16; ++i) sm[(r0 + 4 * i) * 65 + c] = v[i];
  }
  __syncthreads();
  {
    const int n = tid >> 2, ks = (tid & 3) * 16;
    float t0[8], t1[8];
#pragma unroll
    for (int j = 0; j < 8; ++j) { t0[j] = sm[(ks + j) * 65 + n]; t1[j] = sm[(ks + 8 + j) * 65 + n]; }
    const s8v v0 = pack8f(t0), v1 = pack8f(t1);
    u16* dst = wt + (size_t)(n0 + n) * K + k0 + ks;
    *reinterpret_cast<s8v*>(dst) = v0;
    *reinterpret_cast<s8v*>(dst + 8) = v1;
  }
  __syncthreads();
}

template <int NR>
DI void gemv_cols(const float* __restrict__ vec, int K, const float* __restrict__ W, int N, const float* __restrict__ bias,
                  float* __restrict__ out, int col0, float* sm) {
  const int tid = tidx(), kg = tid >> 6, cl = tid & 63;
  const int kper = K >> 2;
  float acc[NR];
#pragma unroll
  for (int r = 0; r < NR; ++r) acc[r] = 0.f;
  for (int k0 = kg * kper; k0 < (kg + 1) * kper; k0 += 16) {
    float wv[16];
#pragma unroll
    for (int j = 0; j < 16; ++j) wv[j] = __builtin_nontemporal_load(W + (size_t)(k0 + j) * N + col0 + cl);
    __builtin_amdgcn_sched_barrier(0);
#pragma unroll
    for (int j = 0; j < 16; ++j)
#pragma unroll
      for (int r = 0; r < NR; ++r) acc[r] += vec[r * K + k0 + j] * wv[j];
    __builtin_amdgcn_sched_barrier(0);
  }
#pragma unroll
  for (int r = 0; r < NR; ++r) sm[(kg * NR + r) * 64 + cl] = acc[r];
  __syncthreads();
  for (int idx = tid; idx < NR * 64; idx += 256) {
    const int r = idx >> 6, c2 = idx & 63;
    float s = bias ? bias[col0 + c2] : 0.f;
#pragma unroll
    for (int g = 0; g < 4; ++g) s += sm[(g * NR + r) * 64 + c2];
    out[(size_t)r * N + col0 + c2] = s;
  }
  __syncthreads();
}

DI void phaseA(const Params& p, unsigned char* smem_raw) {
  float* smf = reinterpret_cast<float*>(smem_raw);
  unsigned char* ws = p.ws;
  constexpr int T0 = 16 * 170, T1 = T0 + 32 * 16, T2 = T1 + 16 * 16, T3 = T2 + 16 * 16, T4 = T3 + 32 * 4, T5 = T4 + 32 * 4,
                T6 = T5 + 4, T7 = T6 + 4, T8 = T7 + 48, T9 = T8 + 8;
  for (int it = blockIdx.x; it < T9; it += gridDim.x) {
    if (it < T0) convT_tile(p.w_in, 1024, NIN, (u16*)(ws + O_WIN), it, smf);
    else if (it < T1) convT_tile(p.w_ssm_out, 2048, 1024, (u16*)(ws + O_WSSM), it - T0, smf);
    else if (it < T2) convT_tile(p.w_nsa_out, 1024, 1024, (u16*)(ws + O_WNSA), it - T1, smf);
    else if (it < T3) convT_tile(p.w_out, 1024, 1024, (u16*)(ws + O_WOUT), it - T2, smf);
    else if (it < T4) convT_tile(p.cmp_w1_k, 2048, 256, (u16*)(ws + O_W1K), it - T3, smf);
    else if (it < T5) convT_tile(p.cmp_w1_v, 2048, 256, (u16*)(ws + O_W1V), it - T4, smf);
    else if (it < T6) convT_tile(p.cmp_w2_k, 256, 64, (u16*)(ws + O_W2K), it - T5, smf);
    else if (it < T7) convT_tile(p.cmp_w2_v, 256, 64, (u16*)(ws + O_W2V), it - T6, smf);
    else if (it < T8) gemv_cols<8>(p.c, 1024, p.w_ada, 3072, p.b_ada, (float*)(ws + O_ADA), (it - T7) * 64, smf);
    else {
      const int j = it - T8, kind = j >> 2, cb = j & 3;
      gemv_cols<1>(kind ? p.cmp_pos_v : p.cmp_pos_k, 2048, kind ? p.cmp_w1_v : p.cmp_w1_k, 256, nullptr,
                   (float*)(ws + O_POSB) + kind * 256, cb * 64, smf);
    }
  }
}

DI void phaseB(const Params& p, int pass) {
  const int tid = tidx(), lane = tid & 63, w = tid >> 6;
  const float* ada = (const float*)(p.ws + O_ADA);
  u16* h = (u16*)(p.ws + O_H);
  for (int it = blockIdx.x; it < MP / 4; it += gridDim.x) {
    const int r = it * 4 + w;
    const int tg = pass * MP + r;
    const int b = tg >> 11;
    const float* xr = p.x + (size_t)tg * DM;
    f4v v[4];
    float ss = 0.f;
#pragma unroll
    for (int i = 0; i < 4; ++i) {
      v[i] = ldf4_nt(xr + i * 256 + lane * 4);
      ss += v[i][0] * v[i][0] + v[i][1] * v[i][1] + v[i][2] * v[i][2] + v[i][3] * v[i][3];
    }
#pragma unroll
    for (int o = 1; o < 64; o <<= 1) ss += __shfl_xor(ss, o);
    const float rstd = rsqrtf(ss * (1.f / DM) + EPS);
    f4v gg[4], shh[4], scc[4];
#pragma unroll
    for (int i = 0; i < 4; ++i) {
      const int c0 = i * 256 + lane * 4;
      gg[i] = ldf4(p.g_pre + c0);
      shh[i] = ldf4(ada + b * 3072 + c0);
      scc[i] = ldf4(ada + b * 3072 + 1024 + c0);
    }
    __builtin_amdgcn_sched_barrier(0);
#pragma unroll
    for (int i = 0; i < 4; ++i) {
      const int c0 = i * 256 + lane * 4;
      const f4v g = gg[i], sh = shh[i], sc = scc[i];
      float o0 = v[i][0] * rstd * g[0] * (1.f + sc[0]) + sh[0];
      float o1 = v[i][1] * rstd * g[1] * (1.f + sc[1]) + sh[1];
      float o2 = v[i][2] * rstd * g[2] * (1.f + sc[2]) + sh[2];
      float o3 = v[i][3] * rstd * g[3] * (1.f + sc[3]) + sh[3];
      st4bf(h + (size_t)r * DM + c0, o0, o1, o2, o3);
    }
  }
}

template <int MODE>
DI void phaseC(const Params& p, u16* smem) {
  const int lane = tidx() & 63, w = tidx() >> 6, wm = w >> 1, wn = w & 1, l15 = lane & 15, quad = lane >> 4;
  const u16* A = (const u16*)(p.ws + O_H);
  const u16* Bt = (const u16*)(p.ws + O_WIN);
  u16* P = (u16*)(p.ws + O_P);
  constexpr int NTN = LDP / 128;
  const int xcd = blockIdx.x & 7, lb = blockIdx.x >> 3, nlb = gridDim.x >> 3;
  bool pre = false;
  for (int t = lb;; t += nlb) {
    const int mi = (xcd & 3) * 4 + (t & 3);
    const int ni = 2 * (t >> 2) + (xcd >> 2);
    if (ni >= NTN) break;
    f4v acc[8][4];
#pragma unroll
    for (int i = 0; i < 8; ++i)
#pragma unroll
      for (int j = 0; j < 4; ++j) acc[i][j] = fz();
    gemm_big(acc, A, 1024, Bt, 1024, 1024, mi * 256, ni * 128, smem, pre);
    {
      const int t2 = t + nlb;
      const int ni2 = 2 * (t2 >> 2) + (xcd >> 2);
      pre = ni2 < NTN;
      if (pre) gemm_big_prefetch(A, 1024, Bt, 1024, ((xcd & 3) * 4 + (t2 & 3)) * 256, ni2 * 128, smem);
    }
    if (MODE != 0) { if (acc[0][0][0] + acc[7][3][3] != 12345.678f) continue; }
#pragma unroll
    for (int mt = 0; mt < 8; ++mt) {
      u16* prow = P + (size_t)(mi * 256 + wm * 128 + mt * 16 + l15) * LDP + ni * 128 + wn * 64;
      st8bf_pair(prow, acc[mt][0], acc[mt][1], quad);
      st8bf_pair(prow + 32, acc[mt][2], acc[mt][3], quad);
    }
  }
}

DI void conv_item(const Params& p, int it) {
  const int tid = tidx();
  const int cb = it % 24, tb = (it / 24) & 31, b = it / (24 * 32);
  const int ch0 = cb * 128 + 2 * (tid & 63);
  const int t0 = tb * 64 + 16 * (tid >> 6);
  const u16* P = (const u16*)(p.ws + O_P);
  u16* xc = (u16*)(p.ws + O_XC);
  u16* xcT = (u16*)(p.ws + O_XCT);
  unsigned raw[19];
#pragma unroll
  for (int i = 0; i < 19; ++i) {
    const int t = t0 - 3 + i;
    raw[i] = (t >= 0) ? *reinterpret_cast<const unsigned*>(P + (size_t)(b * SEQ + t) * LDP + C_XBC + ch0) : 0u;
  }
  const int hd = ch0 >> 6;
  u16 dtr[16];
  const bool isx = ch0 < 2048, isxb = ch0 < 2560;
  if (isx) {
#pragma unroll
    for (int i = 0; i < 16; ++i) dtr[i] = P[(size_t)(b * SEQ + t0 + i) * LDP + C_DT + hd];
  }
  float wv[4][2];
#pragma unroll
  for (int k = 0; k < 4; ++k) { wv[k][0] = p.conv_w[k * 3072 + ch0]; wv[k][1] = p.conv_w[k * 3072 + ch0 + 1]; }
  const float b0 = p.conv_b[ch0], b1 = p.conv_b[ch0 + 1];
  float y0[16], y1[16];
#pragma unroll
  for (int i = 0; i < 16; ++i) {
    float a0 = b0, a1 = b1;
#pragma unroll
    for (int k = 0; k < 4; ++k) {
      a0 += wv[k][0] * __uint_as_float(raw[i + k] << 16);
      a1 += wv[k][1] * __uint_as_float(raw[i + k] & 0xffff0000u);
    }
    y0[i] = siluf_(a0); y1[i] = siluf_(a1);
    const unsigned pk = pk2(y0[i], y1[i]);
    if (ch0 >= 2048) *reinterpret_cast<unsigned*>(xc + (size_t)(b * SEQ + t0 + i) * 3072 + ch0) = pk;
  }
  if (isxb) {
    if (isx) {
      const float db = p.dt_bias[hd];
#pragma unroll
      for (int i = 0; i < 16; ++i) {
        const float dtv = softplusf_(bf2f(dtr[i]) + db);
        y0[i] *= dtv; y1[i] *= dtv;
      }
    }
    u16* d0 = xcT + ((size_t)b * 2560 + ch0) * TS + t0;
    *reinterpret_cast<s8v*>(d0) = pack8f(y0);
    *reinterpret_cast<s8v*>(d0 + 8) = pack8f(y0 + 8);
    *reinterpret_cast<s8v*>(d0 + TS) = pack8f(y1);
    *reinterpret_cast<s8v*>(d0 + TS + 8) = pack8f(y1 + 8);
  }
}
DI void dt_item(const Params& p, int it, float* sm) {
  const int tid = tidx(), hd = tid & 31, seg = tid >> 5;
  const int c = it & 15, b = it >> 4;
  const u16* P = (const u16*)(p.ws + O_P);
  float* dtb = (float*)(p.ws + O_DT);
  float* acs = (float*)(p.ws + O_ACS);
  const float db = p.dt_bias[hd];
  const float a = -expf(p.a_log[hd]);
  const int tbase = c * 128 + seg * 16;
  float v[16], cs[16];
#pragma unroll
  for (int i = 0; i < 16; ++i) v[i] = bf2f(P[(size_t)(b * SEQ + tbase + i) * LDP + C_DT + hd]);
  float run = 0.f;
#pragma unroll
  for (int i = 0; i < 16; ++i) { v[i] = softplusf_(v[i] + db); run += v[i] * a; cs[i] = run; }
  sm[seg * 32 + hd] = run;
  __syncthreads();
  float off = 0.f;
#pragma unroll
  for (int s2 = 0; s2 < 8; ++s2) off += (s2 < seg) ? sm[s2 * 32 + hd] : 0.f;
  float* d0 = dtb + ((size_t)b * 32 + hd) * SEQ + tbase;
  float* d1 = acs + ((size_t)b * 32 + hd) * SEQ + tbase;
#pragma unroll
  for (int i = 0; i < 4; ++i) {
    f4v x0 = {v[4 * i], v[4 * i + 1], v[4 * i + 2], v[4 * i + 3]};
    f4v x1 = {cs[4 * i] + off, cs[4 * i + 1] + off, cs[4 * i + 2] + off, cs[4 * i + 3] + off};
    *reinterpret_cast<f4v*>(d0 + 4 * i) = x0;
    *reinterpret_cast<f4v*>(d1 + 4 * i) = x1;
  }
  __syncthreads();
}
DI void vtr_item(const Params& p, int it) {
  const int tid = tidx();
  const int tb = it & 31, g = (it >> 5) & 3, b = (it >> 7) % NBG, kind = it / (128 * NBG);
  const u16* P = (const u16*)(p.ws + O_P);
  u16* dst = (u16*)(p.ws + (kind ? O_VWT : O_VST));
  const int d = tid & 63, tq = tid >> 6;
  const int t0 = tb * 64 + tq * 16;
  const int col = (kind ? C_VW : C_VS) + g * 64 + d;
  s8v v0, v1;
#pragma unroll
  for (int i = 0; i < 8; ++i) {
    v0[i] = (short)P[(size_t)(b * SEQ + t0 + i) * LDP + col];
    v1[i] = (short)P[(size_t)(b * SEQ + t0 + 8 + i) * LDP + col];
  }
  u16* o = dst + (((size_t)b * 4 + g) * 64 + d) * TS + t0;
  *reinterpret_cast<s8v*>(o) = v0;
  *reinterpret_cast<s8v*>(o + 8) = v1;
}
DI void cmp_item(const Params& p, int it, u16* sm) {
  const int tid = tidx(), lane = tid & 63, w = tid >> 6, l15 = lane & 15, quad = lane >> 4;
  const int jt = it & 7, g = (it >> 3) & 3, b = (it >> 5) % NBG, kind = it / (32 * NBG);
  const u16* P = (const u16*)(p.ws + O_P);
  const u16* W1 = (const u16*)(p.ws + (kind ? O_W1V : O_W1K));
  const u16* W2 = (const u16*)(p.ws + (kind ? O_W2V : O_W2K));
  const float* posb = (const float*)(p.ws + O_POSB) + kind * 256;
  const int col0 = (kind ? C_VC : C_KC) + g * 64;
  const int j = jt * 16 + l15;
  const bool rv = j < 127;
  const u16* arow = P + (size_t)(b * SEQ + (rv ? j : 0) * 16) * LDP + col0 + quad * 8;
  f4v hid[16];
#pragma unroll
  for (int nt = 0; nt < 16; ++nt) hid[nt] = fz();
  s8v zero8 = {0, 0, 0, 0, 0, 0, 0, 0};
#define CMP_LOAD(AF, BW, K2R)                                                                        \
  do {                                                                                               \
    const int _kk = 16 * w + (((K2R) + it) & 15);                        \
    const int _l = _kk >> 1, _d0 = (_kk & 1) * 32;                                                    \
    AF = rv ? ld8(arow + (size_t)_l * LDP + _d0) : zero8;                                             \
    const u16* _wb = W1 + (size_t)l15 * 2048 + _kk * 32 + quad * 8;                                   \
    _Pragma("unroll") for (int nt = 0; nt < 16; ++nt) BW[nt] = ld8(_wb + (size_t)nt * 16 * 2048);    \
  } while (0)
#define CMP_MMA(AF, BW)                                                                              \
  do {                                                                                               \
    _Pragma("unroll") for (int nt = 0; nt < 16; ++nt) hid[nt] = MFMA16(AF, BW[nt], hid[nt]);         \
  } while (0)
  {
    s8v a0, a1, b0[16], b1[16];
    CMP_LOAD(a0, b0, 0);
#pragma unroll 1
    for (int k2r = 0; k2r < 16; k2r += 2) {
      CMP_LOAD(a1, b1, k2r + 1);
      __builtin_amdgcn_sched_barrier(0);
      CMP_MMA(a0, b0);
      __builtin_amdgcn_sched_barrier(0);
      CMP_LOAD(a0, b0, k2r + 2);
      __builtin_amdgcn_sched_barrier(0);
      CMP_MMA(a1, b1);
      __builtin_amdgcn_sched_barrier(0);
    }
  }
#undef CMP_LOAD
#undef CMP_MMA
  float* red = reinterpret_cast<float*>(sm);
#pragma unroll
  for (int nt = 0; nt < 16; ++nt)
#pragma unroll
    for (int i = 0; i < 4; ++i) red[(w * 16 + quad * 4 + i) * 260 + nt * 16 + l15] = hid[nt][i];
  __syncthreads();
  u16 hb[16];
  {
    const float pb = posb[tid];
#pragma unroll
    for (int r = 0; r < 16; ++r) {
      const float v = red[r * 260 + tid] + red[(16 + r) * 260 + tid] + red[(32 + r) * 260 + tid] + red[(48 + r) * 260 + tid] + pb;
      hb[r] = f2bf(siluf_(v));
    }
  }
  __syncthreads();
  constexpr int HS = 264;
#pragma unroll
  for (int r = 0; r < 16; ++r) sm[r * HS + tid] = hb[r];
  __syncthreads();
  f4v res = fz();
#pragma unroll
  for (int ks = 0; ks < 8; ++ks) {
    const s8v a = ld8(sm + l15 * HS + ks * 32 + quad * 8);
    const s8v bw = ld8(W2 + (size_t)(w * 16 + l15) * 256 + ks * 32 + quad * 8);
    res = MFMA16(a, bw, res);
  }
  const int d = w * 16 + l15;
  const int jb = jt * 16 + quad * 4;
  if (kind == 0) {
    u16* kc = (u16*)(p.ws + O_KCMP) + ((size_t)(b * 4 + g) * 128) * 64;
#pragma unroll
    for (int i = 0; i < 4; ++i) kc[(size_t)(jb + i) * 64 + d] = (jb + i < 127) ? f2bf(res[i]) : (u16)0;
  } else {
    u16* vc = (u16*)(p.ws + O_VCT) + ((size_t)(b * 4 + g) * 64 + d) * 128 + jb;
    st4bf(vc, res[0], res[1], res[2], (jb + 3 < 127) ? res[3] : 0.f);
  }
  __syncthreads();
}

DI int q_next(unsigned* ctr) {
  __shared__ int q_slot;
  if (tidx() == 0) q_slot = (int)atomicAdd(ctr, 1u);
  __syncthreads();
  const int it = q_slot;
  __syncthreads();
  return it;
}
DI unsigned* q_counter(const Params& p, int pass, int phase, int rep) {
  return (unsigned*)(p.ws + O_BAR) + 3520 + 8 * (((pass * 4 + phase) * 2) + rep);
}

DI void phaseD(const Params& p, u16* smem, int sub, int pass, int rep) {
  constexpr int N_CMP = 2 * NBG * 32, N_CONV = NBG * 128 * 6, N_VTR = 2 * NBG * 128, N_DT = NBG * 16;
  constexpr int E1 = N_CONV, E2 = E1 + N_VTR, E3 = E2 + N_DT;
  const int ncb = ((int)gridDim.x >= 2 * N_CMP) ? N_CMP : 0;
  constexpr int TAIL = 320;
  int lo, hi, start, step;
  if (ncb == 0) {
    for (int it = blockIdx.x; it < N_CMP; it += gridDim.x)
      if (sub == 0 || sub == 1) cmp_item(p, it, smem);
    lo = 0; hi = E3; start = blockIdx.x; step = gridDim.x;
  } else if ((int)blockIdx.x < ncb) {
    if (sub == 0 || sub == 1) cmp_item(p, blockIdx.x, smem);
    lo = E3 - TAIL; hi = E3; start = lo + blockIdx.x; step = ncb;
  } else {
    lo = 0; hi = E3 - TAIL; start = (int)blockIdx.x - ncb; step = (int)gridDim.x - ncb;
  }
  for (int it = start; it < hi; it += step) {
    if (it < E1) { if (sub == 0 || sub == 2) conv_item(p, it); }
    else if (it < E2) { if (sub == 0 || sub == 3) vtr_item(p, it - E1); }
    else { if (sub == 0 || sub == 3) dt_item(p, it - E2, (float*)smem); }
  }
}

DI void ssd_item(const Params& p, int it, u16* sm) {
  const int tid = tidx(), lane = tid & 63, w = tid >> 6, l15 = lane & 15, quad = lane >> 4;
  const int qr = (it >> 3) & 3, cgx = ((it >> 5) << 3) | (it & 7);
  const int g = cgx & 3, c = (cgx >> 2) & 15, b = cgx >> 6;
  const int t0 = c * 128;
  const u16* xc = (const u16*)(p.ws + O_XC);
  const u16* xcT = (const u16*)(p.ws + O_XCT);
  const float* acsb = (const float*)(p.ws + O_ACS);
  const float* dtb = (const float*)(p.ws + O_DT);
  u16* yd = (u16*)(p.ws + O_YD);
  u16* stb = (u16*)(p.ws + O_ST);
  const u16* Bbase = xc + (size_t)(b * SEQ + t0) * 3072 + 2048 + g * 128;
  const u16* Cbase = xc + (size_t)(b * SEQ + t0) * 3072 + 2560 + g * 128;
  const u16* BT = xcT + ((size_t)b * 2560 + 2048 + g * 128) * TS + t0;
  const int h0 = g * 8 + qr * 2;
  constexpr int LS = 136;
  u16* Bs = sm;
  u16* Xs = sm + 128 * LS;
  float* As = reinterpret_cast<float*>(sm + 256 * LS);
  {
    s8v rb[8], rx[8];
#pragma unroll
    for (int r = 0; r < 8; ++r) {
      const int idx = tid + 256 * r, row = idx >> 4, seg = idx & 15;
      rb[r] = ld8(Bbase + (size_t)row * 3072 + seg * 8);
      rx[r] = ld8(xcT + ((size_t)b * 2560 + h0 * 64 + row) * TS + t0 + seg * 8);
    }
#pragma unroll
    for (int r = 0; r < 8; ++r) {
      const int idx = tid + 256 * r, row = idx >> 4, seg = idx & 15;
      *reinterpret_cast<s8v*>(Bs + row * LS + seg * 8) = rb[r];
      *reinterpret_cast<s8v*>(Xs + row * LS + seg * 8) = rx[r];
    }
    As[tid] = acsb[((size_t)b * 32 + h0 + (tid >> 7)) * SEQ + t0 + (tid & 127)];
  }
  __syncthreads();

#pragma unroll 1
  for (int li = 0; li < 2; ++li) {
    const int lt = li ? 7 - w : w;
    const int l = 16 * lt + l15;
    s8v cf[4];
#pragma unroll
    for (int ks = 0; ks < 4; ++ks) cf[ks] = ld8(Cbase + (size_t)l * 3072 + ks * 32 + quad * 8);
    f4v y[2][4];
#pragma unroll
    for (int hh = 0; hh < 2; ++hh)
#pragma unroll
      for (int pt = 0; pt < 4; ++pt) y[hh][pt] = fz();
    float acl[2];
#pragma unroll
    for (int hh = 0; hh < 2; ++hh) acl[hh] = As[hh * 128 + l];
    const int spn = lt >> 1;
    for (int sp = 0; sp <= spn; ++sp) {
      f4v cb[2];
#pragma unroll
      for (int si = 0; si < 2; ++si) {
        cb[si] = fz();
#pragma unroll
        for (int ks = 0; ks < 4; ++ks)
          cb[si] = MFMA16(ld8(Bs + (32 * sp + 16 * si + l15) * LS + ks * 32 + quad * 8), cf[ks], cb[si]);
      }
#pragma unroll
      for (int hh = 0; hh < 2; ++hh) {
        const float* ah = As + hh * 128;
        const f4v as0 = ldf4(ah + 32 * sp + quad * 4);
        const f4v as1 = ldf4(ah + 32 * sp + 16 + quad * 4);
        f4v m0, m1;
#pragma unroll
        for (int i = 0; i < 4; ++i) {
          const int s0 = 32 * sp + quad * 4 + i, s1 = s0 + 16;
          m0[i] = (s0 <= l) ? cb[0][i] * __expf(acl[hh] - as0[i]) : 0.f;
          m1[i] = (s1 <= l) ? cb[1][i] * __expf(acl[hh] - as1[i]) : 0.f;
        }
        const s8v pb = pack8(m0, m1);
#pragma unroll
        for (int pt = 0; pt < 4; ++pt) {
          const u16* xr = Xs + (hh * 64 + 16 * pt + l15) * LS + 32 * sp + quad * 4;
          y[hh][pt] = MFMA16(cat44(ld4(xr), ld4(xr + 16)), pb, y[hh][pt]);
        }
      }
    }
#pragma unroll
    for (int hh = 0; hh < 2; ++hh) {
      const float dinv = p.d_skip[h0 + hh] / dtb[((size_t)b * 32 + h0 + hh) * SEQ + t0 + l];
#pragma unroll
      for (int pt = 0; pt < 4; ++pt) {
#pragma unroll
        for (int i = 0; i < 4; ++i) y[hh][pt][i] += dinv * bf2f(Xs[(hh * 64 + 16 * pt + 4 * quad + i) * LS + l]);
      }
      u16* yrow = yd + (size_t)(b * SEQ + t0 + l) * 2048 + (h0 + hh) * 64;
      st8bf_pair(yrow, y[hh][0], y[hh][1], quad);
      st8bf_pair(yrow + 32, y[hh][2], y[hh][3], quad);
    }
  }
#pragma unroll 1
  for (int hh = 0; hh < 2; ++hh) {
    const int hd = h0 + hh;
    const float* ah = As + hh * 128;
    const float alast = ah[127];
    f4v st[2][4];
#pragma unroll
    for (int ni = 0; ni < 2; ++ni)
#pragma unroll
      for (int pt = 0; pt < 4; ++pt) st[ni][pt] = fz();
    s8v bt[4][2];
#pragma unroll
    for (int ks = 0; ks < 4; ++ks)
#pragma unroll
      for (int ni = 0; ni < 2; ++ni) bt[ks][ni] = ld8(BT + (size_t)(16 * (2 * w + ni) + l15) * TS + ks * 32 + quad * 8);
    __builtin_amdgcn_sched_barrier(0);
#pragma unroll
    for (int ks = 0; ks < 4; ++ks) {
      const f4v a0 = ldf4(ah + ks * 32 + quad * 8), a1 = ldf4(ah + ks * 32 + quad * 8 + 4);
      float wl[8];
#pragma unroll
      for (int j = 0; j < 4; ++j) { wl[j] = __expf(alast - a0[j]); wl[4 + j] = __expf(alast - a1[j]); }
#pragma unroll
      for (int pt = 0; pt < 4; ++pt) {
        const s8v raw = ld8(Xs + (hh * 64 + 16 * pt + l15) * LS + ks * 32 + quad * 8);
        float xf[8];
#pragma unroll
        for (int j = 0; j < 8; ++j) xf[j] = bfs(raw[j]) * wl[j];
        const s8v xw = pack8f(xf);
        st[0][pt] = MFMA16(bt[ks][0], xw, st[0][pt]);
        st[1][pt] = MFMA16(bt[ks][1], xw, st[1][pt]);
      }
    }
    u16* so = stb + (((size_t)(b * 16 + c) * 32 + hd) * 64) * 128;
#pragma unroll
    for (int pt = 0; pt < 4; ++pt) st8bf_pair(so + (size_t)(16 * pt + l15) * 128 + 32 * w, st[0][pt], st[1][pt], quad);
  }
  __syncthreads();
}

DI void cmpattn_item(const Params& p, int it, unsigned char* smraw) {
  const int tid = tidx(), lane = tid & 63, w = tid >> 6, l15 = lane & 15, quad = lane >> 4;
  const int tq2 = it & 63, g = (it >> 6) & 3, b = it >> 8;
  const int H = g * 4 + w;
  const float slope = exp2f(-0.5f * (float)(H + 1));
  const u16* P = (const u16*)(p.ws + O_P);
  const u16* kcg = (const u16*)(p.ws + O_KCMP) + (size_t)(b * 4 + g) * 128 * 64;
  const u16* vcg = (const u16*)(p.ws + O_VCT) + (size_t)(b * 4 + g) * 64 * 128;
  constexpr int KS = 72, VS = 136;
  u16* kcs = reinterpret_cast<u16*>(smraw);
  u16* vcs = kcs + 128 * KS;
  float* impA = reinterpret_cast<float*>(smraw + 36864);
  float* impB = impA + 2048;
  float* scl = impB + 2112;
  {
    s8v r0[4], r1[4];
#pragma unroll
    for (int r = 0; r < 4; ++r) {
      const int idx = tid + 256 * r;
      r0[r] = ld8(kcg + (size_t)(idx >> 3) * 64 + (idx & 7) * 8);
      r1[r] = ld8(vcg + (size_t)(idx >> 4) * 128 + (idx & 15) * 8);
    }
#pragma unroll
    for (int r = 0; r < 4; ++r) {
      const int idx = tid + 256 * r;
      *reinterpret_cast<s8v*>(kcs + (idx >> 3) * KS + (idx & 7) * 8) = r0[r];
      *reinterpret_cast<s8v*>(vcs + (idx >> 4) * VS + (idx & 15) * 8) = r1[r];
    }
  }
  __syncthreads();
#pragma unroll 1
  for (int sub = 0; sub < 2; ++sub) {
    const int q0 = tq2 * 32 + sub * 16;
    const int njt = (q0 >= 16) ? (((q0 - 16) >> 8) + 1) : 0;
    const int t = q0 + l15;
    const size_t trow = (size_t)(b * SEQ + t);
    s8v qf[2];
    qf[0] = ld8(P + trow * LDP + C_Q + H * 64 + quad * 8);
    qf[1] = ld8(P + trow * LDP + C_Q + H * 64 + 32 + quad * 8);
    f4v s[8];
#pragma unroll
    for (int jt = 0; jt < 8; ++jt) {
      s[jt] = fz();
      if (jt < njt) {
#pragma unroll
        for (int ks = 0; ks < 2; ++ks) s[jt] = MFMA16(ld8(kcs + (16 * jt + l15) * KS + ks * 32 + quad * 8), qf[ks], s[jt]);
      }
    }
    float mx = NEGB;
#pragma unroll
    for (int jt = 0; jt < 8; ++jt)
#pragma unroll
      for (int i = 0; i < 4; ++i) {
        const int j = 16 * jt + 4 * quad + i;
        const int dist = t - (16 * j + 31);
        const float sc = (dist >= 0) ? s[jt][i] * 0.125f - slope * (float)dist : NEGB;
        s[jt][i] = sc;
        mx = fmaxf(mx, sc);
      }
    mx = qmax(mx);
    float lsum = 0.f;
#pragma unroll
    for (int jt = 0; jt < 8; ++jt)
#pragma unroll
      for (int i = 0; i < 4; ++i) {
        const float e = (s[jt][i] > -1e29f) ? __expf(s[jt][i] - mx) : 0.f;
        s[jt][i] = e;
        lsum += e;
      }
    lsum = qsum(lsum);
    const float inv = lsum > 0.f ? 1.f / lsum : 0.f;
#pragma unroll
    for (int jt = 0; jt < 8; ++jt) {
      s[jt] = s[jt] * inv;
      const int k = 4 * jt + quad;
      impA[(w * 16 + l15) * 32 + k] = s[jt][0] + s[jt][1] + s[jt][2] + 0.5f * s[jt][3];
      impB[(w * 16 + l15) * 33 + k + 1] = 0.5f * s[jt][3];
    }
    f4v oc[4];
#pragma unroll
    for (int dt = 0; dt < 4; ++dt) oc[dt] = fz();
#pragma unroll
    for (int kp = 0; kp < 4; ++kp) {
      if (2 * kp < njt) {
        const s8v pb = pack8(s[2 * kp], s[2 * kp + 1]);
#pragma unroll
        for (int dt = 0; dt < 4; ++dt) {
          const u16* vr = vcs + (16 * dt + l15) * VS + 32 * kp + quad * 4;
          oc[dt] = MFMA16(cat44(ld4(vr), ld4(vr + 16)), pb, oc[dt]);
        }
      }
    }
    {
      const float g0 = sigmoidf_(bf2f(P[trow * LDP + C_G + H * 3 + 0]));
      u16* oo = (u16*)(p.ws + O_OCMP) + trow * 1024 + H * 64 + quad * 4;
#pragma unroll
      for (int dt = 0; dt < 4; ++dt) st4bf(oo + 16 * dt, oc[dt][0] * g0, oc[dt][1] * g0, oc[dt][2] * g0, oc[dt][3] * g0);
    }
    __syncthreads();
#pragma unroll
    for (int r = 0; r < 2; ++r) {
      const int idx = tid + 256 * r, q = idx >> 5, k = idx & 31;
      float im = 0.f;
#pragma unroll
      for (int hh = 0; hh < 4; ++hh) {
        im += impA[(hh * 16 + q) * 32 + k];
        if (k > 0) im += impB[(hh * 16 + q) * 33 + k];
      }
      const int blk = (q0 + q) >> 6;
      const bool forced = (k == 0) | (k == blk) | (k == blk - 1);
      scl[q * 32 + k] = forced ? im + 1000.f : ((k <= blk) ? im : -1.f);
    }
    __syncthreads();
    unsigned* sel = (unsigned*)(p.ws + O_SEL) + (size_t)(b * 4 + g) * SEQ + q0;
#pragma unroll
    for (int r = 0; r < 2; ++r) {
      const int idx = tid + 256 * r, q = idx >> 5, k = idx & 31;
      const float me = scl[q * 32 + k];
      int cnt = 0;
#pragma unroll
      for (int k2 = 0; k2 < 32; ++k2) {
        const float o = scl[q * 32 + k2];
        cnt += (o > me || (o == me && k2 < k)) ? 1 : 0;
      }
      const unsigned long long bal = __ballot(cnt < 16);
      if (k == 0) sel[q] = (unsigned)(bal >> (32 * (lane >> 5)));
    }
    __syncthreads();
  }
}

DI void phaseE(const Params& p, float* smf, int sub, int pass, int rep) {
  constexpr int N_SSD = NBG * 256;
  for (int it = blockIdx.x; it < N_SSD; it += gridDim.x) ssd_item(p, it, (u16*)smf);
}

DI void scan_item(const Params& p, int it) {
  const int gid = it * 256 + tidx();
  const int e = gid & 1023, hd = (gid >> 10) & 31, b = gid >> 15;
  u16* stb = (u16*)(p.ws + O_ST);
  const float* acs = (const float*)(p.ws + O_ACS) + ((size_t)b * 32 + hd) * SEQ;
  float carry[8];
#pragma unroll
  for (int j = 0; j < 8; ++j) carry[j] = 0.f;
  s8v sv[16];
  float dec[16];
#pragma unroll
  for (int c = 0; c < 16; ++c) {
    sv[c] = ld8(stb + (((size_t)(b * 16 + c) * 32 + hd) * 8192) + e * 8);
    dec[c] = acs[c * 128 + 127];
  }
#pragma unroll
  for (int c = 0; c < 16; ++c) {
    u16* ptr = stb + (((size_t)(b * 16 + c) * 32 + hd) * 8192) + e * 8;
    const float dc = __expf(dec[c]);
    const s8v pv = pack8f(carry);
#pragma unroll
    for (int j = 0; j < 8; ++j) carry[j] = carry[j] * dc + bfs(sv[c][j]);
    *reinterpret_cast<s8v*>(ptr) = pv;
  }
}

template <bool WIN, bool MASKED>
DI void attn_tile(const u16* Kt, const u16* Vt, const s8v (&qf)[2], const f4v (&cb)[4], int t, int kb, int q0, bool selb,
                  float slope2, float& m, float& l, f4v (&o)[4]) {
  const int lane = tidx() & 63, l15 = lane & 15, quad = lane >> 4;
  constexpr int LS = 72;
  const float bkb = slope2 * (float)(64 * kb - q0);
  f4v s[4];
#pragma unroll
  for (int kt = 0; kt < 4; ++kt) {
    s[kt] = cb[kt] + bkb;
    const u16* kr = Kt + (16 * kt + l15) * LS + quad * 8;
    s[kt] = MFMA16(ld8(kr), qf[0], s[kt]);
    s[kt] = MFMA16(ld8(kr + 32), qf[1], s[kt]);
  }
  if (MASKED) {
    const int dd0 = t - (64 * kb + 4 * quad);
#pragma unroll
    for (int kt = 0; kt < 4; ++kt)
#pragma unroll
      for (int i = 0; i < 4; ++i) {
        const int dd = dd0 - (16 * kt + i);
        const bool ok = WIN ? ((unsigned)dd < 512u) : (selb && dd >= 0);
        s[kt][i] = ok ? s[kt][i] : NEGB;
      }
  }
  float mx = fmaxf(fmaxf(fmaxf(s[0][0], s[0][1]), fmaxf(s[0][2], s[0][3])), fmaxf(fmaxf(s[1][0], s[1][1]), fmaxf(s[1][2], s[1][3])));
  mx = fmaxf(mx, fmaxf(fmaxf(fmaxf(s[2][0], s[2][1]), fmaxf(s[2][2], s[2][3])), fmaxf(fmaxf(s[3][0], s[3][1]), fmaxf(s[3][2], s[3][3]))));
  mx = qmax(mx);
  if (__ballot(mx > m + 6.f) != 0ull) {
    const float mn = fmaxf(m, mx);
    const float alpha = __builtin_amdgcn_exp2f(m - mn);
    m = mn;
    l *= alpha;
#pragma unroll
    for (int dt = 0; dt < 4; ++dt) o[dt] = o[dt] * alpha;
  }
  float ps = 0.f;
#pragma unroll
  for (int kt = 0; kt < 4; ++kt)
#pragma unroll
    for (int i = 0; i < 4; ++i) {
      float e = __builtin_amdgcn_exp2f(s[kt][i] - m);
      if (MASKED) e = (s[kt][i] > -1e29f) ? e : 0.f;
      s[kt][i] = e;
      ps += e;
    }
  l += ps;
#pragma unroll
  for (int kp = 0; kp < 2; ++kp) {
    const s8v pb = pack8(s[2 * kp], s[2 * kp + 1]);
#pragma unroll
    for (int dt = 0; dt < 4; ++dt) {
      const u16* vr = Vt + (16 * dt + l15) * LS + 32 * kp + quad * 4;
      o[dt] = MFMA16(cat44(ld4(vr), ld4(vr + 16)), pb, o[dt]);
    }
  }
}

template <bool WIN, int AV>
DI void attn_pass(const u16* __restrict__ Kbase  , const u16* __restrict__ VT  ,
                  const s8v (&qf)[2], const f4v (&cb)[4], int t, int q0, unsigned mymask, float slope2, unsigned tiles, f4v (&o)[4],
                  float& lout, u16* sm) {
  const int tid = tidx();
  constexpr int LS = 72, TB = 64 * LS;
  const int lrow = tid >> 3, lseg = tid & 7;
  const int blk = q0 >> 6;
  float m = NEGB, l = 0.f;
#pragma unroll
  for (int dt = 0; dt < 4; ++dt) o[dt] = fz();
  const u16* kp0 = Kbase + (size_t)lrow * LDP + lseg * 8;
  const u16* vp0 = VT + (size_t)lrow * TS + lseg * 8;
#define AT_LOAD(RK, RV, KB)                                                            \
  do {                                                                                 \
    RK[0] = ld8(kp0 + (size_t)(64 * (KB)) * LDP);                                       \
    RK[1] = ld8(kp0 + (size_t)(64 * (KB) + 32) * LDP);                                  \
    RV[0] = ld8(vp0 + 64 * (KB));                                                       \
    RV[1] = ld8(vp0 + (size_t)32 * TS + 64 * (KB));                                    \
  } while (0)
#define AT_STORE(RK, RV, BUF)                                                          \
  do {                                                                                 \
    u16* _d = sm + (BUF) * 2 * TB + lrow * LS + lseg * 8;                               \
    *reinterpret_cast<s8v*>(_d) = RK[0];                                                \
    *reinterpret_cast<s8v*>(_d + 32 * LS) = RK[1];                                      \
    *reinterpret_cast<s8v*>(_d + TB) = RV[0];                                           \
    *reinterpret_cast<s8v*>(_d + TB + 32 * LS) = RV[1];                                 \
  } while (0)
#define AT_POPL() do { if (tl) { kbl = 31 - __builtin_clz(tl); tl &= ~(1u << kbl); } } while (0)
#define AT_STEP(RK, RV)                                                                                              \
  {                                                                                                                  \
    const int kb = 31 - __builtin_clz(tc);                                                                            \
    tc &= ~(1u << kb);                                                                                                \
    const u16* Kt = sm + cur * 2 * TB;                                                                                \
    const bool selb = WIN ? true : (((mymask >> kb) & 1u) != 0u);                                                     \
    const bool need = WIN ? ((kb == blk) || (64 * kb <= q0 - 497)) : ((kb == blk) || (__ballot(selb) != ~0ull));      \
    if (AV != 2) {                                                                                                    \
    if (need) attn_tile<WIN, true>(Kt, Kt + TB, qf, cb, t, kb, q0, selb, slope2, m, l, o);                            \
    else attn_tile<WIN, false>(Kt, Kt + TB, qf, cb, t, kb, q0, selb, slope2, m, l, o);                                \
    }                                                                                                                 \
    if (AV != 1) {                                                                                                    \
    if (tc) AT_STORE(RK, RV, cur ^ 1);                                                                                \
    AT_POPL();                                                                                                        \
    AT_LOAD(RK, RV, kbl);                                                                                             \
    }                                                                                                                 \
    __syncthreads();                                                                                                  \
    if (!tc) break;                                                                                                   \
    cur ^= 1;                                                                                                         \
  }
  unsigned tc = tiles, tl = tiles;
  s8v ak[2], av[2], bk[2], bv[2];
  int kbl = 0;
  AT_POPL();
  AT_LOAD(ak, av, kbl);
  AT_STORE(ak, av, 0);
  AT_POPL();
  AT_LOAD(ak, av, kbl);
  AT_POPL();
  AT_LOAD(bk, bv, kbl);
  __syncthreads();
  int cur = 0;
  while (true) {
    AT_STEP(ak, av)
    AT_STEP(bk, bv)
  }
#undef AT_LOAD
#undef AT_STORE
#undef AT_POPL
#undef AT_STEP
  lout = qsum(l);
}

DI void cmp_part(const Params& p, int b, int g, int q0, const s8v (&qf)[2], unsigned char* smraw, f4v (&oc)[4], unsigned& mymask) {
  const int tid = tidx(), lane = tid & 63, w = tid >> 6, l15 = lane & 15, quad = lane >> 4;
  const int H = g * 4 + w;
  const float slope = exp2f(-0.5f * (float)(H + 1));
  const u16* P = (const u16*)(p.ws + O_P);
  const u16* kcg = (const u16*)(p.ws + O_KCMP) + (size_t)(b * 4 + g) * 128 * 64;
  const u16* vcg = (const u16*)(p.ws + O_VCT) + (size_t)(b * 4 + g) * 64 * 128;
  constexpr int KS = 72, VS = 136;
  u16* kcs = reinterpret_cast<u16*>(smraw);
  u16* vcs = kcs + 128 * KS;
  float* impA = reinterpret_cast<float*>(smraw + 36864);
  float* impB = impA + 2048;
  float* scl = impB + 2112;
  unsigned* selm = reinterpret_cast<unsigned*>(scl + 512);
  const int njt = (q0 >= 16) ? (((q0 - 16) >> 8) + 1) : 0;
  {
    s8v r0[4], r1[4];
#pragma unroll
    for (int r = 0; r < 4; ++r) {
      const int idx = tid + 256 * r;
      r0[r] = ld8(kcg + (size_t)(idx >> 3) * 64 + (idx & 7) * 8);
      r1[r] = ld8(vcg + (size_t)(idx >> 4) * 128 + (idx & 15) * 8);
    }
#pragma unroll
    for (int r = 0; r < 4; ++r) {
      const int idx = tid + 256 * r;
      *reinterpret_cast<s8v*>(kcs + (idx >> 3) * KS + (idx & 7) * 8) = r0[r];
      *reinterpret_cast<s8v*>(vcs + (idx >> 4) * VS + (idx & 15) * 8) = r1[r];
    }
  }
  __syncthreads();
  const int t = q0 + l15;
  const size_t trow = (size_t)(b * SEQ + t);
  f4v s[8];
#pragma unroll
  for (int jt = 0; jt < 8; ++jt) {
    s[jt] = fz();
    if (jt < njt) {
#pragma unroll
      for (int ks = 0; ks < 2; ++ks) s[jt] = MFMA16(ld8(kcs + (16 * jt + l15) * KS + ks * 32 + quad * 8), qf[ks], s[jt]);
    }
  }
  float mx = NEGB;
#pragma unroll
  for (int jt = 0; jt < 8; ++jt)
#pragma unroll
    for (int i = 0; i < 4; ++i) {
      const int j = 16 * jt + 4 * quad + i;
      const int dist = t - (16 * j + 31);
      const float sc = (dist >= 0) ? s[jt][i] * 0.125f - slope * (float)dist : NEGB;
      s[jt][i] = sc;
      mx = fmaxf(mx, sc);
    }
  mx = qmax(mx);
  float lsum = 0.f;
#pragma unroll
  for (int jt = 0; jt < 8; ++jt)
#pragma unroll
    for (int i = 0; i < 4; ++i) {
      const float e = (s[jt][i] > -1e29f) ? __expf(s[jt][i] - mx) : 0.f;
      s[jt][i] = e;
      lsum += e;
    }
  lsum = qsum(lsum);
  const float inv = lsum > 0.f ? 1.f / lsum : 0.f;
#pragma unroll
  for (int jt = 0; jt < 8; ++jt) {
    s[jt] = s[jt] * inv;
    const int k = 4 * jt + quad;
    impA[(w * 16 + l15) * 32 + k] = s[jt][0] + s[jt][1] + s[jt][2] + 0.5f * s[jt][3];
    impB[(w * 16 + l15) * 33 + k + 1] = 0.5f * s[jt][3];
  }
#pragma unroll
  for (int dt = 0; dt < 4; ++dt) oc[dt] = fz();
#pragma unroll
  for (int kp = 0; kp < 4; ++kp) {
    if (2 * kp < njt) {
      const s8v pb = pack8(s[2 * kp], s[2 * kp + 1]);
#pragma unroll
      for (int dt = 0; dt < 4; ++dt) {
        const u16* vr = vcs + (16 * dt + l15) * VS + 32 * kp + quad * 4;
        oc[dt] = MFMA16(cat44(ld4(vr), ld4(vr + 16)), pb, oc[dt]);
      }
    }
  }
  {
    const float g0 = sigmoidf_(bf2f(P[trow * LDP + C_G + H * 3 + 0]));
#pragma unroll
    for (int dt = 0; dt < 4; ++dt) oc[dt] = oc[dt] * g0;
  }
  __syncthreads();
#pragma unroll
  for (int r = 0; r < 2; ++r) {
    const int idx = tid + 256 * r, q = idx >> 5, k = idx & 31;
    float im = 0.f;
#pragma unroll
    for (int hh = 0; hh < 4; ++hh) {
      im += impA[(hh * 16 + q) * 32 + k];
      if (k > 0) im += impB[(hh * 16 + q) * 33 + k];
    }
    const int blk = (q0 + q) >> 6;
    const bool forced = (k == 0) | (k == blk) | (k == blk - 1);
    scl[q * 32 + k] = forced ? im + 1000.f : ((k <= blk) ? im : -1.f);
  }
  __syncthreads();
#pragma unroll
  for (int r = 0; r < 2; ++r) {
    const int idx = tid + 256 * r, q = idx >> 5, k = idx & 31;
    const float me = scl[q * 32 + k];
    int cnt = 0;
#pragma unroll
    for (int k2 = 0; k2 < 32; ++k2) {
      const float o = scl[q * 32 + k2];
      cnt += (o > me || (o == me && k2 < k)) ? 1 : 0;
    }
    const unsigned long long bal = __ballot(cnt < 16);
    if (k == 0) selm[q] = (unsigned)(bal >> (32 * (lane >> 5)));
  }
  __syncthreads();
  mymask = selm[l15];
  __syncthreads();
}

template <int AV>
DI void attn_item(const Params& p, int it, u16* sm) {
  const int tid = tidx(), lane = tid & 63, w = tid >> 6, l15 = lane & 15, quad = lane >> 4;
  const int tq = it & 127, g = (it >> 7) & 3, b = it >> 9;
  const int q0 = tq * 16;
  const int H = g * 4 + w;
  const float slope2 = exp2f(-0.5f * (float)(H + 1)) * 1.4426950408889634f;
  constexpr float SCALE2 = 0.125f * 1.4426950408889634f;
  const u16* P = (const u16*)(p.ws + O_P);
  const int t = q0 + l15;
  const size_t trow = (size_t)(b * SEQ + t);
  s8v qf[2], qraw[2];
#pragma unroll
  for (int ks = 0; ks < 2; ++ks) {
    const s8v raw = ld8(P + trow * LDP + C_Q + H * 64 + ks * 32 + quad * 8);
    qraw[ks] = raw;
    float qs[8];
#pragma unroll
    for (int j = 0; j < 8; ++j) qs[j] = bfs(raw[j]) * SCALE2;
    qf[ks] = pack8f(qs);
  }
  f4v ocm[4];
  unsigned mymask;
  cmp_part(p, b, g, q0, qraw, reinterpret_cast<unsigned char*>(sm), ocm, mymask);
  f4v cb[4];
#pragma unroll
  for (int kt = 0; kt < 4; ++kt)
#pragma unroll
    for (int i = 0; i < 4; ++i) cb[kt][i] = slope2 * (float)(16 * kt + 4 * quad + i);
  const int blk = q0 >> 6;
  const unsigned upto = (blk >= 31) ? 0xffffffffu : ((2u << blk) - 1u);
  unsigned um = mymask;
#pragma unroll
  for (int o = 1; o < 64; o <<= 1) um |= (unsigned)__shfl_xor((int)um, o);
  um = (unsigned)__builtin_amdgcn_readfirstlane((int)(um & upto));
  f4v os[4], ow[4];
  float ls, lw;
  attn_pass<false, AV>(P + (size_t)(b * SEQ) * LDP + C_KS + g * 64, (const u16*)(p.ws + O_VST) + (size_t)(b * 4 + g) * 64 * TS, qf, cb, t,
                   q0, mymask, slope2, um, os, ls, sm);
  const int wlo = (q0 - 511 > 0 ? q0 - 511 : 0) >> 6;
  const unsigned wm_ = (unsigned)__builtin_amdgcn_readfirstlane((int)(upto & ~((1u << wlo) - 1u)));
  attn_pass<true, AV>(P + (size_t)(b * SEQ) * LDP + C_KW + g * 64, (const u16*)(p.ws + O_VWT) + (size_t)(b * 4 + g) * 64 * TS, qf, cb, t,
                  q0, 0u, slope2, wm_, ow, lw, sm);
  if (AV != 0) { if (ls + lw + os[0][0] + ow[3][3] != 12345.678f) return; }
  const float g1 = sigmoidf_(bf2f(P[trow * LDP + C_G + H * 3 + 1])) / ls;
  const float g2 = sigmoidf_(bf2f(P[trow * LDP + C_G + H * 3 + 2])) / lw;
  const u16* za = P + trow * LDP + C_ZA + H * 64;
  u16* oo = (u16*)(p.ws + O_O) + trow * 1024 + H * 64;
  f4v rr[4];
  s4v zq[4];
  ld8bf_pair(za, quad, zq[0], zq[1]);
  ld8bf_pair(za + 32, quad, zq[2], zq[3]);
#pragma unroll
  for (int dt = 0; dt < 4; ++dt) {
#pragma unroll
    for (int i = 0; i < 4; ++i) rr[dt][i] = (ocm[dt][i] + g1 * os[dt][i] + g2 * ow[dt][i]) * siluf_(bfs(zq[dt][i]));
  }
  st8bf_pair(oo, rr[0], rr[1], quad);
  st8bf_pair(oo + 32, rr[2], rr[3], quad);
}

DI void phaseF(const Params& p, bool noscan, u16* sm, int pass, int rep) {
  constexpr int N_SC = NBG * 32 * 1024 / 256;
  const int xq = blockIdx.x & 7, lbq = blockIdx.x >> 3, nl = (int)gridDim.x >> 3;
  unsigned* ctr = q_counter(p, pass, 2, rep) + xq;
  const int nend = noscan ? 128 : 128 + N_SC / 8;
  bool first = true;
  while (true) {
    const int j = first ? lbq : q_next(ctr) + nl;
    first = false;
    if (j >= nend) break;
    if (j < 128) attn_item<0>(p, (xq >> 2) * 512 + (xq & 3) * 128 + (127 - j), sm);
    else scan_item(p, (j - 128) * 8 + xq);
  }
}

DI void phaseG(const Params& p, float* smf) {
  const int tid = tidx(), lane = tid & 63, w = tid >> 6, l15 = lane & 15, quad = lane >> 4;
  const u16* xc = (const u16*)(p.ws + O_XC);
  const u16* P = (const u16*)(p.ws + O_P);
  const u16* yd = (const u16*)(p.ws + O_YD);
  const u16* stb = (const u16*)(p.ws + O_ST);
  const float* acsb = (const float*)(p.ws + O_ACS);
  u16* yn = (u16*)(p.ws + O_YN);
  for (int it = blockIdx.x; it < NBG * 256; it += gridDim.x) {
    const int lq = (it >> 3) & 3, cgx = ((it >> 5) << 3) | (it & 7);
    const int g = cgx & 3, c = (cgx >> 2) & 15, b = cgx >> 6;
    const int t0 = b * SEQ + c * 128 + 32 * lq + l15;
    s8v cf[2][4];
#pragma unroll
    for (int li = 0; li < 2; ++li)
#pragma unroll
      for (int ks = 0; ks < 4; ++ks) cf[li][ks] = ld8(xc + (size_t)(t0 + 16 * li) * 3072 + 2560 + g * 128 + ks * 32 + quad * 8);
    f4v y[2][4][2];
    f4v* park = reinterpret_cast<f4v*>(smf + 1024);
    float ss[2] = {0.f, 0.f};
#pragma unroll
    for (int hh = 0; hh < 2; ++hh) {
      const int hd = g * 8 + 2 * w + hh;
      const u16* pv = stb + (((size_t)(b * 16 + c) * 32 + hd) * 64) * 128;
      s8v pf[4][4];
      s4v d4[4], z4[4];
#pragma unroll
      for (int pt = 0; pt < 4; ++pt) {
#pragma unroll
        for (int ks = 0; ks < 4; ++ks) pf[pt][ks] = ld8(pv + (size_t)(16 * pt + l15) * 128 + ks * 32 + quad * 8);
      }
#pragma unroll
      for (int pp = 0; pp < 2; ++pp) {
        ld8bf_pair(yd + (size_t)t0 * 2048 + hd * 64 + 32 * pp, quad, d4[2 * pp], d4[2 * pp + 1]);
        ld8bf_pair(P + (size_t)t0 * LDP + C_Z + hd * 64 + 32 * pp, quad, z4[2 * pp], z4[2 * pp + 1]);
      }
      float ea[2];
#pragma unroll
      for (int li = 0; li < 2; ++li) ea[li] = __expf(acsb[((size_t)b * 32 + hd) * SEQ + (t0 + 16 * li - b * SEQ)]);
      __builtin_amdgcn_sched_barrier(0);
#pragma unroll
      for (int pt = 0; pt < 4; ++pt) {
        y[hh][pt][0] = fz(); y[hh][pt][1] = fz();
#pragma unroll
        for (int ks = 0; ks < 4; ++ks) {
          y[hh][pt][0] = MFMA16(pf[pt][ks], cf[0][ks], y[hh][pt][0]);
          y[hh][pt][1] = MFMA16(pf[pt][ks], cf[1][ks], y[hh][pt][1]);
        }
      }
      __builtin_amdgcn_sched_barrier(0);
      s4v d5[4], z5[4];
#pragma unroll
      for (int pp = 0; pp < 2; ++pp) {
        ld8bf_pair(yd + (size_t)(t0 + 16) * 2048 + hd * 64 + 32 * pp, quad, d5[2 * pp], d5[2 * pp + 1]);
        ld8bf_pair(P + (size_t)(t0 + 16) * LDP + C_Z + hd * 64 + 32 * pp, quad, z5[2 * pp], z5[2 * pp + 1]);
      }
      __builtin_amdgcn_sched_barrier(0);
#pragma unroll
      for (int pt = 0; pt < 4; ++pt)
#pragma unroll
        for (int i = 0; i < 4; ++i) {
          const float v = (bfs(d4[pt][i]) + y[hh][pt][0][i] * ea[0]) * siluf_(bfs(z4[pt][i]));
          y[hh][pt][0][i] = v;
          ss[0] += v * v;
        }
      __builtin_amdgcn_sched_barrier(0);
#pragma unroll
      for (int pt = 0; pt < 4; ++pt)
#pragma unroll
        for (int i = 0; i < 4; ++i) {
          const float v = (bfs(d5[pt][i]) + y[hh][pt][1][i] * ea[1]) * siluf_(bfs(z5[pt][i]));
          y[hh][pt][1][i] = v;
          ss[1] += v * v;
        }
      if (hh == 0) {
#pragma unroll
        for (int pt = 0; pt < 4; ++pt) { park[(2 * pt) * 256 + tid] = y[0][pt][0]; park[(2 * pt + 1) * 256 + tid] = y[0][pt][1]; }
      }
    }
    ss[0] = qsum(ss[0]); ss[1] = qsum(ss[1]);
    if (quad == 0) { smf[w * 32 + l15] = ss[0]; smf[w * 32 + 16 + l15] = ss[1]; }
    f4v gnv[2][4];
#pragma unroll
    for (int hh = 0; hh < 2; ++hh)
#pragma unroll
      for (int pt = 0; pt < 4; ++pt) gnv[hh][pt] = ldf4(p.g_ssm_norm + (g * 8 + 2 * w + hh) * 64 + 16 * pt + quad * 4);
    __syncthreads();
    float rs[2];
#pragma unroll
    for (int li = 0; li < 2; ++li) {
      const float tot = smf[16 * li + l15] + smf[32 + 16 * li + l15] + smf[64 + 16 * li + l15] + smf[96 + 16 * li + l15];
      rs[li] = rsqrtf(tot * (1.f / 512.f) + EPS);
    }
#pragma unroll
    for (int hh = 0; hh < 2; ++hh) {
      const int hd = g * 8 + 2 * w + hh;
#pragma unroll
      for (int li = 0; li < 2; ++li) {
        f4v nv[4];
#pragma unroll
        for (int pt = 0; pt < 4; ++pt) {
          const f4v v = (hh == 0) ? park[(2 * pt + li) * 256 + tid] : y[1][pt][li];
          nv[pt] = v * gnv[hh][pt] * rs[li];
        }
        u16* nrow = yn + (size_t)(t0 + 16 * li) * 2048 + hd * 64;
        st8bf_pair(nrow, nv[0], nv[1], quad);
        st8bf_pair(nrow + 32, nv[2], nv[3], quad);
      }
    }
    __syncthreads();
  }
}

DI void phaseH(const Params& p, u16* smem) {
  const int lane = tidx() & 63, w = tidx() >> 6, wm = w >> 1, wn = w & 1, l15 = lane & 15, quad = lane >> 4;
  const u16* P = (const u16*)(p.ws + O_P);
  u16* mg = (u16*)(p.ws + O_H);
  float* tmp = (float*)(p.ws + O_YD);
  constexpr int MT = MP / 128;
  for (int it = blockIdx.x; it < MT * 16; it += gridDim.x) {
    const int mi = it % MT, ni = it / MT;
    f4v acc[4][2];
    u2v keep[4][2];
    zero_acc<2>(acc);
    gemm_k64(acc, (const u16*)(p.ws + O_YN), 2048, (const u16*)(p.ws + O_WSSM), 2048, 2048, mi * 128, ni * 64, smem);
    s4v gq[4][2];
#pragma unroll
    for (int mt = 0; mt < 4; ++mt)
      ld8bf_pair(P + (size_t)(mi * 128 + wm * 64 + mt * 16 + l15) * LDP + C_MG + ni * 64 + wn * 32, quad, gq[mt][0], gq[mt][1]);
    __builtin_amdgcn_sched_barrier(0);
#pragma unroll
    for (int mt = 0; mt < 4; ++mt)
#pragma unroll
      for (int nt = 0; nt < 2; ++nt) {
        const int m = mi * 128 + wm * 64 + mt * 16 + l15, n = ni * 64 + wn * 32 + nt * 16 + quad * 4;
        const s4v g0 = gq[mt][nt];
        f4v r;
#pragma unroll
        for (int i = 0; i < 4; ++i) r[i] = sigmoidf_(bfs(g0[i])) * acc[mt][nt][i];
        u2v kp = {pk2(r[0], r[1]), pk2(r[2], r[3])};
        keep[mt][nt] = kp;
      }
    zero_acc<2>(acc);
    gemm_k64(acc, (const u16*)(p.ws + O_O), 1024, (const u16*)(p.ws + O_WNSA), 1024, 1024, mi * 128, ni * 64, smem);
    f4v tq[4][2];
#pragma unroll
    for (int mt = 0; mt < 4; ++mt)
      ld8bf_pair(P + (size_t)(mi * 128 + wm * 64 + mt * 16 + l15) * LDP + C_MG + 1024 + ni * 64 + wn * 32, quad, gq[mt][0], gq[mt][1]);
#pragma unroll
    for (int mt = 0; mt < 4; ++mt)
#pragma unroll
      for (int nt = 0; nt < 2; ++nt) {
        const u2v kp = keep[mt][nt];
        f4v tv = {__uint_as_float(kp[0] << 16), __uint_as_float(kp[0] & 0xffff0000u), __uint_as_float(kp[1] << 16),
                  __uint_as_float(kp[1] & 0xffff0000u)};
        tq[mt][nt] = tv;
      }
    __builtin_amdgcn_sched_barrier(0);
#pragma unroll
    for (int mt = 0; mt < 4; ++mt) {
      f4v rr[2];
#pragma unroll
      for (int nt = 0; nt < 2; ++nt) {
        const s4v g1 = gq[mt][nt];
        const f4v t0 = tq[mt][nt];
#pragma unroll
        for (int i = 0; i < 4; ++i) rr[nt][i] = t0[i] + sigmoidf_(bfs(g1[i])) * acc[mt][nt][i];
      }
      st8bf_pair(mg + (size_t)(mi * 128 + wm * 64 + mt * 16 + l15) * 1024 + ni * 64 + wn * 32, rr[0], rr[1], quad);
    }
  }
}

DI void phaseI(const Params& p, u16* smem) {
  const int lane = tidx() & 63, w = tidx() >> 6, wm = w >> 1, wn = w & 1, l15 = lane & 15, quad = lane >> 4;
  u16* outb = (u16*)(p.ws + O_OUTF);
  float* rsq = (float*)(p.ws + O_RSQ);
  constexpr int MT = MP / 128;
  for (int it = blockIdx.x; it < MT * 16; it += gridDim.x) {
    const int mi = it % MT, ni = it / MT;
    f4v acc[4][2];
    zero_acc<2>(acc);
    gemm_k64(acc, (const u16*)(p.ws + O_H), 1024, (const u16*)(p.ws + O_WOUT), 1024, 1024, mi * 128, ni * 64, smem);
#pragma unroll
    for (int mt = 0; mt < 4; ++mt) {
      const int m = mi * 128 + wm * 64 + mt * 16 + l15;
      float ss = 0.f;
#pragma unroll
      for (int nt = 0; nt < 2; ++nt) {
        const f4v v = acc[mt][nt];
        ss += v[0] * v[0] + v[1] * v[1] + v[2] * v[2] + v[3] * v[3];
      }
      st8bf_pair(outb + (size_t)m * 1024 + ni * 64 + wn * 32, acc[mt][0], acc[mt][1], quad);
      ss = qsum(ss);
      if (quad == 0) rsq[(size_t)m * 32 + ni * 2 + wn] = ss;
    }
  }
}

DI void phaseJ(const Params& p, int pass) {
  const int tid = tidx(), lane = tid & 63, w = tid >> 6;
  const u16* outb = (const u16*)(p.ws + O_OUTF);
  const float* rsq = (const float*)(p.ws + O_RSQ);
  const float* ada = (const float*)(p.ws + O_ADA);
  for (int it = blockIdx.x; it < MP / 4; it += gridDim.x) {
    const int r = it * 4 + w;
    const int tg = pass * MP + r, b = tg >> 11;
    float part = (lane < 32) ? rsq[(size_t)r * 32 + lane] : 0.f;
    s4v ob[4];
    f4v xv[4], gp[4], gt[4];
#pragma unroll
    for (int i = 0; i < 4; ++i) {
      const int c0 = i * 256 + lane * 4;
      ob[i] = ld4(outb + (size_t)r * 1024 + c0);
      xv[i] = ldf4_nt(p.x + (size_t)tg * 1024 + c0);
      gp[i] = ldf4(p.g_post + c0);
      gt[i] = ldf4(ada + b * 3072 + 2048 + c0);
    }
    __builtin_amdgcn_sched_barrier(0);
#pragma unroll
    for (int o = 1; o < 64; o <<= 1) part += __shfl_xor(part, o);
    const float rstd = rsqrtf(part * (1.f / 1024.f) + EPS);
#pragma unroll
    for (int i = 0; i < 4; ++i) {
      const int c0 = i * 256 + lane * 4;
      f4v rr;
#pragma unroll
      for (int k = 0; k < 4; ++k) rr[k] = xv[i][k] + gt[i][k] * (bfs(ob[i][k]) * rstd * gp[i][k]);
      stf4_nt(p.out + (size_t)tg * 1024 + c0, rr);
    }
  }
}

#define XB_TMO      128
#define XB_XCNT(j)  (256  + 64 * (j))
#define XB_XSUB(j)  (1280 + 64 * (j))
#define XB_XGEN(j)  (2304 + 64 * (j))
#define XB_TOP      3328
#define XB_TOPGEN   3392
#define XCD_BAR_WORDS 3456
#define XB_SPIN_CAP (1u << 18)
#define LAS __attribute__((address_space(3)))
DI unsigned xb_ld(unsigned* p)              { return __hip_atomic_load(p, __ATOMIC_RELAXED, __HIP_MEMORY_SCOPE_AGENT); }
DI unsigned xb_add(unsigned* p, unsigned v) { return __hip_atomic_fetch_add(p, v, __ATOMIC_RELAXED, __HIP_MEMORY_SCOPE_AGENT); }
DI unsigned xb_xcc_id() { return (unsigned)__builtin_amdgcn_s_getreg((3 << 11) | 20) & 0xFu; }
#define XB_SPIN(cond, bar) do { unsigned _sp = 0; while (cond) { __builtin_amdgcn_s_sleep(1); \
    if ((++_sp & 255u) == 0u) { if (xb_ld(&(bar)[XB_TMO])) break; if (_sp > XB_SPIN_CAP) { atomicAdd(&(bar)[XB_TMO], 1u); break; } } } } while (0)
struct XcdBarrier { unsigned* bar; unsigned x; volatile LAS unsigned* st; };
DI XcdBarrier xcd_barrier_post(unsigned* bar, volatile LAS unsigned* st) {
  XcdBarrier b; b.bar = bar; b.x = xb_xcc_id(); b.st = st;
  if (threadIdx.x == 0) (void)xb_add(&bar[XB_XCNT(b.x)], 1u);
  return b;
}
DI void xcd_barrier_complete(unsigned* bar, unsigned x, unsigned& nloc, unsigned& nx) {
  const unsigned G = gridDim.x * gridDim.y * gridDim.z;
  unsigned sum, cnt, mine, sp = 0u;
  for (;;) {
    sum = 0u; cnt = 0u; mine = 0u;
#pragma unroll
    for (unsigned j = 0; j < 16; ++j) { const unsigned c = xb_ld(&bar[XB_XCNT(j)]); sum += c; cnt += (c > 0u) ? 1u : 0u; mine = (j == x) ? c : mine; }
    if (sum == G) break;
    __builtin_amdgcn_s_sleep(1);
    if ((++sp & 255u) == 0u) { if (xb_ld(&bar[XB_TMO])) break; if (sp > XB_SPIN_CAP) { atomicAdd(&bar[XB_TMO], 1u); break; } }
  }
  nloc = mine > 0u ? mine : 1u; nx = cnt > 0u ? cnt : 1u;
}
DI void xcd_barrier(const XcdBarrier& b) {
  asm volatile("s_waitcnt vmcnt(0)" ::: "memory");
  __syncthreads();
  if (threadIdx.x == 0) {
    unsigned* bar = b.bar;
    __builtin_amdgcn_s_waitcnt(0);
    unsigned nloc = b.st[0], nx = b.st[1];
    if (nloc == 0u) { xcd_barrier_complete(bar, b.x, nloc, nx); b.st[0] = nloc; b.st[1] = nx; }
    const unsigned old = xb_add(&bar[XB_XSUB(b.x)], 1u);
    const unsigned gen = old / nloc;
    if (old + 1u == (gen + 1u) * nloc) {
      __builtin_amdgcn_fence(__ATOMIC_RELEASE, "agent");
      asm volatile("s_waitcnt vmcnt(0)" ::: "memory");
      const unsigned og = xb_add(&bar[XB_TOP], 1u);
      const unsigned tg = og / nx;
      if (og + 1u == (tg + 1u) * nx) xb_add(&bar[XB_TOPGEN], 1u);
      else XB_SPIN(xb_ld(&bar[XB_TOPGEN]) == tg, bar);
      __builtin_amdgcn_fence(__ATOMIC_ACQUIRE, "agent");
      xb_add(&bar[XB_XGEN(b.x)], 1u);
      asm volatile("s_waitcnt vmcnt(0)" ::: "memory");
    } else {
      XB_SPIN(xb_ld(&bar[XB_XGEN(b.x)]) == gen, bar);
      __builtin_amdgcn_fence(__ATOMIC_ACQUIRE, "agent");
      asm volatile("s_waitcnt vmcnt(0)" ::: "memory");
    }
  }
  __syncthreads();
}

constexpr int PH_PER_PASS = 8;
constexpr int N_PHASES = 2 + NPASS * PH_PER_PASS;

constexpr int REP_MASK = 0;
constexpr int REP_SUB = 0;
constexpr int REP_A = 0;
constexpr int CPROBE = 0;
__global__ void __launch_bounds__(256, 2) mega_kernel(Params p, int ph_lo, int ph_hi) {
  __shared__ __attribute__((aligned(16))) unsigned char smem[73728];
  __shared__ uint4 xb_words;
  cg::grid_group grid = cg::this_grid();
  if (threadIdx.x == 0) xb_words = make_uint4(0u, 0u, 0u, 0u);
  __syncthreads();
  const XcdBarrier xb = xcd_barrier_post((unsigned*)(p.ws + O_BAR), (volatile LAS unsigned*)&xb_words);
  for (int ph = ph_lo; ph < ph_hi; ++ph) {
    if (ph == 0) {
      phaseA(p, smem);
      if (REP_A) { xcd_barrier(xb); phaseA(p, smem); }
    } else if (ph == 1) {
      phaseB(p, 0);
    } else {
      const int pass = (ph - 2) / PH_PER_PASS, k = (ph - 2) % PH_PER_PASS;
      Params q = p;
      const int nrep = ((REP_MASK >> k) & 1) ? 2 : 1;
      for (int rep = 0; rep < nrep; ++rep) {
        if (rep) xcd_barrier(xb);
        if (rep && REP_SUB == 9) continue;
        switch (k) {
          case 0: if (REP_MASK != 0 && rep) phaseC<CPROBE>(q, (u16*)smem); else phaseC<0>(q, (u16*)smem); break;
          case 1: phaseD(q, (u16*)smem, rep ? REP_SUB : 0, pass, rep); break;
          case 2: phaseE(q, (float*)smem, rep ? REP_SUB : 0, pass, rep); break;
          case 3: phaseF(q, rep > 0, (u16*)smem, pass, rep); break;
          case 4: phaseG(q, (float*)smem); break;
          case 5: phaseH(q, (u16*)smem); break;
          case 6: phaseI(q, (u16*)smem); break;
          default:
            phaseJ(q, pass);
            if (pass + 1 < NPASS) phaseB(q, pass + 1);
            break;
        }
      }
    }
    if (ph + 1 < ph_hi) {
      if (ph_hi < 0) grid.sync();
      xcd_barrier(xb);
    }
  }
}

extern "C" void kernel_launch(void* const* d_in, const int* in_sizes, int n_in, void* d_out, int out_size, void* d_ws,
                              size_t ws_size, hipStream_t stream) {
  static int grid_blocks = 0;
  if (!grid_blocks) {
    int dev = 0, cus = 0, per_cu = 0;
    hipGetDevice(&dev);
    hipDeviceGetAttribute(&cus, hipDeviceAttributeMultiprocessorCount, dev);
    hipOccupancyMaxActiveBlocksPerMultiprocessor(&per_cu, mega_kernel, 256, 0);
    if (per_cu < 1) per_cu = 1;
    if (per_cu > 2) per_cu = 2;
    grid_blocks = cus * per_cu;
  }
  if (ws_size < O_END) { fprintf(stderr, "workspace too small: %zu < %zu\n", ws_size, (size_t)O_END); return; }
  Params p{};
  const float** pp = reinterpret_cast<const float**>(&p);
  for (int i = 0; i < 22; ++i) pp[i] = (const float*)d_in[i];
  p.out = (float*)d_out;
  p.ws = (unsigned char*)d_ws;
  hipMemsetAsync((unsigned char*)d_ws + O_BAR, 0, 16384, stream);
  int lo = 0, hi = N_PHASES;
  void* args[] = {&p, &lo, &hi};
  hipError_t e = hipLaunchCooperativeKernel((void*)mega_kernel, dim3(grid_blocks), dim3(256), args, 0, stream);
  if (e != hipSuccess) fprintf(stderr, "cooperative launch failed: %s (grid %d)\n", hipGetErrorString(e), grid_blocks);
}
```
